# Optimizing an MI355X kernel written in HIP

```python
import math
import jax, jax.numpy as jnp
from jax import lax
import numpy as np

D_MODEL = 1024
BATCH = 8
SEQ = 2048
DEPTH = 2

HEAD_DIM = 64
D_MIX = D_MODEL
SSM_WIDTH = D_MIX // 4
SSM_CH = 16
SSM_GROUPS = SSM_WIDTH // SSM_CH
SSM_STATE = 64
ATTN_HEADS = (D_MIX - SSM_WIDTH) // (2 * HEAD_DIM)
MLA_HEADS = ATTN_HEADS
MLA_NOPE = HEAD_DIM
MLA_ROPE = HEAD_DIM // 2
MLA_V = HEAD_DIM
MLA_Q_RANK = 192
MLA_KV_RANK = 128
NSA_HEADS = ATTN_HEADS
NSA_KV_HEADS = 2
NSA_REP = NSA_HEADS // NSA_KV_HEADS
NSA_DIM = HEAD_DIM
CMP_BLOCK = 32
CMP_STRIDE = 16
SEL_BLOCK = 64
SEL_TOPN = 8
WINDOW = 256
REL_BUCKETS = 32
REL_MAX_DIST = 128
XATTN_HEADS = 4
XATTN_DIM = D_MODEL // XATTN_HEADS
MEM_TOKENS = 256
FF_DENSE = 2816
N_EXPERTS = 8
TOP_K = 2
FF_EXPERT = 3584
Q_BLOCK = 128
ROPE_THETA = 10000.0
EPS = 1e-6
NEG_INF = -1e30
FORCE = 1e9
N_DENSE = (DEPTH + 1) // 2
N_MOE = DEPTH // 2
MLA_WIDTH = MLA_HEADS * MLA_V
NSA_WIDTH = NSA_HEADS * NSA_DIM
IN_SPLITS = (SSM_WIDTH, MLA_Q_RANK, MLA_KV_RANK, MLA_ROPE, NSA_HEADS * NSA_DIM,
             6 * NSA_KV_HEADS * NSA_DIM, 3 * NSA_HEADS)
IN_COLS = sum(IN_SPLITS)

kernel_name = "hymba_s5_mla_nsa_moe_trunk"


def rmsnorm(x, g):
    xf = x.astype(jnp.float32)
    y = xf * lax.rsqrt(jnp.mean(xf * xf, axis=-1, keepdims=True) + EPS)
    return (y * g.astype(jnp.float32)).astype(x.dtype)


def softmax32(s):
    return jax.nn.softmax(s.astype(jnp.float32), axis=-1)


def t5_bucket(dist):
    n = jnp.maximum(dist, 0)
    exact = REL_BUCKETS // 2
    nf = jnp.maximum(n, exact).astype(jnp.float32)
    large = exact + (jnp.log(nf / exact) / math.log(REL_MAX_DIST / exact)
                     * (REL_BUCKETS - exact)).astype(jnp.int32)
    return jnp.where(n < exact, n, jnp.minimum(large, REL_BUCKETS - 1))


def rope_tables(seq, dim):
    pos = jnp.arange(seq, dtype=jnp.float32)
    inv = 1.0 / (ROPE_THETA ** (jnp.arange(0, dim, 2, dtype=jnp.float32) / dim))
    ang = pos[:, None] * inv[None, :]
    return jnp.cos(ang), jnp.sin(ang)


def apply_rope(x, cos, sin):
    half = x.shape[-1] // 2
    xf = x.astype(jnp.float32)
    x1, x2 = xf[..., :half], xf[..., half:]
    return jnp.concatenate([x1 * cos - x2 * sin, x2 * cos + x1 * sin], axis=-1).astype(x.dtype)


def _cplx_combine(e1, e2):
    a1r, a1i, b1r, b1i = e1
    a2r, a2i, b2r, b2i = e2
    ar = a2r * a1r - a2i * a1i
    ai = a2r * a1i + a2i * a1r
    br = a2r * b1r - a2i * b1i + b2r
    bi = a2r * b1i + a2i * b1r + b2i
    return (ar, ai, br, bi)


def ssm_mixer(u, a_re, a_im, b_re, b_im, c_re, c_im, d, log_dt, w_glu):
    f32 = jnp.float32
    bsz, seq, _ = u.shape
    ug = u.astype(f32).reshape(bsz, seq, SSM_GROUPS, SSM_CH)
    dt = jnp.exp(log_dt.astype(f32))[:, None]
    lr, li = a_re.astype(f32), a_im.astype(f32)
    mag = jnp.exp(lr * dt)
    ab_r, ab_i = mag * jnp.cos(li * dt), mag * jnp.sin(li * dt)
    den = lr * lr + li * li
    nr = ab_r - 1.0
    f_r = (nr * lr + ab_i * li) / den
    f_i = (ab_i * lr - nr * li) / den
    br, bi = b_re.astype(f32), b_im.astype(f32)
    bb_r = f_r[..., None] * br - f_i[..., None] * bi
    bb_i = f_r[..., None] * bi + f_i[..., None] * br
    bu_r = jnp.einsum('bsgc,gpc->bsgp', ug, bb_r)
    bu_i = jnp.einsum('bsgc,gpc->bsgp', ug, bb_i)
    a_r = jnp.broadcast_to(ab_r, bu_r.shape)
    a_i = jnp.broadcast_to(ab_i, bu_r.shape)
    _, _, h_r, h_i = lax.associative_scan(_cplx_combine, (a_r, a_i, bu_r, bu_i), axis=1)
    y = (jnp.einsum('bsgp,gcp->bsgc', h_r, c_re.astype(f32))
         - jnp.einsum('bsgp,gcp->bsgc', h_i, c_im.astype(f32))
         + d.astype(f32).reshape(SSM_GROUPS, SSM_CH) * ug)
    y = jax.nn.gelu(y.reshape(bsz, seq, SSM_WIDTH)).astype(u.dtype)
    return y * jax.nn.sigmoid(y @ w_glu)


def mla_mixer(cq, ckv, kr, q_norm, w_uq, kv_norm, w_ukv, cos, sin):
    bsz, seq, _ = cq.shape
    q = (rmsnorm(cq, q_norm) @ w_uq).reshape(bsz, seq, MLA_HEADS, MLA_NOPE + MLA_ROPE)
    q_nope = q[..., :MLA_NOPE]
    q_rope = apply_rope(q[..., MLA_NOPE:], cos[:, None, :], sin[:, None, :])
    kv = (rmsnorm(ckv, kv_norm) @ w_ukv).reshape(bsz, seq, MLA_HEADS, MLA_NOPE + MLA_V)
    k_nope, v = kv[..., :MLA_NOPE], kv[..., MLA_NOPE:]
    k_rope = apply_rope(kr, cos, sin)
    scale = (MLA_NOPE + MLA_ROPE) ** -0.5
    kpos = jnp.arange(seq)

    def block(i):
        qs = i * Q_BLOCK
        qn = lax.dynamic_slice_in_dim(q_nope, qs, Q_BLOCK, axis=1)
        qr = lax.dynamic_slice_in_dim(q_rope, qs, Q_BLOCK, axis=1)
        s = (jnp.einsum('bqhd,bkhd->bhqk', qn, k_nope)
             + jnp.einsum('bqhr,bkr->bhqk', qr, k_rope)).astype(jnp.float32) * scale
        t = qs + jnp.arange(Q_BLOCK)
        s = jnp.where(kpos[None, :] <= t[:, None], s, NEG_INF)
        p = softmax32(s).astype(v.dtype)
        return jnp.einsum('bhqk,bkhd->bqhd', p, v)

    o = lax.map(block, jnp.arange(seq // Q_BLOCK))
    return o.transpose(1, 0, 2, 3, 4).reshape(bsz, seq, MLA_WIDTH)


def nsa_compress(k, pe, w1, w2):
    bsz, seq, g, dh = k.shape
    ratio = CMP_BLOCK // CMP_STRIDE
    n_chunk = seq // CMP_STRIDE
    nbc = n_chunk - ratio + 1
    ch = k.reshape(bsz, n_chunk, CMP_STRIDE, g, dh)
    blocks = jnp.concatenate([ch[:, j:j + nbc] for j in range(ratio)], axis=2)
    blocks = blocks + pe[None, None, :, None, :]
    flat = blocks.transpose(0, 1, 3, 2, 4).reshape(bsz, nbc, g, CMP_BLOCK * dh)
    return jax.nn.gelu(flat @ w1) @ w2


def nsa_mixer(q, kv, gate_logits, cmp_pe, cmp_w1, cmp_w2, rel_bias):
    f32 = jnp.float32
    bsz, seq, _ = q.shape
    G, R, dh = NSA_KV_HEADS, NSA_REP, NSA_DIM
    dt = q.dtype
    q = q.reshape(bsz, seq, G, R, dh)
    kv = kv.reshape(bsz, seq, 6, G, dh)
    k_cr, v_cr, k_sl, v_sl, k_wn, v_wn = [kv[:, :, j] for j in range(6)]
    gates = jax.nn.sigmoid(gate_logits.astype(f32)).reshape(bsz, seq, 3, G, R).astype(dt)
    k_c = nsa_compress(k_cr, cmp_pe[0], cmp_w1[0], cmp_w2[0])
    v_c = nsa_compress(v_cr, cmp_pe[1], cmp_w1[1], cmp_w2[1])
    nbc = k_c.shape[1]
    nbs = seq // SEL_BLOCK
    n_sel = min(SEL_TOPN, nbs)
    c_end = jnp.arange(nbc) * CMP_STRIDE + CMP_BLOCK - 1
    ci = jnp.arange(nbc)[:, None]
    sj = jnp.arange(nbs)[None, :]
    overlap = ((ci * CMP_STRIDE <= sj * SEL_BLOCK + SEL_BLOCK - 1)
               & (ci * CMP_STRIDE + CMP_BLOCK - 1 >= sj * SEL_BLOCK)).astype(f32)
    k_sb = k_sl.reshape(bsz, nbs, SEL_BLOCK, G, dh).transpose(0, 3, 1, 2, 4)
    v_sb = v_sl.reshape(bsz, nbs, SEL_BLOCK, G, dh).transpose(0, 3, 1, 2, 4)
    pad = ((0, 0), (WINDOW, 0), (0, 0), (0, 0))
    k_wp = jnp.pad(k_wn, pad)
    v_wp = jnp.pad(v_wn, pad)
    rb_h = rel_bias.astype(f32)
    rb_grn = rb_h.reshape(REL_BUCKETS, G, R).transpose(1, 2, 0)
    b_ix = jnp.arange(bsz)[:, None, None, None]
    g_ix = jnp.arange(G)[None, :, None, None]
    gi5 = jnp.arange(G)[None, :, None, None, None]
    ri5 = jnp.arange(R)[None, None, :, None, None]
    scale = dh ** -0.5
    span = Q_BLOCK + WINDOW

    def head_bias(dist):
        return rb_h[t5_bucket(dist)].reshape(*dist.shape, G, R).transpose(2, 3, 0, 1)

    def block(i):
        qs = i * Q_BLOCK
        t = qs + jnp.arange(Q_BLOCK)
        qb = lax.dynamic_slice_in_dim(q, qs, Q_BLOCK, axis=1)
        gb = lax.dynamic_slice_in_dim(gates, qs, Q_BLOCK, axis=1)
        dist_c = t[:, None] - c_end[None, :]
        ok_c = dist_c >= 0
        s_c = jnp.einsum('bqgrd,bngd->bgrqn', qb, k_c).astype(f32) * scale + head_bias(dist_c)
        p_c = softmax32(jnp.where(ok_c, s_c, NEG_INF)) * ok_c.any(-1)[:, None].astype(f32)
        o_c = jnp.einsum('bgrqn,bngd->bqgrd', p_c.astype(dt), v_c)
        imp = jnp.einsum('bgrqn,nm->bgqm', p_c, overlap)
        cur = t // SEL_BLOCK
        forced = (sj == 0) | (sj == cur[:, None]) | (sj == cur[:, None] - 1)
        future = sj * SEL_BLOCK > t[:, None]
        imp = jnp.where(forced, FORCE, jnp.where(future, -FORCE, imp))
        _, idx = lax.top_k(imp, n_sel)
        k_g = k_sb[b_ix, g_ix, idx].reshape(bsz, G, Q_BLOCK, n_sel * SEL_BLOCK, dh)
        v_g = v_sb[b_ix, g_ix, idx].reshape(bsz, G, Q_BLOCK, n_sel * SEL_BLOCK, dh)
        kpos = (idx[..., None] * SEL_BLOCK + jnp.arange(SEL_BLOCK)).reshape(bsz, G, Q_BLOCK, n_sel * SEL_BLOCK)
        dist_s = t[:, None] - kpos
        bias_s = rb_grn[gi5, ri5, t5_bucket(dist_s)[:, :, None]]
        s_s = jnp.einsum('bqgrd,bgqmd->bgrqm', qb, k_g).astype(f32) * scale + bias_s
        p_s = softmax32(jnp.where((dist_s >= 0)[:, :, None], s_s, NEG_INF))
        o_s = jnp.einsum('bgrqm,bgqmd->bqgrd', p_s.astype(dt), v_g)
        k_w = lax.dynamic_slice_in_dim(k_wp, qs, span, axis=1)
        v_w = lax.dynamic_slice_in_dim(v_wp, qs, span, axis=1)
        kpos_w = qs - WINDOW + jnp.arange(span)
        dist_w = t[:, None] - kpos_w[None, :]
        ok_w = (dist_w >= 0) & (dist_w < WINDOW) & (kpos_w >= 0)[None, :]
        s_w = jnp.einsum('bqgrd,blgd->bgrql', qb, k_w).astype(f32) * scale + head_bias(dist_w)
        p_w = softmax32(jnp.where(ok_w, s_w, NEG_INF))
        o_w = jnp.einsum('bgrql,blgd->bqgrd', p_w.astype(dt), v_w)
        o = (gb[:, :, 0][..., None] * o_c + gb[:, :, 1][..., None] * o_s
             + gb[:, :, 2][..., None] * o_w)
        return o.reshape(bsz, Q_BLOCK, G * R * dh)

    o = lax.map(block, jnp.arange(seq // Q_BLOCK))
    return o.transpose(1, 0, 2, 3).reshape(bsz, seq, NSA_WIDTH)


def cross_attn(h, mem, g_x, g_mem, wq, wkv, wo):
    bsz, seq, _ = h.shape
    m = mem.shape[1]
    q = (rmsnorm(h, g_x) @ wq).reshape(bsz, seq, XATTN_HEADS, XATTN_DIM)
    kv = (rmsnorm(mem, g_mem) @ wkv).reshape(bsz, m, 2, XATTN_HEADS, XATTN_DIM)
    k, v = kv[:, :, 0], kv[:, :, 1]
    s = jnp.einsum('bshd,bmhd->bhsm', q, k).astype(jnp.float32) * XATTN_DIM ** -0.5
    p = softmax32(s).astype(v.dtype)
    o = jnp.einsum('bhsm,bmhd->bshd', p, v).reshape(bsz, seq, XATTN_HEADS * XATTN_DIM)
    return o @ wo


def swiglu(x, wg, wu, wd):
    return (jax.nn.silu(x @ wg) * (x @ wu)) @ wd


def moe_swiglu(x, router, wg, wu, wd):
    bsz, seq, d = x.shape
    xt = x.reshape(-1, d)
    logits = (xt @ router).astype(jnp.float32)
    top_v, top_i = lax.top_k(logits, TOP_K)
    w = jax.nn.softmax(top_v, axis=-1)
    comb = jnp.sum(jax.nn.one_hot(top_i, N_EXPERTS, dtype=jnp.float32) * w[..., None], axis=1)
    comb = comb.astype(xt.dtype)
    out = jnp.zeros_like(xt)
    for e in range(N_EXPERTS):
        out = out + comb[:, e:e + 1] * swiglu(xt, wg[e], wu[e], wd[e])
    return out.reshape(bsz, seq, d)


def setup_inputs(seed: int = 0) -> dict:
    key = jax.random.key(seed)
    ks = iter(jax.random.split(key, 48))
    f32 = jnp.float32
    L, G, P, C = DEPTH, SSM_GROUPS, SSM_STATE, SSM_CH

    def nrm(shape, scale):
        return jax.random.normal(next(ks), shape, f32) * scale

    def gain(shape):
        return 1.0 + nrm(shape, 0.02)

    return {
        "x": nrm((BATCH, SEQ, D_MODEL), 1.0),
        "mem": nrm((BATCH, MEM_TOKENS, D_MODEL), 1.0),
        "w_in": nrm((L, D_MODEL, IN_COLS), D_MODEL ** -0.5),
        "w_out": nrm((L, D_MIX, D_MODEL), D_MIX ** -0.5),
        "mix_norm": gain((L, D_MODEL)),
        "out_norm": gain((L, D_MIX)),
        "ssm_a_re": -0.5 + nrm((L, G, P), 0.01),
        "ssm_a_im": jnp.pi * jnp.arange(P, dtype=f32) + nrm((L, G, P), 0.01),
        "ssm_b_re": nrm((L, G, P, C), C ** -0.5),
        "ssm_b_im": nrm((L, G, P, C), C ** -0.5),
        "ssm_c_re": nrm((L, G, C, P), P ** -0.5),
        "ssm_c_im": nrm((L, G, C, P), P ** -0.5),
        "ssm_d": nrm((L, SSM_WIDTH), 1.0),
        "ssm_log_dt": jax.random.uniform(next(ks), (L, G), f32, math.log(1e-3), math.log(1e-1)),
        "ssm_w_glu": nrm((L, SSM_WIDTH, SSM_WIDTH), SSM_WIDTH ** -0.5),
        "mla_q_norm": gain((L, MLA_Q_RANK)),
        "mla_w_uq": nrm((L, MLA_Q_RANK, MLA_HEADS * (MLA_NOPE + MLA_ROPE)), MLA_Q_RANK ** -0.5),
        "mla_kv_norm": gain((L, MLA_KV_RANK)),
        "mla_w_ukv": nrm((L, MLA_KV_RANK, MLA_HEADS * (MLA_NOPE + MLA_V)), MLA_KV_RANK ** -0.5),
        "nsa_cmp_pe": nrm((L, 2, CMP_BLOCK, NSA_DIM), 0.1),
        "nsa_cmp_w1": nrm((L, 2, CMP_BLOCK * NSA_DIM, NSA_DIM), (CMP_BLOCK * NSA_DIM) ** -0.5),
        "nsa_cmp_w2": nrm((L, 2, NSA_DIM, NSA_DIM), NSA_DIM ** -0.5),
        "rel_bias": nrm((REL_BUCKETS, NSA_HEADS), 0.5),
        "xattn_norm": gain((L, D_MODEL)),
        "mem_norm": gain((L, D_MODEL)),
        "xattn_wq": nrm((L, D_MODEL, XATTN_HEADS * XATTN_DIM), D_MODEL ** -0.5),
        "xattn_wkv": nrm((L, D_MODEL, 2 * XATTN_HEADS * XATTN_DIM), D_MODEL ** -0.5),
        "xattn_wo": nrm((L, XATTN_HEADS * XATTN_DIM, D_MODEL), D_MODEL ** -0.5),
        "ffn_norm": gain((L, D_MODEL)),
        "dense_w_gate": nrm((N_DENSE, D_MODEL, FF_DENSE), D_MODEL ** -0.5),
        "dense_w_up": nrm((N_DENSE, D_MODEL, FF_DENSE), D_MODEL ** -0.5),
        "dense_w_down": nrm((N_DENSE, FF_DENSE, D_MODEL), FF_DENSE ** -0.5),
        "moe_router": nrm((N_MOE, D_MODEL, N_EXPERTS), D_MODEL ** -0.5),
        "moe_w_gate": nrm((N_MOE, N_EXPERTS, D_MODEL, FF_EXPERT), D_MODEL ** -0.5),
        "moe_w_up": nrm((N_MOE, N_EXPERTS, D_MODEL, FF_EXPERT), D_MODEL ** -0.5),
        "moe_w_down": nrm((N_MOE, N_EXPERTS, FF_EXPERT, D_MODEL), FF_EXPERT ** -0.5),
        "final_norm": gain((D_MODEL,)),
    }


def reference(x, mem, w_in, w_out, mix_norm, out_norm, ssm_a_re, ssm_a_im, ssm_b_re, ssm_b_im,
              ssm_c_re, ssm_c_im, ssm_d, ssm_log_dt, ssm_w_glu, mla_q_norm, mla_w_uq, mla_kv_norm,
              mla_w_ukv, nsa_cmp_pe, nsa_cmp_w1, nsa_cmp_w2, rel_bias, xattn_norm, mem_norm, xattn_wq,
              xattn_wkv, xattn_wo, ffn_norm, dense_w_gate, dense_w_up, dense_w_down, moe_router,
              moe_w_gate, moe_w_up, moe_w_down, final_norm):
    seq = x.shape[1]
    cos, sin = rope_tables(seq, MLA_ROPE)
    offsets = np.cumsum(IN_SPLITS)[:-1].tolist()
    o1 = SSM_WIDTH
    o2 = SSM_WIDTH + MLA_WIDTH
    h = x
    for l in range(DEPTH):
        proj = rmsnorm(h, mix_norm[l]) @ w_in[l]
        u, cq, ckv, kr, nq, nkv, ngate = jnp.split(proj, offsets, axis=-1)
        y_ssm = ssm_mixer(u, ssm_a_re[l], ssm_a_im[l], ssm_b_re[l], ssm_b_im[l], ssm_c_re[l],
                          ssm_c_im[l], ssm_d[l], ssm_log_dt[l], ssm_w_glu[l])
        y_mla = mla_mixer(cq, ckv, kr, mla_q_norm[l], mla_w_uq[l], mla_kv_norm[l], mla_w_ukv[l], cos, sin)
        y_nsa = nsa_mixer(nq, nkv, ngate, nsa_cmp_pe[l], nsa_cmp_w1[l], nsa_cmp_w2[l], rel_bias)
        g = out_norm[l]
        y = jnp.concatenate([rmsnorm(y_ssm, g[:o1]), rmsnorm(y_mla, g[o1:o2]),
                             rmsnorm(y_nsa, g[o2:])], axis=-1)
        h = h + y @ w_out[l]
        h = h + cross_attn(h, mem, xattn_norm[l], mem_norm[l], xattn_wq[l], xattn_wkv[l], xattn_wo[l])
        hn = rmsnorm(h, ffn_norm[l])
        if l % 2 == 0:
            h = h + swiglu(hn, dense_w_gate[l // 2], dense_w_up[l // 2], dense_w_down[l // 2])
        else:
            h = h + moe_swiglu(hn, moe_router[l // 2], moe_w_gate[l // 2], moe_w_up[l // 2],
                               moe_w_down[l // 2])
    return rmsnorm(h, final_norm)
```

```cpp
#include <hip/hip_runtime.h>
#include <cstdio>
#include <cstdint>

#ifndef MK_ONE_LAUNCH
#define MK_ONE_LAUNCH 1
#endif

#define LAS __attribute__((address_space(3)))
typedef float f32x4 __attribute__((ext_vector_type(4)));
typedef float f32x2 __attribute__((ext_vector_type(2)));
typedef unsigned short bf16_t;
typedef unsigned u32x2 __attribute__((ext_vector_type(2)));
typedef unsigned u32x4 __attribute__((ext_vector_type(4)));
typedef __bf16 bf16v2_t __attribute__((ext_vector_type(2)));
__device__ __forceinline__ unsigned pk_bf16(float lo, float hi) { const f32x2 v = {lo, hi}; return __builtin_bit_cast(unsigned, __builtin_convertvector(v, bf16v2_t)); }
__device__ __forceinline__ bf16_t f2bf(float f) { return (bf16_t)(pk_bf16(f, 0.f) & 0xffffu); }
__device__ __forceinline__ float bf2f(bf16_t b) { return __uint_as_float(((unsigned)b) << 16); }
__device__ __forceinline__ float bflo(unsigned u) { return __uint_as_float(u << 16); }
__device__ __forceinline__ float bfhi(unsigned u) { return __uint_as_float(u & 0xffff0000u); }
typedef short bf16x8_t __attribute__((ext_vector_type(8)));
typedef __bf16 bfv8_t __attribute__((ext_vector_type(8)));
typedef float f32x8_t __attribute__((ext_vector_type(8)));
__device__ __forceinline__ bf16x8_t pack8f(float a0, float a1, float a2, float a3, float a4, float a5, float a6, float a7) {
    const f32x8_t v = {a0, a1, a2, a3, a4, a5, a6, a7};
    return __builtin_bit_cast(bf16x8_t, __builtin_convertvector(v, bfv8_t));
}
__device__ __forceinline__ float xhalf_max(float x) { const auto r = __builtin_amdgcn_permlane32_swap(__float_as_uint(x), __float_as_uint(x), false, false); return fmaxf(__uint_as_float(r[0]), __uint_as_float(r[1])); }
__device__ __forceinline__ float xhalf_sum(float x) { const auto r = __builtin_amdgcn_permlane32_swap(__float_as_uint(x), __float_as_uint(x), false, false); return __uint_as_float(r[0]) + __uint_as_float(r[1]); }
__device__ __forceinline__ int tid_() { int t = threadIdx.x; asm volatile("" : "+v"(t)); return t; }

constexpr int NB = 8, SEQ = 2048, T = NB * SEQ, D = 1024;
constexpr int INC = 1778, INLD = 1792;
constexpr int O_U = 0, O_CQ = 256, O_CKV = 448, O_KR = 576, O_NQ = 608, O_NKV = 992, O_NG = 1760;
constexpr int NBC = 127;
constexpr int FFD = 2816, FFE = 3584, NE = 8;
constexpr int MOE_ROWS = 2 * T + NE * 256;
constexpr int MOE_TILES = MOE_ROWS / 256;
constexpr int MOE_NR = 3, MOE_RT = 64;
constexpr float EPS = 1e-6f;
constexpr int NTHR = 512;

constexpr size_t MiB = 1u << 20;
constexpr size_t WS_CTL = 0, CTL_BYTES = 1 * MiB;
constexpr size_t WS_SMALL = 1 * MiB;
constexpr size_t SM_ROPE = WS_SMALL;
constexpr size_t SM_SSME = SM_ROPE + 256 * 1024;
constexpr size_t SM_KC = SM_SSME + 2 * MiB;
constexpr size_t SM_HID = SM_KC + 2 * MiB;
constexpr size_t SM_SEL = SM_HID + 2 * MiB;
constexpr size_t SM_TOPI = SM_SEL + 256 * 1024;
constexpr size_t SM_TOPW = SM_TOPI + 256 * 1024;
constexpr size_t SM_POS = SM_TOPW + 256 * 1024;
constexpr size_t SM_RSRC = SM_POS + 256 * 1024;
constexpr size_t SM_TEXP = SM_RSRC + 256 * 1024;
constexpr size_t SM_KROPE = SM_TEXP + 256 * 1024;
constexpr size_t SM_IMPP = SM_KROPE + 2 * MiB;
static_assert(SM_IMPP + 12 * MiB <= 25 * MiB, "small region");
constexpr size_t WS_H = 25 * MiB;
constexpr size_t WS_XNB = 89 * MiB;
constexpr size_t XB_CQN = WS_XNB, XB_CKVN = WS_XNB + 8 * MiB, XB_YPRE = WS_XNB + 16 * MiB;
constexpr size_t WS_WBS = 121 * MiB;
constexpr size_t WS_KVX = 169 * MiB;
constexpr size_t WS_R = 201 * MiB;
constexpr size_t BG_PROJ = WS_R, BG_NKVB = WS_R + 112 * MiB, BG_QMLA = WS_R + 136 * MiB, BG_NQB = WS_R + 160 * MiB, BG_KVMB = WS_R + 184 * MiB, BG_YCAT = WS_R + 208 * MiB, BG_KRB = WS_R + 272 * MiB;
constexpr size_t BG_MEMN = WS_R + 275 * MiB;
constexpr size_t BG_QX = WS_R, BG_OX = WS_R + 64 * MiB;
constexpr size_t BG_ACT = WS_R;
constexpr size_t MOE_ACT = 121 * MiB;
constexpr size_t MOE_YS = 233 * MiB;
constexpr size_t MOE_YS2P = 297 * MiB;
constexpr size_t MOE_W = 331 * MiB;
constexpr size_t WS_END = 499 * MiB;

constexpr size_t WL_WIN = 0, WL_WUQ = WL_WIN + (size_t)1792 * 1024, WL_WUKV = WL_WUQ + 768 * 256, WL_WGLU = WL_WUKV + 768 * 256, WL_WOUT = WL_WGLU + 256 * 256,
                 WL_XWQ = WL_WOUT + 1024 * 1024, WL_XWKV = WL_XWQ + 1024 * 1024, WL_XWO = WL_XWKV + 2048 * 1024, WL_CW1 = WL_XWO + 1024 * 1024, WL_SIZE = WL_CW1 + 2 * 64 * 2048;
constexpr size_t WD_GU = 2 * WL_SIZE, WD_DN = WD_GU + (size_t)5632 * 1024, W_SMALL_END = WD_DN + (size_t)1024 * 2816;
static_assert(W_SMALL_END * 2 <= 48 * MiB, "small weights fit");
constexpr size_t ME_GU = 0, ME_DN = (size_t)7168 * 1024, ME_SIZE = ME_DN + (size_t)1024 * 3584;
static_assert(MOE_W + ME_SIZE * 8 * 2 <= WS_END, "moe weights fit");
#ifndef USE_PG8
#define USE_PG8 2
#endif

#define XB_TMO      128
#define XB_XCNT(j)  (256  + 64 * (j))
#define XB_XSUB(j)  (1280 + 64 * (j))
#define XB_XGEN(j)  (2304 + 64 * (j))
#define XB_TOP      3328
#define XB_TOPGEN   3392
#define XCD_BAR_WORDS 3456
#define XB_SPIN_CAP (1u << 22)
__device__ __forceinline__ unsigned xb_ld(unsigned* p)              { return __hip_atomic_load(p, __ATOMIC_RELAXED, __HIP_MEMORY_SCOPE_AGENT); }
__device__ __forceinline__ unsigned xb_add(unsigned* p, unsigned v) { return __hip_atomic_fetch_add(p, v, __ATOMIC_RELAXED, __HIP_MEMORY_SCOPE_AGENT); }
__device__ __forceinline__ unsigned xb_xcc_id() { return (unsigned)__builtin_amdgcn_s_getreg((3 << 11) | 20) & 0xFu; }
#define XB_SPIN(cond, bar) do { unsigned _sp = 0; while (cond) { __builtin_amdgcn_s_sleep(1); \
    if ((++_sp & 255u) == 0u) { if (xb_ld(&(bar)[XB_TMO])) break; if (_sp > XB_SPIN_CAP) { atomicAdd(&(bar)[XB_TMO], 1u); break; } } } } while (0)
struct XcdBarrier { unsigned* bar; unsigned x; volatile LAS unsigned* st; };
__device__ __forceinline__ XcdBarrier xcd_barrier_post(unsigned* bar, volatile LAS unsigned* st) {
    XcdBarrier b; b.bar = bar; b.x = xb_xcc_id(); b.st = st;
    if (threadIdx.x == 0) (void)xb_add(&bar[XB_XCNT(b.x)], 1u);
    return b;
}
__device__ __forceinline__ void xcd_barrier_complete(unsigned* bar, unsigned x, unsigned& nloc, unsigned& nx) {
    const unsigned G = gridDim.x * gridDim.y * gridDim.z;
    unsigned sum, cnt, mine, sp = 0u;
    for (;;) {
        sum = 0u; cnt = 0u; mine = 0u;
#pragma unroll
        for (unsigned j = 0; j < 16; ++j) { const unsigned c = xb_ld(&bar[XB_XCNT(j)]); sum += c; cnt += (c > 0u) ? 1u : 0u; mine = (j == x) ? c : mine; }
        if (sum == G) break;
        __builtin_amdgcn_s_sleep(1);
        if ((++sp & 255u) == 0u) { if (xb_ld(&bar[XB_TMO])) break; if (sp > XB_SPIN_CAP) { atomicAdd(&bar[XB_TMO], 1u); break; } }
    }
    nloc = mine > 0u ? mine : 1u; nx = cnt > 0u ? cnt : 1u;
}
__device__ __forceinline__ void xcd_barrier(const XcdBarrier& b) {
    asm volatile("s_waitcnt vmcnt(0)" ::: "memory");
    __syncthreads();
    if (threadIdx.x == 0) {
        unsigned* bar = b.bar;
        __builtin_amdgcn_s_waitcnt(0);
        unsigned nloc = b.st[0], nx = b.st[1];
        if (nloc == 0u) { xcd_barrier_complete(bar, b.x, nloc, nx); b.st[0] = nloc; b.st[1] = nx; }
        const unsigned old = xb_add(&bar[XB_XSUB(b.x)], 1u);
        const unsigned gen = old / nloc;
        if (old + 1u == (gen + 1u) * nloc) {
            __builtin_amdgcn_fence(__ATOMIC_RELEASE, "agent");
            asm volatile("s_waitcnt vmcnt(0)" ::: "memory");
            const unsigned og = xb_add(&bar[XB_TOP], 1u);
            const unsigned tg = og / nx;
            if (og + 1u == (tg + 1u) * nx) xb_add(&bar[XB_TOPGEN], 1u);
            else XB_SPIN(xb_ld(&bar[XB_TOPGEN]) == tg, bar);
            __builtin_amdgcn_fence(__ATOMIC_ACQUIRE, "agent");
            xb_add(&bar[XB_XGEN(b.x)], 1u);
            asm volatile("s_waitcnt vmcnt(0)" ::: "memory");
        } else {
            XB_SPIN(xb_ld(&bar[XB_XGEN(b.x)]) == gen, bar);
            __builtin_amdgcn_fence(__ATOMIC_ACQUIRE, "agent");
            asm volatile("s_waitcnt vmcnt(0)" ::: "memory");
        }
    }
    __syncthreads();
}

template <int CTRL> __device__ __forceinline__ float dpp_mov(float v) { return __uint_as_float(__builtin_amdgcn_update_dpp(0u, __float_as_uint(v), CTRL, 0xf, 0xf, true)); }
__device__ __forceinline__ float wave_sum(float v) {
    v += dpp_mov<0xB1>(v); v += dpp_mov<0x4E>(v); v += dpp_mov<0x124>(v); v += dpp_mov<0x128>(v);
    v += __shfl_xor(v, 16);
    const auto r = __builtin_amdgcn_permlane32_swap(__float_as_uint(v), __float_as_uint(v), false, false);
    return __uint_as_float(r[0]) + __uint_as_float(r[1]);
}
__device__ __forceinline__ float wave_max(float v) {
    v = fmaxf(v, dpp_mov<0xB1>(v)); v = fmaxf(v, dpp_mov<0x4E>(v)); v = fmaxf(v, dpp_mov<0x124>(v)); v = fmaxf(v, dpp_mov<0x128>(v));
    v = fmaxf(v, __shfl_xor(v, 16));
    const auto r = __builtin_amdgcn_permlane32_swap(__float_as_uint(v), __float_as_uint(v), false, false);
    return fmaxf(__uint_as_float(r[0]), __uint_as_float(r[1]));
}
__device__ __forceinline__ float sigmoidf_(float x) { return __builtin_amdgcn_rcpf(1.f + __expf(-x)); }
__device__ __forceinline__ float gelu_tanh(float x) {
    const float u = 0.7978845608028654f * (x + 0.044715f * x * x * x);
    const float th = 1.f - 2.f * __builtin_amdgcn_rcpf(__expf(2.f * u) + 1.f);
    return 0.5f * x * (1.f + th);
}
__device__ __forceinline__ void sincos_d(double ang, float& s, float& c) {
    double rev = ang * 0.15915494309189535;
    rev -= floor(rev);
    const float r = (float)rev;
    s = __builtin_amdgcn_sinf(r); c = __builtin_amdgcn_cosf(r);
}
__device__ __forceinline__ int t5_bucket(int dist) {
    const int n = dist < 0 ? 0 : dist;
    if (n < 16) return n;
    const int lg = 16 + (int)(__logf((float)n * 0.0625f) * (16.0f / 2.0794415416798357f));
    return lg < 31 ? lg : 31;
}

struct Params {
    const float* in[37];
    float* out;
    unsigned char* ws;
    int ph_lo, ph_hi;
};
#define IN_X 0
#define IN_MEM 1
#define IN_WIN 2
#define IN_WOUT 3
#define IN_MIXN 4
#define IN_OUTN 5
#define IN_SARE 6
#define IN_SAIM 7
#define IN_SBRE 8
#define IN_SBIM 9
#define IN_SCRE 10
#define IN_SCIM 11
#define IN_SD 12
#define IN_SLDT 13
#define IN_SGLU 14
#define IN_MQN 15
#define IN_MWUQ 16
#define IN_MKVN 17
#define IN_MWUKV 18
#define IN_NPE 19
#define IN_NW1 20
#define IN_NW2 21
#define IN_RELB 22
#define IN_XN 23
#define IN_MEMN 24
#define IN_XWQ 25
#define IN_XWKV 26
#define IN_XWO 27
#define IN_FFN 28
#define IN_DWG 29
#define IN_DWU 30
#define IN_DWD 31
#define IN_ROUTER 32
#define IN_MWG 33
#define IN_MWU 34
#define IN_MWD 35
#define IN_FINAL 36

#define GT_DECL const int tid = tid_(), lane = tid & 63; const int gt = blockIdx.x * NTHR + tid, NT = gridDim.x * NTHR; const int gw = gt >> 6, NW = NT >> 6; (void)lane; (void)gw; (void)NW; (void)gt; (void)NT;

__device__ __forceinline__ void ph_rms(const float* src, const float* gain, bf16_t* dst, int rows) {
    GT_DECL
    for (int r = gw; r < rows; r += NW) {
        const f32x4* x = (const f32x4*)(src + (size_t)r * D) + lane;
        f32x4 v[4]; float s = 0.f;
#pragma unroll
        for (int j = 0; j < 4; ++j) { v[j] = x[64 * j]; s += v[j].x * v[j].x + v[j].y * v[j].y + v[j].z * v[j].z + v[j].w * v[j].w; }
        const float rstd = rsqrtf(wave_sum(s) * (1.f / D) + EPS);
        u32x2* o = (u32x2*)(dst + (size_t)r * D) + lane; const f32x4* g = (const f32x4*)gain + lane;
#pragma unroll
        for (int j = 0; j < 4; ++j) { const f32x4 gg = g[64 * j]; o[64 * j] = (u32x2){pk_bf16(v[j].x * rstd * gg.x, v[j].y * rstd * gg.y), pk_bf16(v[j].z * rstd * gg.z, v[j].w * rstd * gg.w)}; }
    }
}

template <int MODE, bool CBF>
__device__ __forceinline__ void gemm_naive(LAS float* lds, const bf16_t* A, int lda, const int* rowidx,
                                           const float* B, const float* B2, int ldb, size_t bstride, const int* tile_exp,
                                           void* Cv, int ldc, const void* Rv, int ldr, int N, int K, int tm_lo, int tm_hi, int crow_off) {
    const int tid = tid_();
    LAS float* As = lds;
    LAS float* Bs = lds + 16 * 132;
    LAS float* B2s = Bs + 16 * 64;
    const int ntn = (N + 63) / 64, ntiles = (tm_hi - tm_lo) * ntn;
    const int ty = tid >> 4, tx = tid & 15;
    for (int tile = blockIdx.x; tile < ntiles; tile += gridDim.x) {
        const int tm = tm_lo + tile / ntn, tn = tile % ntn;
        const int row0 = tm * 128, n0 = tn * 64;
        const float* Bp = B; const float* B2p = B2;
        if (tile_exp) { const int e = tile_exp[row0 >> 8]; if (e < 0) continue; Bp = B + (size_t)e * bstride; if (MODE == 2) B2p = B2 + (size_t)e * bstride; }
        float acc[4][4], acc2[4][4];
#pragma unroll
        for (int i = 0; i < 4; ++i)
#pragma unroll
            for (int j = 0; j < 4; ++j) { acc[i][j] = 0.f; acc2[i][j] = 0.f; }
        const int ar = tid >> 2, ak = (tid & 3) * 4;
        const int arow = rowidx ? rowidx[row0 + ar] : (row0 + ar);
        const bf16_t* Ap = A + (size_t)arow * lda + ak;
        for (int k0 = 0; k0 < K; k0 += 16) {
            const u32x2 av = *(const u32x2*)(Ap + k0);
            As[(ak + 0) * 132 + ar] = bflo(av.x); As[(ak + 1) * 132 + ar] = bfhi(av.x); As[(ak + 2) * 132 + ar] = bflo(av.y); As[(ak + 3) * 132 + ar] = bfhi(av.y);
#pragma unroll
            for (int i = 0; i < 2; ++i) {
                const int e = tid + i * 512, kk = e >> 6, nn = e & 63, col = n0 + nn;
                Bs[kk * 64 + nn] = col < N ? Bp[(size_t)(k0 + kk) * ldb + col] : 0.f;
                if (MODE == 2) B2s[kk * 64 + nn] = col < N ? B2p[(size_t)(k0 + kk) * ldb + col] : 0.f;
            }
            __syncthreads();
#pragma unroll
            for (int kk = 0; kk < 16; ++kk) {
                const f32x4 a = *(const LAS f32x4*)(As + kk * 132 + ty * 4);
                const f32x4 b = *(const LAS f32x4*)(Bs + kk * 64 + tx * 4);
                const float aa[4] = {a.x, a.y, a.z, a.w}, bb[4] = {b.x, b.y, b.z, b.w};
#pragma unroll
                for (int i = 0; i < 4; ++i)
#pragma unroll
                    for (int j = 0; j < 4; ++j) acc[i][j] += aa[i] * bb[j];
                if (MODE == 2) {
                    const f32x4 b2 = *(const LAS f32x4*)(B2s + kk * 64 + tx * 4);
                    const float bb2[4] = {b2.x, b2.y, b2.z, b2.w};
#pragma unroll
                    for (int i = 0; i < 4; ++i)
#pragma unroll
                        for (int j = 0; j < 4; ++j) acc2[i][j] += aa[i] * bb2[j];
                }
            }
            __syncthreads();
        }
#pragma unroll
        for (int i = 0; i < 4; ++i) {
            const int row = row0 + ty * 4 + i;
#pragma unroll
            for (int j = 0; j < 4; ++j) {
                const int col = n0 + tx * 4 + j;
                if (col < N) {
                    float v = acc[i][j];
                    if (MODE == 1) v += ((const float*)Rv)[(size_t)row * ldr + col];
                    if (MODE == 2) v = v * sigmoidf_(v) * acc2[i][j];
                    if (MODE == 3) v = bf2f(((const bf16_t*)Rv)[(size_t)row * ldr + col]) * sigmoidf_(v);
                    if (CBF) ((bf16_t*)Cv)[(size_t)(row - crow_off) * ldc + col] = f2bf(v);
                    else ((float*)Cv)[(size_t)(row - crow_off) * ldc + col] = v;
                }
            }
        }
    }
}

namespace pg8 {
#define PG8_LAS __attribute__((address_space(3)))
typedef short bf16x8 __attribute__((ext_vector_type(8)));
constexpr int BM = 256, BK = 64, HALF = 128, HTB = HALF * BK * 2, STAGE_BYTES = 8 * HTB, NXCD = 8, WGM = 8;
__host__ __device__ __forceinline__ int lds_byte(int r, int c) { const int st = (r >> 4) * 2 + (c >> 5), rr = r & 15, cc = c & 31, ob = rr * 64 + cc * 2; return st * 1024 + (ob ^ (((ob >> 9) & 1) << 5)); }
__host__ __device__ __forceinline__ void stage_rc(int b, int& R, int& C) { const int st = b / 1024, sb = b % 1024, swz = sb ^ (((sb >> 9) & 1) << 5); R = (st >> 1) * 16 + swz / 64; C = (st & 1) * 32 + (swz % 64) / 2; }
__host__ __device__ __forceinline__ int perm32(int rho) { const int n = rho >> 4, i = rho & 15; return 8 * (i >> 2) + 4 * n + (i & 3); }

struct Unit { int pm, pn, ks; };
struct Gemm { const bf16_t* A; const bf16_t* Bt; int K; const int* rowidx; const int* texp; size_t estride; int ld; int nks; int nNr; };

struct StaticOrder {
    int nM, nN, nwg, G, c, pm0;
    __device__ void init(int nM_, int nN_, int G_, int c_, int pm0_) { nM = nM_; nN = nN_; nwg = nM * nN; G = G_; c = c_; pm0 = pm0_; }
    __device__ bool next(int i, Unit& u) const {
        const long L = (long)i * G + c; if (L >= nwg) return false;
        int wgid = (int)L; { const int q = nwg / NXCD, r = nwg % NXCD, xcd = wgid % NXCD, off = wgid / NXCD; wgid = (xcd < r ? xcd * (q + 1) : r * (q + 1) + (xcd - r) * q) + off; }
        const int nig = WGM * nN, gid = wgid / nig, fm = gid * WGM, gsz = (nM - fm) < WGM ? (nM - fm) : WGM;
        u.pm = pm0 + fm + ((wgid % nig) % gsz); u.pn = (wgid % nig) / gsz; return true;
    }
};

__device__ __forceinline__ float row_rstd(const float* ssq, int row) {
    const f32x4* q = (const f32x4*)(ssq + (size_t)row * 16); const f32x4 a = q[0], b = q[1], c = q[2], d = q[3];
    const float s = ((a.x + a.y) + (a.z + a.w)) + ((b.x + b.y) + (b.z + b.w)) + ((c.x + c.y) + (c.z + c.w)) + ((d.x + d.y) + (d.z + d.w));
    return rsqrtf(s * (1.f / 1024.f) + EPS);
}
struct EpiF32 {
    static constexpr bool PERM = false;
    float* C; int ldc; const float* ssq;
    __device__ __forceinline__ void operator()(const f32x4 (&acc)[2][2][4][2], const Unit& u, int wr, int wc, int fr, int fq) const {
        const int row0 = u.pm * BM + wr * 64 + fr, col0 = u.pn * BM + wc * 32 + 4 * fq;
#pragma unroll
        for (int ai = 0; ai < 2; ++ai)
#pragma unroll
            for (int m = 0; m < 4; ++m) { const int row = row0 + ai * HALF + m * 16; float* rowp = C + (size_t)row * ldc + col0;
                const float rs = ssq ? row_rstd(ssq, row) : 1.f;
#pragma unroll
                for (int bj = 0; bj < 2; ++bj)
#pragma unroll
                    for (int n = 0; n < 2; ++n) *(f32x4*)(rowp + bj * HALF + n * 16) = acc[ai][bj][m][n] * rs; }
    }
};
struct EpiF32Slab {
    static constexpr bool PERM = false;
    float* C; int ldc; size_t slab; int rsub;
    __device__ __forceinline__ void operator()(const f32x4 (&acc)[2][2][4][2], const Unit& u, int wr, int wc, int fr, int fq) const {
        const int row0 = u.pm * BM - rsub + wr * 64 + fr, col0 = u.pn * BM + wc * 32 + 4 * fq;
        float* Cs = C + (size_t)u.ks * slab;
#pragma unroll
        for (int ai = 0; ai < 2; ++ai)
#pragma unroll
            for (int m = 0; m < 4; ++m) { float* rowp = Cs + (size_t)(row0 + ai * HALF + m * 16) * ldc + col0;
#pragma unroll
                for (int bj = 0; bj < 2; ++bj)
#pragma unroll
                    for (int n = 0; n < 2; ++n) *(f32x4*)(rowp + bj * HALF + n * 16) = acc[ai][bj][m][n]; }
    }
};
struct EpiProj {
    static constexpr bool PERM = false;
    float* C; int ldc; bf16_t* NK; const float* ssq; bf16_t* NQ;
    __device__ __forceinline__ void operator()(const f32x4 (&acc)[2][2][4][2], const Unit& u, int wr, int wc, int fr, int fq) const {
        const int row0 = u.pm * BM + wr * 64 + fr, col0 = u.pn * BM + wc * 32 + 4 * fq;
#pragma unroll
        for (int ai = 0; ai < 2; ++ai)
#pragma unroll
            for (int m = 0; m < 4; ++m) { const int row = row0 + ai * HALF + m * 16; float* rowp = C + (size_t)row * ldc + col0;
                const float rs = ssq ? row_rstd(ssq, row) : 1.f;
#pragma unroll
                for (int bj = 0; bj < 2; ++bj)
#pragma unroll
                    for (int n = 0; n < 2; ++n) { const f32x4 v = acc[ai][bj][m][n] * rs; const int col = col0 + bj * HALF + n * 16;
                        if (col >= 992 && col < 1760) *(u32x2*)(NK + (size_t)row * 768 + (col - 992)) = (u32x2){pk_bf16(v[0], v[1]), pk_bf16(v[2], v[3])};
                        else if (col >= 608 && col < 992) *(u32x2*)(NQ + (size_t)row * 384 + (col - 608)) = (u32x2){pk_bf16(v[0], v[1]), pk_bf16(v[2], v[3])};
                        else *(f32x4*)(rowp + bj * HALF + n * 16) = v; } }
    }
};
struct EpiResF32 {
    static constexpr bool PERM = false;
    float* C; const float* R; int ld;
    __device__ __forceinline__ void operator()(const f32x4 (&acc)[2][2][4][2], const Unit& u, int wr, int wc, int fr, int fq) const {
        const int row0 = u.pm * BM + wr * 64 + fr, col0 = u.pn * BM + wc * 32 + 4 * fq;
#pragma unroll
        for (int ai = 0; ai < 2; ++ai)
#pragma unroll
            for (int m = 0; m < 4; ++m) { const size_t ro = (size_t)(row0 + ai * HALF + m * 16) * ld + col0;
                f32x4 rv[2][2];
#pragma unroll
                for (int bj = 0; bj < 2; ++bj)
#pragma unroll
                    for (int n = 0; n < 2; ++n) rv[bj][n] = *(const f32x4*)(R + ro + bj * HALF + n * 16);
#pragma unroll
                for (int bj = 0; bj < 2; ++bj)
#pragma unroll
                    for (int n = 0; n < 2; ++n) *(f32x4*)(C + ro + bj * HALF + n * 16) = rv[bj][n] + acc[ai][bj][m][n]; }
    }
};
struct EpiResNorm {
    static constexpr bool PERM = false;
    bf16_t* HB; const float* Rf; int ld; float* ssq;
    __device__ __forceinline__ void operator()(const f32x4 (&acc)[2][2][4][2], const Unit& u, int wr, int wc, int fr, int fq) const {
        const int row0 = u.pm * BM + wr * 64 + fr, col0 = u.pn * BM + wc * 32 + 4 * fq;
#pragma unroll
        for (int ai = 0; ai < 2; ++ai)
#pragma unroll
            for (int m = 0; m < 4; ++m) { const int row = row0 + ai * HALF + m * 16; const size_t ro = (size_t)row * ld + col0;
                f32x4 rv[2][2];
#pragma unroll
                for (int bj = 0; bj < 2; ++bj)
#pragma unroll
                    for (int n = 0; n < 2; ++n) {
                        if (Rf) rv[bj][n] = *(const f32x4*)(Rf + ro + bj * HALF + n * 16);
                        else { const u32x2 hb = *(const u32x2*)(HB + ro + bj * HALF + n * 16); rv[bj][n] = (f32x4){bflo(hb.x), bfhi(hb.x), bflo(hb.y), bfhi(hb.y)}; } }
                float sq = 0.f;
#pragma unroll
                for (int bj = 0; bj < 2; ++bj)
#pragma unroll
                    for (int n = 0; n < 2; ++n) { const f32x4 v = rv[bj][n] + acc[ai][bj][m][n];
                        *(u32x2*)(HB + ro + bj * HALF + n * 16) = (u32x2){pk_bf16(v[0], v[1]), pk_bf16(v[2], v[3])};
                        sq += (v[0] * v[0] + v[1] * v[1]) + (v[2] * v[2] + v[3] * v[3]); }
                if (ssq) { sq += __shfl_xor(sq, 16); sq += __shfl_xor(sq, 32);
                    if (fq == 0) ssq[(size_t)row * 16 + u.pn * 4 + wc] = sq; } }
    }
};
struct EpiGlu {
    static constexpr bool PERM = false;
    float* Y; int ldy; const bf16_t* R;
    __device__ __forceinline__ void operator()(const f32x4 (&acc)[2][2][4][2], const Unit& u, int wr, int wc, int fr, int fq) const {
        const int row0 = u.pm * BM + wr * 64 + fr, col0 = u.pn * BM + wc * 32 + 4 * fq;
#pragma unroll
        for (int ai = 0; ai < 2; ++ai)
#pragma unroll
            for (int m = 0; m < 4; ++m) { const int row = row0 + ai * HALF + m * 16;
#pragma unroll
                for (int bj = 0; bj < 2; ++bj)
#pragma unroll
                    for (int n = 0; n < 2; ++n) { const int col = col0 + bj * HALF + n * 16;
                        const u32x2 r2 = *(const u32x2*)(R + (size_t)row * 256 + col); const f32x4 a = acc[ai][bj][m][n];
                        *(f32x4*)(Y + (size_t)row * ldy + col) = (f32x4){bflo(r2.x) * sigmoidf_(a[0]), bfhi(r2.x) * sigmoidf_(a[1]), bflo(r2.y) * sigmoidf_(a[2]), bfhi(r2.y) * sigmoidf_(a[3])}; } }
    }
};
struct EpiSwiglu {
    static constexpr bool PERM = true;
    bf16_t* O; int ldo; int rsub; const float* ssq;
    __device__ __forceinline__ void operator()(const f32x4 (&acc)[2][2][4][2], const Unit& u, int wr, int wc, int fr, int fq) const {
        const int row0 = u.pm * BM - rsub + wr * 64 + fr, col0 = u.pn * HALF + wc * 32 + 8 * fq;
#pragma unroll
        for (int ai = 0; ai < 2; ++ai)
#pragma unroll
            for (int m = 0; m < 4; ++m) { bf16_t* rowp = O + (size_t)(row0 + ai * HALF + m * 16) * ldo + col0;
                const float rs = ssq ? row_rstd(ssq, u.pm * BM + wr * 64 + fr + ai * HALF + m * 16) : 1.f;
                const f32x4 g0 = acc[ai][0][m][0] * rs, g1 = acc[ai][0][m][1] * rs, u0 = acc[ai][1][m][0] * rs, u1 = acc[ai][1][m][1] * rs;
                u32x4 w;
                w.x = pk_bf16(g0[0] * sigmoidf_(g0[0]) * u0[0], g0[1] * sigmoidf_(g0[1]) * u0[1]); w.y = pk_bf16(g0[2] * sigmoidf_(g0[2]) * u0[2], g0[3] * sigmoidf_(g0[3]) * u0[3]);
                w.z = pk_bf16(g1[0] * sigmoidf_(g1[0]) * u1[0], g1[1] * sigmoidf_(g1[1]) * u1[1]); w.w = pk_bf16(g1[2] * sigmoidf_(g1[2]) * u1[2], g1[3] * sigmoidf_(g1[3]) * u1[3]);
                *(u32x4*)rowp = w; }
    }
};
struct EpiBf16 {
    static constexpr bool PERM = true;
    bf16_t* O; int ldo; const float* ssq;
    __device__ __forceinline__ void operator()(const f32x4 (&acc)[2][2][4][2], const Unit& u, int wr, int wc, int fr, int fq) const {
        const int row0 = u.pm * BM + wr * 64 + fr, col0 = u.pn * BM + wc * 32 + 8 * fq;
#pragma unroll
        for (int ai = 0; ai < 2; ++ai)
#pragma unroll
            for (int m = 0; m < 4; ++m) { const int row = row0 + ai * HALF + m * 16; bf16_t* rowp = O + (size_t)row * ldo + col0;
                const float rs = ssq ? row_rstd(ssq, row) : 1.f;
#pragma unroll
                for (int bj = 0; bj < 2; ++bj) { const f32x4 v0 = acc[ai][bj][m][0] * rs, v1 = acc[ai][bj][m][1] * rs;
                    u32x4 w; w.x = pk_bf16(v0[0], v0[1]); w.y = pk_bf16(v0[2], v0[3]); w.z = pk_bf16(v1[0], v1[1]); w.w = pk_bf16(v1[2], v1[3]);
                    *(u32x4*)(rowp + bj * HALF) = w; } }
    }
};

template <class Epi, bool GATHER>
__device__ __forceinline__ void gemm_phase(PG8_LAS unsigned char* lds, const Gemm g, const StaticOrder& S, const Epi& E) {
    const int tid = tid_(), wid = __builtin_amdgcn_readfirstlane(tid >> 6), lane = tid & 63, wr = wid >> 2, wc = wid & 3, fr = lane & 15, fq = lane >> 4;
    const int K = g.ld ? g.ld : g.K, nt = g.K / BK;
    unsigned voffA[2], voffB[2]; int sR[2], sC[2];
#pragma unroll
    for (int i = 0; i < 2; ++i) { int R, C; stage_rc(tid * 16 + i * 8192, R, C); const int Rb = Epi::PERM ? ((R & ~31) + perm32(R & 31)) : R; sR[i] = R; sC[i] = C;
        voffA[i] = (unsigned)(R * K + C) * 2u; voffB[i] = (unsigned)(Rb * K + C) * 2u; }
    const size_t kstep = (size_t)(BK * 2);
    const size_t hstep = (size_t)HALF * K * 2;
    const size_t sstep = (size_t)g.K * 2;
    const size_t tstep = 2 * hstep;
    const unsigned ldsw = (unsigned)wid * 1024u;
    const int aoff = lds_byte(wr * 64 + fr, fq * 8), boff = lds_byte(wc * 32 + fr, fq * 8);
#define PG8_SA(b, h) (((b) * 2 + (h)) * HTB)
#define PG8_SB(b, h) ((4 + (b) * 2 + (h)) * HTB)
#define PG8_STAGE(bufoff, gbase, voff) do { _Pragma("unroll") for (int _i = 0; _i < 2; ++_i) \
        __builtin_amdgcn_global_load_lds((const unsigned*)((const char*)(gbase) + (voff)[_i]), (PG8_LAS unsigned*)(lds + (bufoff) + ldsw + _i * 8192), 16, 0, 0); } while (0)
#define PG8_LDA(dst, b, h) do { _Pragma("unroll") for (int m = 0; m < 4; ++m) _Pragma("unroll") for (int k = 0; k < 2; ++k) dst[m][k] = *(const PG8_LAS bf16x8*)(lds + PG8_SA(b, h) + aoff + m * 2048 + k * 1024); } while (0)
#define PG8_LDB(dst, b, h) do { _Pragma("unroll") for (int n = 0; n < 2; ++n) _Pragma("unroll") for (int k = 0; k < 2; ++k) dst[n][k] = *(const PG8_LAS bf16x8*)(lds + PG8_SB(b, h) + boff + n * 2048 + k * 1024); } while (0)
#define PG8_MMA(ai, bj, At, Bt) do { __builtin_amdgcn_s_setprio(1); _Pragma("unroll") for (int m = 0; m < 4; ++m) _Pragma("unroll") for (int n = 0; n < 2; ++n) _Pragma("unroll") for (int k = 0; k < 2; ++k) \
        acc[ai][bj][m][n] = __builtin_amdgcn_mfma_f32_16x16x32_bf16(Bt[n][k], At[m][k], acc[ai][bj][m][n], 0, 0, 0); __builtin_amdgcn_s_setprio(0); } while (0)
#define PG8_WAIT_V(n) asm volatile("s_waitcnt vmcnt(" #n ")" ::: "memory")
#define PG8_WAIT_L(n) asm volatile("s_waitcnt lgkmcnt(" #n ")" ::: "memory")
#define PG8_BAR __builtin_amdgcn_s_barrier()
#define PG8_SCHED __builtin_amdgcn_sched_barrier(0)
#define PG8_GOFF(v, u) do { _Pragma("unroll") for (int _h = 0; _h < 2; ++_h) _Pragma("unroll") for (int _i = 0; _i < 2; ++_i) \
        v[_h][_i] = (unsigned)(g.rowidx[(u).pm * BM + _h * HALF + sR[_i]] * K + sC[_i]) * 2u; } while (0)
    Unit cur, nxt; int ui = 0;
    if (!S.next(0, cur)) return;
    cur.ks = 0; if (g.nks > 1) { cur.ks = cur.pn / g.nNr; cur.pn -= cur.ks * g.nNr; }
    f32x4 acc[2][2][4][2];
#pragma unroll
    for (int a = 0; a < 2; ++a)
#pragma unroll
        for (int b = 0; b < 2; ++b)
#pragma unroll
            for (int m = 0; m < 4; ++m)
#pragma unroll
                for (int n = 0; n < 2; ++n) acc[a][b][m][n] = (f32x4){0.f, 0.f, 0.f, 0.f};
    bf16x8 At[4][2], B0[2][2], B1[2][2];
    unsigned vAc[2][2], vAn[2][2];
    if constexpr (GATHER) { PG8_GOFF(vAc, cur); }
    const char* gA = (const char*)g.A;
    const char* cA = gA + (GATHER ? (size_t)0 : (size_t)cur.pm * tstep + (size_t)cur.ks * sstep);
    const char* cB = (const char*)g.Bt + (size_t)cur.pn * tstep + (size_t)cur.ks * sstep + (g.texp ? (size_t)g.texp[cur.pm] * g.estride * 2 : (size_t)0);
    PG8_STAGE(PG8_SB(0, 0), cB, voffB); PG8_STAGE(PG8_SB(0, 1), cB + hstep, voffB);
    if constexpr (GATHER) { PG8_STAGE(PG8_SA(0, 0), gA, vAc[0]); PG8_STAGE(PG8_SA(0, 1), gA, vAc[1]); }
    else { PG8_STAGE(PG8_SA(0, 0), cA, voffA); PG8_STAGE(PG8_SA(0, 1), cA + hstep, voffA); }
    if (wr == 1) PG8_BAR;
    PG8_WAIT_V(2); PG8_BAR;
    PG8_STAGE(PG8_SB(1, 0), cB + kstep, voffB);
    if constexpr (GATHER) { PG8_STAGE(PG8_SA(1, 0), gA + kstep, vAc[0]); } else { PG8_STAGE(PG8_SA(1, 0), cA + kstep, voffA); }
    PG8_STAGE(PG8_SB(1, 1), cB + hstep + kstep, voffB);
    PG8_WAIT_V(6); PG8_BAR;
    for (;;) {
        const bool has_next = S.next(ui + 1, nxt);
        nxt.ks = 0; if (has_next && g.nks > 1) { nxt.ks = nxt.pn / g.nNr; nxt.pn -= nxt.ks * g.nNr; }
        const char* nA = (has_next && !GATHER) ? gA + (size_t)nxt.pm * tstep + (size_t)nxt.ks * sstep : cA;
        const char* nB = has_next ? (const char*)g.Bt + (size_t)nxt.pn * tstep + (size_t)nxt.ks * sstep + (g.texp ? (size_t)g.texp[nxt.pm] * g.estride * 2 : (size_t)0) : cB;
        if constexpr (GATHER) { if (has_next) { PG8_GOFF(vAn, nxt); } else {
#pragma unroll
            for (int h = 0; h < 2; ++h)
#pragma unroll
                for (int i = 0; i < 2; ++i) vAn[h][i] = vAc[h][i]; } }
        for (int t = 0; t < nt; t += 2) {
            const bool last = (t == nt - 2);
            const char* a1 = cA + (size_t)(t + 1) * kstep;
            const char* a2 = last ? nA : cA + (size_t)(t + 2) * kstep; const char* b2 = last ? nB : cB + (size_t)(t + 2) * kstep;
            const char* a3 = a2 + kstep; const char* b3 = b2 + kstep;
            unsigned v2[2][2];
            if constexpr (GATHER) {
#pragma unroll
                for (int h = 0; h < 2; ++h)
#pragma unroll
                    for (int i = 0; i < 2; ++i) v2[h][i] = last ? vAn[h][i] : vAc[h][i]; }
#define PG8_STA1(buf) do { if constexpr (GATHER) { PG8_STAGE(buf, a1, vAc[1]); } else { PG8_STAGE(buf, a1 + hstep, voffA); } } while (0)
#define PG8_STA2(buf, h) do { if constexpr (GATHER) { PG8_STAGE(buf, a2, v2[h]); } else { PG8_STAGE(buf, a2 + (h) * hstep, voffA); } } while (0)
#define PG8_STA3(buf) do { if constexpr (GATHER) { PG8_STAGE(buf, a3, v2[0]); } else { PG8_STAGE(buf, a3, voffA); } } while (0)
            PG8_LDB(B0, 0, 0); PG8_LDB(B1, 0, 1); PG8_SCHED; PG8_LDA(At, 0, 0); PG8_STA1(PG8_SA(1, 1));
            PG8_WAIT_V(8); PG8_WAIT_L(0); PG8_BAR; PG8_MMA(0, 0, At, B0); PG8_MMA(0, 1, At, B1); PG8_BAR; PG8_SCHED;
            PG8_LDA(At, 0, 1); PG8_STAGE(PG8_SB(0, 0), b2, voffB); PG8_STAGE(PG8_SB(0, 1), b2 + hstep, voffB); PG8_STA2(PG8_SA(0, 0), 0);
            PG8_WAIT_V(8); PG8_WAIT_L(0); PG8_BAR; PG8_MMA(1, 0, At, B0); PG8_MMA(1, 1, At, B1); PG8_BAR; PG8_SCHED;
            PG8_LDB(B0, 1, 0); PG8_LDB(B1, 1, 1); PG8_SCHED; PG8_LDA(At, 1, 0); PG8_STA2(PG8_SA(0, 1), 1);
            PG8_WAIT_V(8); PG8_WAIT_L(0); PG8_BAR; PG8_MMA(0, 0, At, B0); PG8_MMA(0, 1, At, B1); PG8_BAR; PG8_SCHED;
            PG8_LDA(At, 1, 1); PG8_STAGE(PG8_SB(1, 0), b3, voffB); PG8_STAGE(PG8_SB(1, 1), b3 + hstep, voffB); PG8_STA3(PG8_SA(1, 0));
            PG8_WAIT_V(8); PG8_WAIT_L(0); PG8_BAR; PG8_MMA(1, 0, At, B0); PG8_MMA(1, 1, At, B1); PG8_BAR; PG8_SCHED;
        }
        if (wr == 0) PG8_BAR;
        E(acc, cur, wr, wc, fr, fq);
        if (!has_next) break;
#pragma unroll
        for (int a = 0; a < 2; ++a)
#pragma unroll
            for (int b = 0; b < 2; ++b)
#pragma unroll
                for (int m = 0; m < 4; ++m)
#pragma unroll
                    for (int n = 0; n < 2; ++n) acc[a][b][m][n] = (f32x4){0.f, 0.f, 0.f, 0.f};
        cur = nxt; cA = nA; cB = nB; ++ui;
        if constexpr (GATHER) {
#pragma unroll
            for (int h = 0; h < 2; ++h)
#pragma unroll
                for (int i = 0; i < 2; ++i) vAc[h][i] = vAn[h][i]; }
        if (wr == 1) PG8_BAR;
    }
    PG8_WAIT_V(0);
    PG8_BAR;
#undef PG8_SA
#undef PG8_SB
#undef PG8_STAGE
#undef PG8_LDA
#undef PG8_LDB
#undef PG8_MMA
#undef PG8_WAIT_V
#undef PG8_WAIT_L
#undef PG8_BAR
#undef PG8_SCHED
#undef PG8_GOFF
#undef PG8_STA1
#undef PG8_STA2
#undef PG8_STA3
}
}

struct CvtCursor { int base; };
template <bool VEC4>
__device__ __forceinline__ void cvt_matrix(CvtCursor& cur, const float* W, int K, int N, bf16_t* WT, int Kpad, int Npad, int mode, LAS float* scr, int gw, int NW, int lane, const float* kgain = nullptr) {
    const int nkb = Kpad / 64, nnb = Npad / 32, nitems = nkb * nnb;
    int first = (gw - cur.base % NW + NW) % NW;
    cur.base += nitems;
    for (int it = first; it < nitems; it += NW) {
        const int kb = it / nnb, nb = it % nnb, k0 = kb * 64, n0 = nb * 32;
        const int drow0 = mode == 0 ? n0 : (((n0 >> 7) << 8) + (n0 & 127) + (mode == 2 ? 128 : 0));
        if (VEC4) {
            const bool inr = (k0 < K) && (n0 < N);
#pragma unroll
            for (int i = 0; i < 8; ++i) {
                const int kk = i * 8 + (lane >> 3), nn = (lane & 7) * 4;
                f32x4 v = {0.f, 0.f, 0.f, 0.f};
                if (inr) { v = *(const f32x4*)(W + (size_t)(k0 + kk) * N + n0 + nn); if (kgain) v = v * kgain[k0 + kk]; }
                scr[kk * 33 + nn] = v.x; scr[kk * 33 + nn + 1] = v.y; scr[kk * 33 + nn + 2] = v.z; scr[kk * 33 + nn + 3] = v.w;
            }
        } else {
#pragma unroll 8
            for (int i = 0; i < 32; ++i) { const int kk = 2 * i + (lane >> 5), n = n0 + (lane & 31);
                scr[kk * 33 + (lane & 31)] = (k0 + kk < K && n < N) ? W[(size_t)(k0 + kk) * N + n] * (kgain ? kgain[k0 + kk] : 1.f) : 0.f; }
        }
        asm volatile("s_waitcnt lgkmcnt(0)" ::: "memory");
        const int c = lane & 7;
#pragma unroll
        for (int j = 0; j < 4; ++j) { const int n = (lane >> 3) + 8 * j; const LAS float* sp = scr + (8 * c) * 33 + n;
            u32x4 o; o.x = pk_bf16(sp[0 * 33], sp[1 * 33]); o.y = pk_bf16(sp[2 * 33], sp[3 * 33]); o.z = pk_bf16(sp[4 * 33], sp[5 * 33]); o.w = pk_bf16(sp[6 * 33], sp[7 * 33]);
            *(u32x4*)(WT + (size_t)(drow0 + n) * Kpad + k0 + 8 * c) = o; }
        asm volatile("s_waitcnt lgkmcnt(0)" ::: "memory");
    }
}

__device__ __forceinline__ void ph_rope_table(float* tab) {
    GT_DECL
    for (int i = gt; i < SEQ * 16; i += NT) {
        const int s = i >> 4, k = i & 15;
        const double inv = exp10(-0.25 * (double)k);
        float sn, cs; sincos_d((double)s * inv, sn, cs);
        tab[i] = cs; tab[SEQ * 16 + i] = sn;
    }
}

__device__ __forceinline__ void ph_mla_prep(const float* proj, const float* qn_g, const float* kvn_g, const float* rope, bf16_t* cqn, bf16_t* ckvn, bf16_t* krope) {
    GT_DECL
    const bool qa = lane < 48, ka = lane < 32;
    const f32x4 gq = qa ? *(const f32x4*)(qn_g + lane * 4) : (f32x4){0.f, 0.f, 0.f, 0.f};
    const f32x4 gk = ka ? *(const f32x4*)(kvn_g + lane * 4) : (f32x4){0.f, 0.f, 0.f, 0.f};
    for (int t = gw; t < T; t += NW) {
        const float* pr = proj + (size_t)t * INLD;
        const f32x4 a = qa ? *(const f32x4*)(pr + O_CQ + lane * 4) : (f32x4){0.f, 0.f, 0.f, 0.f};
        const f32x4 b = ka ? *(const f32x4*)(pr + O_CKV + lane * 4) : (f32x4){0.f, 0.f, 0.f, 0.f};
        float x1 = 0.f, x2 = 0.f, c = 0.f, sn = 0.f;
        if (lane < 16) { const int s = t & (SEQ - 1); c = rope[s * 16 + lane]; sn = rope[SEQ * 16 + s * 16 + lane]; x1 = pr[O_KR + lane]; x2 = pr[O_KR + 16 + lane]; }
        const float rs = rsqrtf(wave_sum((a.x * a.x + a.y * a.y) + (a.z * a.z + a.w * a.w)) * (1.f / 192.f) + EPS);
        const float rs2 = rsqrtf(wave_sum((b.x * b.x + b.y * b.y) + (b.z * b.z + b.w * b.w)) * (1.f / 128.f) + EPS);
        *(u32x2*)(cqn + (size_t)t * 256 + lane * 4) = (u32x2){pk_bf16(a.x * rs * gq.x, a.y * rs * gq.y), pk_bf16(a.z * rs * gq.z, a.w * rs * gq.w)};
        *(u32x2*)(ckvn + (size_t)t * 256 + lane * 4) = (u32x2){pk_bf16(b.x * rs2 * gk.x, b.y * rs2 * gk.y), pk_bf16(b.z * rs2 * gk.z, b.w * rs2 * gk.w)};
        if (lane < 16) { krope[(size_t)t * 32 + lane] = f2bf(x1 * c - x2 * sn); krope[(size_t)t * 32 + 16 + lane] = f2bf(x2 * c + x1 * sn); }
    }
}

struct SsmConst { float ab_r, ab_i, bb_r[16], bb_i[16]; double ang; float lrdt; };
__device__ __forceinline__ void ssm_consts(const Params& p, int l, int g, int lane, SsmConst& c) {
    const float dt = expf(p.in[IN_SLDT][l * 16 + g]);
    const float lr = p.in[IN_SARE][(l * 16 + g) * 64 + lane], li = p.in[IN_SAIM][(l * 16 + g) * 64 + lane];
    const float mag = expf(lr * dt);
    float sn, cs; sincos_d((double)li * (double)dt, sn, cs);
    c.ab_r = mag * cs; c.ab_i = mag * sn; c.ang = (double)li * (double)dt; c.lrdt = lr * dt;
    const float den = lr * lr + li * li, nr = c.ab_r - 1.f;
    const float f_r = (nr * lr + c.ab_i * li) / den, f_i = (c.ab_i * lr - nr * li) / den;
    const float* bre = p.in[IN_SBRE] + ((size_t)(l * 16 + g) * 64 + lane) * 16;
    const float* bim = p.in[IN_SBIM] + ((size_t)(l * 16 + g) * 64 + lane) * 16;
#pragma unroll
    for (int k4 = 0; k4 < 4; ++k4) { const f32x4 br4 = *(const f32x4*)(bre + 4 * k4), bi4 = *(const f32x4*)(bim + 4 * k4);
        const float brr[4] = {br4.x, br4.y, br4.z, br4.w}, bii[4] = {bi4.x, bi4.y, bi4.z, bi4.w};
#pragma unroll
        for (int q = 0; q < 4; ++q) { c.bb_r[4 * k4 + q] = f_r * brr[q] - f_i * bii[q]; c.bb_i[4 * k4 + q] = f_r * bii[q] + f_i * brr[q]; } }
}
__device__ __forceinline__ void ph_ssm1(const Params& p, int l, const float* proj, f32x2* E, LAS unsigned char* lds) {
    GT_DECL
    LAS float* ut = (LAS float*)(lds + (tid >> 6) * 16384 + 9216);
    const int nblk = (int)gridDim.x, half_w = (nblk / 2) * (NTHR / 64);
    const bool even_split = (nblk & 1) || (NB * 32 * 16 != 4 * half_w);
    const int wv = gw;
    const int my_first = even_split ? wv : (wv < half_w ? wv : half_w + (wv - half_w) * 3);
    const int my_count = even_split ? 0 : (wv < half_w ? 1 : 3);
    for (int it = 0; even_split ? (my_first + it * NW < NB * 32 * 16) : (it < my_count); ++it) {
        const int w = even_split ? my_first + it * NW : my_first + it;
        const int g = w & 15, k = (w >> 4) & 31, b = w >> 9;
        const float* up = proj + (size_t)(b * SEQ + k * 64) * INLD + O_U + g * 16;
        {
            const f32x4* ur = (const f32x4*)(up + (size_t)lane * INLD);
            const f32x4 u0 = ur[0], u1 = ur[1], u2 = ur[2], u3 = ur[3];
            LAS f32x4* ud = (LAS f32x4*)(ut + lane * 16);
            ud[0] = u0; ud[1] = u1; ud[2] = u2; ud[3] = u3;
        }
        SsmConst c; ssm_consts(p, l, g, lane, c);
        float hr = 0.f, hi = 0.f;
        asm volatile("s_waitcnt lgkmcnt(0)" ::: "memory");
        for (int j = 0; j < 64; ++j) {
            float br = 0.f, bi = 0.f;
            const LAS f32x4* uj4 = (const LAS f32x4*)(ut + j * 16);
            const f32x4 ua = uj4[0], ub = uj4[1], uc = uj4[2], ud4 = uj4[3];
            const float uu[16] = {ua.x, ua.y, ua.z, ua.w, ub.x, ub.y, ub.z, ub.w, uc.x, uc.y, uc.z, uc.w, ud4.x, ud4.y, ud4.z, ud4.w};
#pragma unroll
            for (int q = 0; q < 16; ++q) { const float u = uu[q]; br += u * c.bb_r[q]; bi += u * c.bb_i[q]; }
            const float nr = c.ab_r * hr - c.ab_i * hi + br, ni = c.ab_r * hi + c.ab_i * hr + bi;
            hr = nr; hi = ni;
        }
        E[(size_t)w * 64 + lane] = (f32x2){hr, hi};
    }
}
__device__ __forceinline__ void ph_ssm2(const Params& p, int l, const float* proj, const f32x2* E, bf16_t* ypre, LAS unsigned char* lds) {
    GT_DECL
    constexpr int HSTR = 272;
    LAS unsigned char* hb = lds + (tid >> 6) * 16384;
    LAS float* ut = (LAS float*)(lds + (tid >> 6) * 16384 + 9216);
    LAS bf16_t* yt = (LAS bf16_t*)(lds + (tid >> 6) * 16384 + 13312);
    const int fr = lane & 15, fq = lane >> 4;
    for (int w = gw; w < NB * 32 * 16; w += NW) {
        const int g = w & 15, k = (w >> 4) & 31, b = w >> 9;
        SsmConst c; ssm_consts(p, l, g, lane, c);
        float l64r, l64i; { float sn, cs; sincos_d(c.ang * 64.0, sn, cs); const float m = expf(64.f * c.lrdt); l64r = m * cs; l64i = m * sn; }
        float hr = 0.f, hi = 0.f;
        for (int kk0 = 0; kk0 < k; kk0 += 8) {
            f32x2 ev[8];
#pragma unroll
            for (int q = 0; q < 8; ++q) { const int kk = kk0 + q < k ? kk0 + q : k - 1; ev[q] = E[(size_t)(((b * 32 + kk) * 16) + g) * 64 + lane]; }
#pragma unroll
            for (int q = 0; q < 8; ++q) if (kk0 + q < k) {
                const float nr = l64r * hr - l64i * hi + ev[q].x, ni = l64r * hi + l64i * hr + ev[q].y;
                hr = nr; hi = ni;
            }
        }
        bf16x8_t cb[4];
        {
            const float* cre = p.in[IN_SCRE] + ((size_t)(l * 16 + g) * 16 + fr) * 64;
            const float* cim = p.in[IN_SCIM] + ((size_t)(l * 16 + g) * 16 + fr) * 64;
#pragma unroll
            for (int s = 0; s < 4; ++s) {
                const f32x4 vr = *(const f32x4*)(cre + 16 * s + 4 * fq), vi = *(const f32x4*)(cim + 16 * s + 4 * fq);
                cb[s] = pack8f(vr.x, -vi.x, vr.y, -vi.y, vr.z, -vi.z, vr.w, -vi.w);
            }
        }
        const float dd = p.in[IN_SD][l * 256 + g * 16 + fr];
        const float* up = proj + (size_t)(b * SEQ + k * 64) * INLD + O_U + g * 16;
        {
            const f32x4* ur = (const f32x4*)(up + (size_t)lane * INLD);
            const f32x4 u0 = ur[0], u1 = ur[1], u2 = ur[2], u3 = ur[3];
            LAS f32x4* ud = (LAS f32x4*)(ut + lane * 16);
            ud[0] = u0; ud[1] = u1; ud[2] = u2; ud[3] = u3;
        }
        asm volatile("s_waitcnt lgkmcnt(0)" ::: "memory");
        for (int half = 0; half < 2; ++half) {
            for (int j = 0; j < 32; ++j) {
                float br = 0.f, bi = 0.f;
                const LAS f32x4* uj4 = (const LAS f32x4*)(ut + (half * 32 + j) * 16);
                const f32x4 ua = uj4[0], ub = uj4[1], uc = uj4[2], ud4 = uj4[3];
                const float uu[16] = {ua.x, ua.y, ua.z, ua.w, ub.x, ub.y, ub.z, ub.w, uc.x, uc.y, uc.z, uc.w, ud4.x, ud4.y, ud4.z, ud4.w};
#pragma unroll
                for (int q = 0; q < 16; ++q) { const float u = uu[q]; br += u * c.bb_r[q]; bi += u * c.bb_i[q]; }
                const float nr = c.ab_r * hr - c.ab_i * hi + br, ni = c.ab_r * hi + c.ab_i * hr + bi;
                hr = nr; hi = ni;
                *(LAS unsigned*)(hb + j * HSTR + lane * 4) = pk_bf16(hr, hi);
            }
            asm volatile("s_waitcnt lgkmcnt(0)" ::: "memory");
#pragma unroll
            for (int mt = 0; mt < 2; ++mt) {
                f32x4 acc = {0.f, 0.f, 0.f, 0.f};
#pragma unroll
                for (int s = 0; s < 4; ++s) {
                    const bf16x8_t a = *(const LAS bf16x8_t*)(hb + (16 * mt + fr) * HSTR + (32 * s + 8 * fq) * 2);
                    acc = __builtin_amdgcn_mfma_f32_16x16x32_bf16(a, cb[s], acc, 0, 0, 0);
                }
#pragma unroll
                for (int rg = 0; rg < 4; ++rg) {
                    const int step = half * 32 + 16 * mt + 4 * fq + rg;
                    const float u = ut[step * 16 + fr];
                    yt[step * 16 + fr] = f2bf(gelu_tanh(acc[rg] + dd * u));
                }
            }
            asm volatile("s_waitcnt lgkmcnt(0)" ::: "memory");
        }
        {
            const LAS u32x4* yr = (const LAS u32x4*)(yt + lane * 16);
            const u32x4 y0 = yr[0], y1 = yr[1];
            u32x4* yo = (u32x4*)(ypre + (size_t)(b * SEQ + k * 64 + lane) * 256 + g * 16);
            yo[0] = y0; yo[1] = y1;
        }
        asm volatile("s_waitcnt lgkmcnt(0)" ::: "memory");
    }
}

__device__ __forceinline__ void ph_cmp1(const Params& p, int l, const float* proj, float* hid) {
    GT_DECL
    const int total = 2 * NB * NBC * 2 * 64;
    for (int i = gt; i < total; i += NT) {
        const int c = i & 63, row = (i >> 6) % (NB * NBC * 2), j = (i >> 6) / (NB * NBC * 2);
        const int g = row & 1, n = (row >> 1) % NBC, b = (row >> 1) / NBC;
        const float* w1 = p.in[IN_NW1] + (size_t)(l * 2 + j) * 2048 * 64;
        const float* pe = p.in[IN_NPE] + (size_t)(l * 2 + j) * 32 * 64;
        float acc = 0.f;
        for (int pos = 0; pos < 32; ++pos) {
            const float* kv = proj + (size_t)(b * SEQ + n * 16 + pos) * INLD + O_NKV + j * 128 + g * 64;
            for (int d = 0; d < 64; ++d) acc += (kv[d] + pe[pos * 64 + d]) * w1[(size_t)(pos * 64 + d) * 64 + c];
        }
        hid[i] = gelu_tanh(acc);
    }
}
__device__ __forceinline__ void ph_cmp2(const Params& p, int l, const float* hid, float* kc) {
    GT_DECL
    const int total = 2 * NB * NBC * 2 * 64;
    for (int i = gt; i < total; i += NT) {
        const int c = i & 63, j = (i >> 6) / (NB * NBC * 2);
        const float* w2 = p.in[IN_NW2] + (size_t)(l * 2 + j) * 64 * 64;
        const float* h = hid + (size_t)(i >> 6) * 64;
        float acc = 0.f;
        for (int k = 0; k < 64; ++k) acc += h[k] * w2[k * 64 + c];
        kc[i] = acc;
    }
}

__device__ __forceinline__ void ph_mla_attn(const float* qmla, const float* kvmla, const float* krope, const float* rope, float* ycat) {
    GT_DECL
    const float scale = 0.10206207261596575f;
    for (int w = gw; w < 6 * (T / 64); w += NW) {
        const int h = __builtin_amdgcn_readfirstlane(w % 6), tb = __builtin_amdgcn_readfirstlane(w / 6);
        const int t = tb * 64 + lane, s = t & (SEQ - 1), b = __builtin_amdgcn_readfirstlane(t >> 11);
        float q[96];
        const float* qp = qmla + (size_t)t * 768 + h * 96;
#pragma unroll
        for (int d = 0; d < 64; ++d) q[d] = qp[d] * scale;
#pragma unroll
        for (int d = 0; d < 16; ++d) {
            const float c = rope[s * 16 + d], sn = rope[SEQ * 16 + s * 16 + d];
            const float x1 = qp[64 + d], x2 = qp[80 + d];
            q[64 + d] = (x1 * c - x2 * sn) * scale; q[80 + d] = (x2 * c + x1 * sn) * scale;
        }
        const int jmax = __builtin_amdgcn_readfirstlane((tb * 64 + 63) & (SEQ - 1));
        for (int half = 0; half < 2; ++half) {
            float acc[32];
#pragma unroll
            for (int d = 0; d < 32; ++d) acc[d] = 0.f;
            float m = -1e30f, lsum = 0.f;
            for (int j = 0; j <= jmax; ++j) {
                const float* kp = kvmla + (size_t)(b * SEQ + j) * 768 + h * 128;
                const float* rp = krope + (size_t)(b * SEQ + j) * 32;
                float sc = 0.f;
#pragma unroll
                for (int d = 0; d < 64; ++d) sc += q[d] * kp[d];
#pragma unroll
                for (int d = 0; d < 32; ++d) sc += q[64 + d] * rp[d];
                const bool ok = j <= s;
                const float mn = ok ? fmaxf(m, sc) : m;
                const float corr = __expf(m - mn), pj = ok ? __expf(sc - mn) : 0.f;
                lsum = lsum * corr + pj; m = mn;
#pragma unroll
                for (int d = 0; d < 32; ++d) acc[d] = acc[d] * corr + pj * kp[64 + half * 32 + d];
            }
            const float inv = 1.f / lsum;
            float* o = ycat + (size_t)t * D + 256 + h * 64 + half * 32;
#pragma unroll
            for (int d = 0; d < 32; ++d) o[d] = acc[d] * inv;
        }
    }
}

__device__ __forceinline__ void ph_nsa_cmp(const Params& p, const float* proj, const float* kc, float* impp, float* ycat) {
    GT_DECL
    const float* relb = p.in[IN_RELB];
    for (int w = gw; w < 6 * (T / 64); w += NW) {
        const int hh = __builtin_amdgcn_readfirstlane(w % 6), tb = __builtin_amdgcn_readfirstlane(w / 6);
        const int g = hh / 3;
        const int t = tb * 64 + lane, s = t & (SEQ - 1), b = __builtin_amdgcn_readfirstlane(t >> 11);
        float q[64];
        const float* qp = proj + (size_t)t * INLD + O_NQ + hh * 64;
#pragma unroll
        for (int d = 0; d < 64; ++d) q[d] = qp[d] * 0.125f;
        const int nvis = s >= 31 ? ((s - 31) >> 4) + 1 : 0;
        const int smax = (tb * 64 + 63) & (SEQ - 1);
        const int nmax = __builtin_amdgcn_readfirstlane(smax >= 31 ? ((smax - 31) >> 4) + 1 : 0);
        const float* kcb = kc + (size_t)b * NBC * 128 + g * 64;
        const float* vcb = kc + (size_t)NB * NBC * 128 + (size_t)b * NBC * 128 + g * 64;
        float m = -1e30f, lsum = 0.f;
        for (int n = 0; n < nmax; ++n) {
            const float* kp = kcb + n * 128;
            float sc = 0.f;
#pragma unroll
            for (int d = 0; d < 64; ++d) sc += q[d] * kp[d];
            const bool ok = n < nvis;
            sc += relb[t5_bucket(s - (n * 16 + 31)) * 6 + hh];
            const float mn = ok ? fmaxf(m, sc) : m;
            lsum = lsum * __expf(m - mn) + (ok ? __expf(sc - mn) : 0.f); m = mn;
        }
        const float inv = nvis > 0 ? 1.f / lsum : 0.f;
        float acc[64];
#pragma unroll
        for (int d = 0; d < 64; ++d) acc[d] = 0.f;
        const int mmax = (nmax + 4) >> 2;
        for (int mb = 0; mb < 32; ++mb) {
            float im = 0.f;
            if (mb < mmax) {
                for (int dn = -1; dn < 4; ++dn) {
                    const int n = 4 * mb + dn;
                    if (n < 0 || n >= nmax) continue;
                    const float* kp = kcb + n * 128;
                    float sc = 0.f;
#pragma unroll
                    for (int d = 0; d < 64; ++d) sc += q[d] * kp[d];
                    sc += relb[t5_bucket(s - (n * 16 + 31)) * 6 + hh];
                    const float pn = (n < nvis) ? __expf(sc - m) * inv : 0.f;
                    im += pn;
                    if (dn >= 0) { const float* vp = vcb + n * 128;
#pragma unroll
                        for (int d = 0; d < 64; ++d) acc[d] += pn * vp[d]; }
                }
            }
            impp[((size_t)t * 6 + hh) * 32 + mb] = im;
        }
        const float gate = sigmoidf_(proj[(size_t)t * INLD + O_NG + 0 * 6 + hh]);
        float* o = ycat + (size_t)t * D + 640 + hh * 64;
#pragma unroll
        for (int d = 0; d < 64; ++d) o[d] = gate * acc[d];
    }
}
__device__ __forceinline__ unsigned nsa_topk_mask(const float* ip  , int cur) {
    float imp[32];
#pragma unroll
    for (int m = 0; m < 32; ++m) imp[m] = (ip[(size_t)m * SEQ] + ip[(size_t)(32 + m) * SEQ]) + ip[(size_t)(64 + m) * SEQ];
#pragma unroll
    for (int m = 0; m < 32; ++m) {
        const bool forced = (m == 0) || (m == cur) || (m == cur - 1);
        const bool future = m > cur;
        imp[m] = forced ? 1e9f : (future ? -1e9f : imp[m]);
    }
    unsigned mask = 0u;
#pragma unroll
    for (int k = 0; k < 8; ++k) {
        float best = -3e38f; int bi = 0;
#pragma unroll
        for (int m = 0; m < 32; ++m) { const bool free_ = !((mask >> m) & 1u); if (free_ && imp[m] > best) { best = imp[m]; bi = m; } }
        mask |= 1u << bi;
    }
    return mask;
}
__device__ __forceinline__ void ph_nsa_selwin(const Params& p, const float* proj, const unsigned* sel, float* ycat) {
    GT_DECL
    const float* relb = p.in[IN_RELB];
    for (int w = gw; w < 6 * (T / 64); w += NW) {
        const int hh = w % 6, tb = w / 6, g = hh / 3;
        const int t = tb * 64 + lane, s = t & (SEQ - 1), b = t >> 11, cur = s >> 6;
        float q[64];
        const float* qp = proj + (size_t)t * INLD + O_NQ + hh * 64;
#pragma unroll
        for (int d = 0; d < 64; ++d) q[d] = qp[d] * 0.125f;
        const unsigned mask = sel[t * 2 + g];
        float* o = ycat + (size_t)t * D + 640 + hh * 64;
        const float gs = sigmoidf_(proj[(size_t)t * INLD + O_NG + 1 * 6 + hh]), gwn = sigmoidf_(proj[(size_t)t * INLD + O_NG + 2 * 6 + hh]);
        for (int half = 0; half < 2; ++half) {
        {
            float acc[32];
#pragma unroll
            for (int d = 0; d < 32; ++d) acc[d] = 0.f;
            float m = -1e30f, lsum = 0.f;
            for (int mb = 0; mb < 32; ++mb) {
                const bool on = ((mask >> mb) & 1u) && mb <= cur;
                if (!__any(on)) continue;
                for (int j = 0; j < 64; ++j) {
                    const int kpos = mb * 64 + j;
                    const bool ok = on && kpos <= s;
                    if (ok) {
                        const float* kp = proj + (size_t)(b * SEQ + kpos) * INLD + O_NKV + 2 * 128 + g * 64;
                        const float* vp = kp + 128 + half * 32;
                        float sc = 0.f;
#pragma unroll
                        for (int d = 0; d < 64; ++d) sc += q[d] * kp[d];
                        sc += relb[t5_bucket(s - kpos) * 6 + hh];
                        const float mn = fmaxf(m, sc), corr = __expf(m - mn), pj = __expf(sc - mn);
                        lsum = lsum * corr + pj; m = mn;
#pragma unroll
                        for (int d = 0; d < 32; ++d) acc[d] = acc[d] * corr + pj * vp[d];
                    }
                }
            }
            const float inv = gs / lsum;
#pragma unroll
            for (int d = 0; d < 32; ++d) o[half * 32 + d] += acc[d] * inv;
        }
        {
            float acc[32];
#pragma unroll
            for (int d = 0; d < 32; ++d) acc[d] = 0.f;
            float m = -1e30f, lsum = 0.f;
            for (int j = 0; j < 256; ++j) {
                const int kpos = s - 255 + j;
                if (kpos >= 0) {
                    const float* kp = proj + (size_t)(b * SEQ + kpos) * INLD + O_NKV + 4 * 128 + g * 64;
                    const float* vp = kp + 128 + half * 32;
                    float sc = 0.f;
#pragma unroll
                    for (int d = 0; d < 64; ++d) sc += q[d] * kp[d];
                    sc += relb[t5_bucket(s - kpos) * 6 + hh];
                    const float mn = fmaxf(m, sc), corr = __expf(m - mn), pj = __expf(sc - mn);
                    lsum = lsum * corr + pj; m = mn;
#pragma unroll
                    for (int d = 0; d < 32; ++d) acc[d] = acc[d] * corr + pj * vp[d];
                }
            }
            const float inv = gwn / lsum;
#pragma unroll
            for (int d = 0; d < 32; ++d) o[half * 32 + d] += acc[d] * inv;
        }
        }
    }
}

__device__ __forceinline__ void ph_group_norm(const float* ycat, const float* gain, bf16_t* yb) {
    GT_DECL
    const f32x4 ga = *(const f32x4*)(gain + lane * 4);
    f32x2 gb[3], gc[3];
#pragma unroll
    for (int i = 0; i < 3; ++i) { gb[i] = *(const f32x2*)(gain + 256 + lane * 6 + 2 * i); gc[i] = *(const f32x2*)(gain + 640 + lane * 6 + 2 * i); }
    for (int t = gw; t < T; t += NW) {
        const float* y = ycat + (size_t)t * D; bf16_t* o = yb + (size_t)t * D;
        const f32x4 a = *(const f32x4*)(y + lane * 4);
        f32x2 b[3], c[3];
#pragma unroll
        for (int i = 0; i < 3; ++i) { b[i] = *(const f32x2*)(y + 256 + lane * 6 + 2 * i); c[i] = *(const f32x2*)(y + 640 + lane * 6 + 2 * i); }
        float sa = (a.x * a.x + a.y * a.y) + (a.z * a.z + a.w * a.w), sb = 0.f, sc = 0.f;
#pragma unroll
        for (int i = 0; i < 3; ++i) { sb += b[i].x * b[i].x + b[i].y * b[i].y; sc += c[i].x * c[i].x + c[i].y * c[i].y; }
        const float ra = rsqrtf(wave_sum(sa) * (1.f / 256.f) + EPS), rb = rsqrtf(wave_sum(sb) * (1.f / 384.f) + EPS), rc = rsqrtf(wave_sum(sc) * (1.f / 384.f) + EPS);
        *(u32x2*)(o + lane * 4) = (u32x2){pk_bf16(a.x * ra * ga.x, a.y * ra * ga.y), pk_bf16(a.z * ra * ga.z, a.w * ra * ga.w)};
#pragma unroll
        for (int i = 0; i < 3; ++i) {
            *(unsigned*)(o + 256 + lane * 6 + 2 * i) = pk_bf16(b[i].x * rb * gb[i].x, b[i].y * rb * gb[i].y);
            *(unsigned*)(o + 640 + lane * 6 + 2 * i) = pk_bf16(c[i].x * rc * gc[i].x, c[i].y * rc * gc[i].y);
        }
    }
}

__device__ __forceinline__ void ph_xattn(const float* qx, const float* kvx, bf16_t* ox) {
    GT_DECL
    for (int w = gw; w < T * 4; w += NW) {
        const int h = w & 3, t = w >> 2, b = t >> 11;
        const float* q = qx + (size_t)t * D + h * 256;
        const float* kb = kvx + (size_t)(b * 256) * 2048 + h * 256;
        float sc[4] = {0.f, 0.f, 0.f, 0.f};
        for (int d = 0; d < 256; d += 4) {
            const f32x4 qv = *(const f32x4*)(q + d);
#pragma unroll
            for (int i = 0; i < 4; ++i) { const f32x4 kv = *(const f32x4*)(kb + (size_t)(i * 64 + lane) * 2048 + d); sc[i] += qv.x * kv.x + qv.y * kv.y + qv.z * kv.z + qv.w * kv.w; }
        }
        float mx = -1e30f;
#pragma unroll
        for (int i = 0; i < 4; ++i) { sc[i] *= 0.0625f; mx = fmaxf(mx, sc[i]); }
        mx = wave_max(mx);
        float ls = 0.f;
#pragma unroll
        for (int i = 0; i < 4; ++i) { sc[i] = __expf(sc[i] - mx); ls += sc[i]; }
        ls = wave_sum(ls);
        const float inv = 1.f / ls;
        f32x4 o = {0.f, 0.f, 0.f, 0.f};
        const float* vb = kb + 1024 + lane * 4;
#pragma unroll
        for (int i = 0; i < 4; ++i)
            for (int j = 0; j < 64; ++j) {
                const float pj = __shfl(sc[i], j);
                const f32x4 vv = *(const f32x4*)(vb + (size_t)(i * 64 + j) * 2048);
                o.x += pj * vv.x; o.y += pj * vv.y; o.z += pj * vv.z; o.w += pj * vv.w;
            }
        *(u32x2*)(ox + (size_t)t * D + h * 256 + lane * 4) = (u32x2){pk_bf16(o.x * inv, o.y * inv), pk_bf16(o.z * inv, o.w * inv)};
    }
}

__device__ __forceinline__ void ph_moe_route(const bf16_t* h, const float* gain, const float* router, bf16_t* hn, int* topi, float* topw) {
    GT_DECL
    f32x4 ra[16], rb[16], gg4[4];
#pragma unroll
    for (int j = 0; j < 4; ++j) {
        gg4[j] = *((const f32x4*)gain + lane + 64 * j);
#pragma unroll
        for (int c = 0; c < 4; ++c) { const float* r = router + (size_t)(j * 256 + lane * 4 + c) * 8; ra[4 * j + c] = *(const f32x4*)r; rb[4 * j + c] = *(const f32x4*)(r + 4); }
    }
    for (int t = gw; t < T; t += NW) {
        const u32x2* x = (const u32x2*)(h + (size_t)t * D) + lane;
        f32x4 v[4]; float s = 0.f;
#pragma unroll
        for (int j = 0; j < 4; ++j) { const u32x2 xb = x[64 * j]; v[j] = (f32x4){bflo(xb.x), bfhi(xb.x), bflo(xb.y), bfhi(xb.y)}; s += v[j].x * v[j].x + v[j].y * v[j].y + v[j].z * v[j].z + v[j].w * v[j].w; }
        const float rstd = rsqrtf(wave_sum(s) * (1.f / D) + EPS);
        u32x2* o = (u32x2*)(hn + (size_t)t * D) + lane;
        float lg[8] = {0.f, 0.f, 0.f, 0.f, 0.f, 0.f, 0.f, 0.f};
#pragma unroll
        for (int j = 0; j < 4; ++j) {
            const f32x4 gg = gg4[j];
            const f32x4 y = {v[j].x * rstd * gg.x, v[j].y * rstd * gg.y, v[j].z * rstd * gg.z, v[j].w * rstd * gg.w};
            o[64 * j] = (u32x2){pk_bf16(y.x, y.y), pk_bf16(y.z, y.w)};
            const float yy[4] = {y.x, y.y, y.z, y.w};
#pragma unroll
            for (int c = 0; c < 4; ++c) {
                const f32x4 r0 = ra[4 * j + c], r1 = rb[4 * j + c];
                lg[0] += yy[c] * r0.x; lg[1] += yy[c] * r0.y; lg[2] += yy[c] * r0.z; lg[3] += yy[c] * r0.w;
                lg[4] += yy[c] * r1.x; lg[5] += yy[c] * r1.y; lg[6] += yy[c] * r1.z; lg[7] += yy[c] * r1.w;
            }
        }
#pragma unroll
        for (int e = 0; e < 8; ++e) lg[e] = wave_sum(lg[e]);
        float v0 = -3e38f; int i0 = 0;
#pragma unroll
        for (int e = 0; e < 8; ++e) if (lg[e] > v0) { v0 = lg[e]; i0 = e; }
        float v1 = -3e38f; int i1 = 0;
#pragma unroll
        for (int e = 0; e < 8; ++e) if (e != i0 && lg[e] > v1) { v1 = lg[e]; i1 = e; }
        const float e1 = __expf(v1 - v0), w0 = 1.f / (1.f + e1), w1 = e1 * w0;
        if (lane == 0) { topi[t * 2] = i0; topi[t * 2 + 1] = i1; topw[t * 2] = w0; topw[t * 2 + 1] = w1; }
    }
}
__device__ __forceinline__ void ph_moe_sort(LAS int* lds, const int* topi, int* pos, int* rsrc, int* texp) {
    if (blockIdx.x != 0) return;
    const int tid = tid_(), lane = tid & 63, wave = tid >> 6;
    LAS int* cnt = lds;
    LAS int* tot = lds + 8 * 512;
    int c[8];
#pragma unroll
    for (int k = 0; k < 8; ++k) c[k] = 0;
    for (int i = 0; i < 64; ++i) { const int e = topi[i * NTHR + tid];
#pragma unroll
        for (int k = 0; k < 8; ++k) c[k] += (e == k) ? 1 : 0; }
#pragma unroll
    for (int k = 0; k < 8; ++k) cnt[k * NTHR + tid] = c[k];
    __syncthreads();
    {
        int v[8]; int sum = 0;
#pragma unroll
        for (int j = 0; j < 8; ++j) { v[j] = cnt[wave * NTHR + lane * 8 + j]; sum += v[j]; }
        int incl = sum;
#pragma unroll
        for (int o = 1; o < 64; o <<= 1) { const int t = __shfl_up(incl, o); if (lane >= o) incl += t; }
        int run = incl - sum;
#pragma unroll
        for (int j = 0; j < 8; ++j) { cnt[wave * NTHR + lane * 8 + j] = run; run += v[j]; }
        if (lane == 63) tot[wave] = incl;
    }
    __syncthreads();
    if (tid == 0) { int off = 0; for (int e = 0; e < 8; ++e) { tot[8 + e] = off; off += (tot[e] + 255) & ~255; } tot[16] = off; texp[160] = off >> 8; }
    __syncthreads();
    if (tid < MOE_TILES) { const int r0 = tid * 256; int ex = -1;
        for (int e = 0; e < 8; ++e) { const int lo = tot[8 + e], hi = lo + ((tot[e] + 255) & ~255); if (r0 >= lo && r0 < hi) ex = e; }
        texp[tid] = ex; }
    for (int e = 0; e < 8; ++e) { const int lo = tot[8 + e] + tot[e], hi = tot[8 + e] + ((tot[e] + 255) & ~255); for (int r = lo + tid; r < hi; r += NTHR) rsrc[r] = 0; }
    int run[8];
#pragma unroll
    for (int k = 0; k < 8; ++k) run[k] = tot[8 + k] + cnt[k * NTHR + tid];
    for (int i = 0; i < 64; ++i) {
        const int idx = i * NTHR + tid, e = topi[idx];
        int r = 0;
#pragma unroll
        for (int k = 0; k < 8; ++k) { r = (e == k) ? run[k] : r; run[k] += (e == k) ? 1 : 0; }
        rsrc[r] = idx >> 1; pos[idx] = r;
    }
}
__device__ __forceinline__ f32x4 moe_row4(const bf16_t* ys, const float* ys2p, int r, int col) {
    if (r < 2 * MOE_RT * 256) { const u32x2 b2 = *(const u32x2*)(ys + (size_t)r * D + col); return (f32x4){bflo(b2.x), bfhi(b2.x), bflo(b2.y), bfhi(b2.y)}; }
    const float* q = ys2p + (size_t)(r - 2 * MOE_RT * 256) * D + col;
    return (*(const f32x4*)q + *(const f32x4*)(q + (size_t)2048 * D)) + (*(const f32x4*)(q + (size_t)2 * 2048 * D) + *(const f32x4*)(q + (size_t)3 * 2048 * D));
}
__device__ __forceinline__ void ph_moe_combine_final(const bf16_t* h, const bf16_t* ys, const float* ys2p, const int* pos, const float* topw, const float* gain, float* out) {
    GT_DECL
    for (int t = gw; t < T; t += NW) {
        const u32x2* x = (const u32x2*)(h + (size_t)t * D) + lane;
        const int r0 = pos[t * 2], r1 = pos[t * 2 + 1];
        const float w0 = topw[t * 2], w1 = topw[t * 2 + 1];
        f32x4 v[4]; float s = 0.f;
#pragma unroll
        for (int j = 0; j < 4; ++j) { const u32x2 xb = x[64 * j]; const f32x4 a = {bflo(xb.x), bfhi(xb.x), bflo(xb.y), bfhi(xb.y)};
            const f32x4 b = moe_row4(ys, ys2p, r0, 256 * j + 4 * lane), c = moe_row4(ys, ys2p, r1, 256 * j + 4 * lane);
            v[j] = (f32x4){a.x + w0 * b.x + w1 * c.x, a.y + w0 * b.y + w1 * c.y, a.z + w0 * b.z + w1 * c.z, a.w + w0 * b.w + w1 * c.w};
            s += v[j].x * v[j].x + v[j].y * v[j].y + v[j].z * v[j].z + v[j].w * v[j].w; }
        const float rstd = rsqrtf(wave_sum(s) * (1.f / D) + EPS);
        f32x4* o = (f32x4*)(out + (size_t)t * D) + lane; const f32x4* g = (const f32x4*)gain + lane;
#pragma unroll
        for (int j = 0; j < 4; ++j) { const f32x4 gg = g[64 * j]; o[64 * j] = (f32x4){v[j].x * rstd * gg.x, v[j].y * rstd * gg.y, v[j].z * rstd * gg.z, v[j].w * rstd * gg.w}; }
    }
}

namespace fa {
typedef short bf16x8 __attribute__((ext_vector_type(8)));
typedef __bf16 bfv8 __attribute__((ext_vector_type(8)));
typedef float f32x8 __attribute__((ext_vector_type(8)));
typedef float f32x16 __attribute__((ext_vector_type(16)));
typedef short s16x4 __attribute__((ext_vector_type(4)));
#define FA_MFMA(a, b, c) __builtin_amdgcn_mfma_f32_32x32x16_bf16((a), (b), (c), 0, 0, 0)
constexpr float LOG2E = 1.4426950408889634f;
constexpr float NEG_S = -1e30f, M_INIT = -1e20f;
enum { MASK_NONE = 0, MASK_CAUSAL = 1, MASK_WIN = 2, MASK_SEL = 3 };

__device__ __forceinline__ bf16x8 pack8(float a0, float a1, float a2, float a3, float a4, float a5, float a6, float a7) {
    const f32x8 v = {a0, a1, a2, a3, a4, a5, a6, a7};
    return __builtin_bit_cast(bf16x8, __builtin_convertvector(v, bfv8));
}
struct KVSrc { const bf16_t* K0; int ldk0; const bf16_t* K1; int ldk1; const bf16_t* V; int ldv; };

template <int DK, int DK0, int DVT, int KT>
struct Geo {
    static constexpr int KSTR = DK * 2 + 16, VSTR = (DVT == 64) ? 192 : (DVT * 2 + 64);
    static constexpr int KBUF = KT * KSTR, VBUF = KT * VSTR;
    static constexpr int NKC = KT * DK / 8 / 256, NVC = KT * DVT / 8 / 256;
    static constexpr int LDS_TILES = 2 * KBUF + 2 * VBUF;
    static_assert(NKC * 256 * 8 == KT * DK && NVC * 256 * 8 == KT * DVT && (VSTR / 4) % 64 % 32 == 16, "staging split / V stride");
};

template <int DK, int DK0, int DVW, int DVT, int KT, int MASK>
__device__ __forceinline__ void attn_pass(LAS unsigned char* lds, const KVSrc src, const bf16x8 (&qf)[DK / 16], f32x16 (&O)[DVW / 32], float& m, float& l,
                                          int kt_lo, int kt_hi, int qpos, int qw, int dvoff, unsigned selmask, const LAS float* biasT, float c1) {
    typedef Geo<DK, DK0, DVT, KT> G;
    const int tid = tid_(), lane = tid & 63, r = lane & 31, h = lane >> 5;
    u32x4 kreg[G::NKC]; u32x4 vreg[G::NVC];
    const int trq = (lane & 15) >> 2, trp = lane & 3, trblk = (lane >> 4) & 1;
#define FA_ISSUE(k0_) do { const int k0i_ = (k0_); \
    if (tid >= 256) { _Pragma("unroll") for (int i_ = 0; i_ < G::NKC; ++i_) { const int c_ = (tid - 256) + 256 * i_, key_ = c_ / (DK / 8), col_ = (c_ % (DK / 8)) * 8; \
        const bf16_t* p_ = (col_ < DK0) ? src.K0 + (size_t)(k0i_ + key_) * src.ldk0 + col_ : src.K1 + (size_t)(k0i_ + key_) * src.ldk1 + (col_ - DK0); \
        kreg[i_] = *(const u32x4*)p_; } } \
    else { _Pragma("unroll") for (int i_ = 0; i_ < G::NVC; ++i_) { const int c_ = tid + 256 * i_, key_ = c_ / (DVT / 8), cc_ = c_ % (DVT / 8); \
        vreg[i_] = *(const u32x4*)(src.V + (size_t)(k0i_ + key_) * src.ldv + cc_ * 8); } } } while (0)
#define FA_COMMIT(buf_) do { LAS unsigned char* kb_ = lds + (buf_) * G::KBUF; LAS unsigned char* vb_ = lds + 2 * G::KBUF + (buf_) * G::VBUF; \
    if (tid >= 256) { _Pragma("unroll") for (int i_ = 0; i_ < G::NKC; ++i_) { const int c_ = (tid - 256) + 256 * i_, key_ = c_ / (DK / 8), cc_ = c_ % (DK / 8); \
        *(LAS u32x4*)(kb_ + key_ * G::KSTR + cc_ * 16) = kreg[i_]; } } \
    else { _Pragma("unroll") for (int i_ = 0; i_ < G::NVC; ++i_) { const int c_ = tid + 256 * i_, key_ = c_ / (DVT / 8), cc_ = c_ % (DVT / 8); \
        *(LAS u32x4*)(vb_ + key_ * G::VSTR + cc_ * 16) = vreg[i_]; } } } while (0)
    if (kt_lo < kt_hi) { FA_ISSUE(kt_lo * KT); FA_COMMIT(0); }
    __syncthreads();
    for (int kt = kt_lo; kt < kt_hi; ++kt) {
        const int buf = (kt - kt_lo) & 1, k0 = kt * KT;
        if (kt + 1 < kt_hi) FA_ISSUE(k0 + KT);
        bool need = true, full = true;
        if (MASK == MASK_CAUSAL || MASK == MASK_SEL) { need = k0 <= qw + 31; full = (k0 + KT - 1 <= qw); }
        if (MASK == MASK_WIN) { need = (k0 <= qw + 31) && (k0 + KT - 1 >= qw - 255); full = (k0 + KT - 1 <= qw) && (k0 >= qw + 31 - 255); }
        if (need) {
            const LAS unsigned char* kb = lds + buf * G::KBUF; const LAS unsigned char* vb = lds + 2 * G::KBUF + buf * G::VBUF;
            f32x16 S[KT / 32];
#pragma unroll
            for (int mt = 0; mt < KT / 32; ++mt) {
#pragma unroll
                for (int i = 0; i < 16; ++i) S[mt][i] = 0.f;
#pragma unroll
                for (int s = 0; s < DK / 16; ++s) {
                    const bf16x8 a = *(const LAS bf16x8*)(kb + (32 * mt + r) * G::KSTR + (2 * s + h) * 16);
                    __builtin_amdgcn_s_setprio(1); S[mt] = FA_MFMA(a, qf[s], S[mt]); __builtin_amdgcn_s_setprio(0);
                }
            }
            const bool hasbias = (MASK == MASK_WIN || MASK == MASK_SEL);
            const bool near = hasbias && (qw - (k0 + KT - 1) < 127);
            const bool selok = (MASK == MASK_SEL) ? (((selmask >> (k0 >> 6)) & 1u) != 0u) : true;
            const float bfar = hasbias ? biasT[256] : 0.f;
            float tmax = NEG_S;
            bool raw = false;
            if (full && !near) {
                if (!hasbias && MASK != MASK_SEL) {
                    raw = true;
#pragma unroll
                    for (int mt = 0; mt < KT / 32; ++mt)
#pragma unroll
                        for (int i = 0; i < 16; ++i) tmax = fmaxf(tmax, S[mt][i]);
                    tmax *= c1;
                } else {
                    raw = true;
#pragma unroll
                    for (int mt = 0; mt < KT / 32; ++mt)
#pragma unroll
                        for (int i = 0; i < 16; ++i) tmax = fmaxf(tmax, S[mt][i]);
                    tmax = selok ? tmax * c1 + bfar : NEG_S;
                }
            } else if (hasbias) {
                const LAS float* tb = biasT + (383 - (qpos - k0 - 4 * h));
#pragma unroll
                for (int mt = 0; mt < KT / 32; ++mt)
#pragma unroll
                    for (int i = 0; i < 16; ++i) {
                        float v = S[mt][i] * c1 + tb[32 * mt + (i & 3) + 8 * (i >> 2)];
                        if (MASK == MASK_SEL) v = selok ? v : NEG_S;
                        v = fmaxf(v, NEG_S);
                        S[mt][i] = v; tmax = fmaxf(tmax, v);
                    }
            } else {
                const int qrel = qpos - k0 - 4 * h;
#pragma unroll
                for (int mt = 0; mt < KT / 32; ++mt)
#pragma unroll
                    for (int i = 0; i < 16; ++i) {
                        const int dist = qrel - (32 * mt + (i & 3) + 8 * (i >> 2));
                        bool ok = selok;
                        if (MASK != MASK_NONE) ok = ok && (dist >= 0);
                        if (MASK == MASK_WIN) ok = ok && (dist < 256);
                        float b = 0.f;
                        if (hasbias) { const int di = dist < 0 ? 0 : (dist > 127 ? 127 : dist); b = biasT[di]; }
                        const float v = ok ? S[mt][i] * c1 + b : NEG_S;
                        S[mt][i] = v; tmax = fmaxf(tmax, v);
                    }
            }
            tmax = xhalf_max(tmax);
            const float mn = fmaxf(m, tmax);
            const bool moved = mn > m;
            float ps = 0.f;
            if (raw) {
                const float off = selok ? bfar - mn : NEG_S;
#pragma unroll
                for (int mt = 0; mt < KT / 32; ++mt)
#pragma unroll
                    for (int i = 0; i < 16; ++i) { const float pv = __builtin_amdgcn_exp2f(S[mt][i] * c1 + off); S[mt][i] = pv; ps += pv; }
            } else {
#pragma unroll
                for (int mt = 0; mt < KT / 32; ++mt)
#pragma unroll
                    for (int i = 0; i < 16; ++i) { const float pv = __builtin_amdgcn_exp2f(S[mt][i] - mn); S[mt][i] = pv; ps += pv; }
            }
            if (__any(moved)) {
                const float alpha = __builtin_amdgcn_exp2f(m - mn);
                l *= alpha;
#pragma unroll
                for (int dt = 0; dt < DVW / 32; ++dt)
#pragma unroll
                    for (int i = 0; i < 16; ++i) O[dt][i] *= alpha;
            }
            m = mn;
            l += ps;
#pragma unroll
            for (int mt = 0; mt < KT / 32; ++mt)
#pragma unroll
                for (int s = 0; s < 2; ++s) {
                    const bf16x8 pb = pack8(S[mt][8 * s + 0], S[mt][8 * s + 1], S[mt][8 * s + 2], S[mt][8 * s + 3], S[mt][8 * s + 4], S[mt][8 * s + 5], S[mt][8 * s + 6], S[mt][8 * s + 7]);
#pragma unroll
                    for (int dt = 0; dt < DVW / 32; ++dt) {
                        const LAS unsigned char* vp = vb + (32 * mt + 16 * s + 4 * h + trq) * G::VSTR + (dvoff + 32 * dt + 16 * trblk + 4 * trp) * 2;
                        const s16x4 lo = __builtin_amdgcn_ds_read_tr16_b64_v4i16((LAS s16x4*)vp);
                        const s16x4 hi = __builtin_amdgcn_ds_read_tr16_b64_v4i16((LAS s16x4*)(vp + 8 * G::VSTR));
                        const bf16x8 av = __builtin_shufflevector(lo, hi, 0, 1, 2, 3, 4, 5, 6, 7);
                        O[dt] = FA_MFMA(av, pb, O[dt]);
                    }
                }
        }
        if (kt + 1 < kt_hi) FA_COMMIT(buf ^ 1);
        __syncthreads();
    }
#undef FA_ISSUE
#undef FA_COMMIT
}

__device__ __forceinline__ bf16x8 ld8f(const float* p) { const f32x4 a = *(const f32x4*)p, b = *(const f32x4*)(p + 4); return pack8(a.x, a.y, a.z, a.w, b.x, b.y, b.z, b.w); }

__device__ __forceinline__ int next_unit(unsigned* ctr, volatile LAS unsigned* uw) {
    __syncthreads();
    if (threadIdx.x == 0) *uw = atomicAdd(ctr, 1u);
    __syncthreads();
    return (int)*uw;
}
constexpr int LDS_BIAS = 98304, LDS_UW = 98304 + 1024;

__device__ __forceinline__ void mla_unit(LAS unsigned char* lds, int qb, int bh, const bf16_t* qmla, const bf16_t* kvmb, const bf16_t* krb, const float* rope, float* ycat) {
    const int tid = tid_(), lane = tid & 63, wave = tid >> 6, r = lane & 31, h = lane >> 5;
    {
        const int b = bh / 6, hd = bh % 6;
        const int qw = qb * 256 + wave * 32, qpos = qw + r;
        const bf16_t* qp = qmla + (size_t)(b * SEQ + qpos) * 768 + hd * 96;
        bf16x8 qf[6];
#pragma unroll
        for (int s = 0; s < 4; ++s) qf[s] = *(const bf16x8*)(qp + 16 * s + 8 * h);
        {
            const u32x4 r1 = *(const u32x4*)(qp + 64 + 8 * h), r2 = *(const u32x4*)(qp + 80 + 8 * h);
            const f32x4 x1a = {bflo(r1.x), bfhi(r1.x), bflo(r1.y), bfhi(r1.y)}, x1b = {bflo(r1.z), bfhi(r1.z), bflo(r1.w), bfhi(r1.w)};
            const f32x4 x2a = {bflo(r2.x), bfhi(r2.x), bflo(r2.y), bfhi(r2.y)}, x2b = {bflo(r2.z), bfhi(r2.z), bflo(r2.w), bfhi(r2.w)};
            const float* cs = rope + qpos * 16 + 8 * h; const float* sn = rope + SEQ * 16 + qpos * 16 + 8 * h;
            const f32x4 ca = *(const f32x4*)cs, cb = *(const f32x4*)(cs + 4), sa = *(const f32x4*)sn, sb = *(const f32x4*)(sn + 4);
            qf[4] = pack8(x1a.x * ca.x - x2a.x * sa.x, x1a.y * ca.y - x2a.y * sa.y, x1a.z * ca.z - x2a.z * sa.z, x1a.w * ca.w - x2a.w * sa.w,
                          x1b.x * cb.x - x2b.x * sb.x, x1b.y * cb.y - x2b.y * sb.y, x1b.z * cb.z - x2b.z * sb.z, x1b.w * cb.w - x2b.w * sb.w);
            qf[5] = pack8(x2a.x * ca.x + x1a.x * sa.x, x2a.y * ca.y + x1a.y * sa.y, x2a.z * ca.z + x1a.z * sa.z, x2a.w * ca.w + x1a.w * sa.w,
                          x2b.x * cb.x + x1b.x * sb.x, x2b.y * cb.y + x1b.y * sb.y, x2b.z * cb.z + x1b.z * sb.z, x2b.w * cb.w + x1b.w * sb.w);
        }
        KVSrc src; src.K0 = kvmb + (size_t)b * SEQ * 768 + hd * 128; src.ldk0 = 768; src.K1 = krb + (size_t)b * SEQ * 32; src.ldk1 = 32; src.V = kvmb + (size_t)b * SEQ * 768 + hd * 128 + 64; src.ldv = 768;
        f32x16 O[2];
#pragma unroll
        for (int dt = 0; dt < 2; ++dt)
#pragma unroll
            for (int i = 0; i < 16; ++i) O[dt][i] = 0.f;
        float m = M_INIT, l = 0.f;
        attn_pass<96, 64, 64, 64, 64, MASK_CAUSAL>(lds, src, qf, O, m, l, 0, (qb + 1) * 4, qpos, qw, 0, 0u, nullptr, 0.10206207261596575f * LOG2E);
        const float inv = 1.f / xhalf_sum(l);
        float* op = ycat + (size_t)(b * SEQ + qpos) * D + 256 + hd * 64;
#pragma unroll
        for (int dt = 0; dt < 2; ++dt)
#pragma unroll
            for (int g = 0; g < 4; ++g)
                *(f32x4*)(op + 32 * dt + 8 * g + 4 * h) = (f32x4){O[dt][4 * g] * inv, O[dt][4 * g + 1] * inv, O[dt][4 * g + 2] * inv, O[dt][4 * g + 3] * inv};
    }
}

__device__ __forceinline__ void selwin_unit(LAS unsigned char* lds, int qb, int bh, const float* proj, const bf16_t* nqb, const bf16_t* nkvb, const float* impp, const float* relb, float* ycat) {
    const int tid = tid_(), lane = tid & 63, wave = tid >> 6, r = lane & 31, h = lane >> 5;
    LAS float* biasT = (LAS float*)(lds + LDS_BIAS);
    {
        const int b = bh / 6, hh = bh % 6, g = hh / 3;
        { const int dist = 383 - tid; biasT[tid] = (dist < 0 || dist >= 256) ? NEG_S : relb[t5_bucket(dist > 127 ? 127 : dist) * 6 + hh] * LOG2E; }
        const int qw = qb * 256 + wave * 32, qpos = qw + r;
        const size_t trow = (size_t)(b * SEQ + qpos);
        const bf16_t* qp = nqb + trow * 384 + hh * 64;
        bf16x8 qf[4];
#pragma unroll
        for (int s = 0; s < 4; ++s) qf[s] = *(const bf16x8*)(qp + 16 * s + 8 * h);
        const unsigned selmask = nsa_topk_mask(impp + ((size_t)(b * 6 + g * 3) * 32) * SEQ + qpos, qpos >> 6);
        const bf16_t* kvb = nkvb + (size_t)b * SEQ * 768 + g * 64;
        f32x16 O[2], Os[2];
        float m, l;
        KVSrc src; src.K1 = nullptr; src.ldk1 = 0; src.ldk0 = 768; src.ldv = 768;
#pragma unroll
        for (int dt = 0; dt < 2; ++dt)
#pragma unroll
            for (int i = 0; i < 16; ++i) O[dt][i] = 0.f;
        m = M_INIT; l = 0.f;
        src.K0 = kvb + 2 * 128; src.V = kvb + 3 * 128;
        attn_pass<64, 64, 64, 64, 64, MASK_SEL>(lds, src, qf, O, m, l, 0, (qb + 1) * 4, qpos, qw, 0, selmask, biasT, 0.125f * LOG2E);
        {
            const float gs = sigmoidf_(proj[trow * INLD + O_NG + 6 + hh]) / xhalf_sum(l);
#pragma unroll
            for (int dt = 0; dt < 2; ++dt)
#pragma unroll
                for (int i = 0; i < 16; ++i) { Os[dt][i] = O[dt][i] * gs; O[dt][i] = 0.f; }
        }
        m = M_INIT; l = 0.f;
        src.K0 = kvb + 4 * 128; src.V = kvb + 5 * 128;
        attn_pass<64, 64, 64, 64, 64, MASK_WIN>(lds, src, qf, O, m, l, qb > 0 ? qb * 4 - 4 : 0, (qb + 1) * 4, qpos, qw, 0, 0u, biasT, 0.125f * LOG2E);
        const float gwn = sigmoidf_(proj[trow * INLD + O_NG + 12 + hh]) / xhalf_sum(l);
        float* op = ycat + trow * D + 640 + hh * 64;
#pragma unroll
        for (int dt = 0; dt < 2; ++dt)
#pragma unroll
            for (int gq = 0; gq < 4; ++gq) {
                float* o4 = op + 32 * dt + 8 * gq + 4 * h;
                const f32x4 old = *(const f32x4*)o4;
                *(f32x4*)o4 = (f32x4){old.x + Os[dt][4 * gq] + O[dt][4 * gq] * gwn, old.y + Os[dt][4 * gq + 1] + O[dt][4 * gq + 1] * gwn,
                                      old.z + Os[dt][4 * gq + 2] + O[dt][4 * gq + 2] * gwn, old.w + Os[dt][4 * gq + 3] + O[dt][4 * gq + 3] * gwn};
            }
    }
}

__device__ __forceinline__ void ph_attn_merged(LAS unsigned char* lds, unsigned* ctr, const bf16_t* qmla, const bf16_t* kvmb, const bf16_t* krb, const float* rope,
                                               const float* proj, const bf16_t* nqb, const bf16_t* nkvb, const float* impp, const float* relb, float* ycat) {
    volatile LAS unsigned* uw = (volatile LAS unsigned*)(lds + LDS_UW);
    for (;;) {
        const int u = next_unit(ctr, uw);
        if (u >= 16 * 48) break;
        const int grp = u / 48, bh = u % 48;
        const unsigned code = (unsigned)((0x7654736251430210ull >> (4 * (15 - grp))) & 0xfull);
        const bool is_mla = ((0x0ab7u >> (15 - grp)) & 1u) != 0u;
        if (is_mla) mla_unit(lds, (int)code, bh, qmla, kvmb, krb, rope, ycat);
        else selwin_unit(lds, (int)code, bh, proj, nqb, nkvb, impp, relb, ycat);
    }
}

__device__ __forceinline__ void ph_xattn_mfma(LAS unsigned char* lds, unsigned* ctr, const bf16_t* qx, const bf16_t* kvxb, bf16_t* oxb) {
    const int tid = tid_(), lane = tid & 63, wave = tid >> 6, r = lane & 31, h = lane >> 5;
    volatile LAS unsigned* uw = (volatile LAS unsigned*)(lds + LDS_UW);
    for (;;) {
        const int u = next_unit(ctr, uw);
        if (u >= (T / 128) * 4) break;
        const int hd = u & 3, tt = u >> 2, t0 = tt * 128, b = t0 >> 11;
        const int qw = t0 + (wave & 3) * 32, qrow = qw + r, dvoff = (wave >> 2) * 128;
        const bf16_t* qp = qx + (size_t)qrow * D + hd * 256;
        bf16x8 qf[16];
#pragma unroll
        for (int s = 0; s < 16; ++s) qf[s] = *(const bf16x8*)(qp + 16 * s + 8 * h);
        KVSrc src; src.K0 = kvxb + (size_t)(b * 256) * 2048 + hd * 256; src.ldk0 = 2048; src.K1 = nullptr; src.ldk1 = 0; src.V = src.K0 + 1024; src.ldv = 2048;
        f32x16 O[4];
#pragma unroll
        for (int dt = 0; dt < 4; ++dt)
#pragma unroll
            for (int i = 0; i < 16; ++i) O[dt][i] = 0.f;
        float m = M_INIT, l = 0.f;
        attn_pass<256, 256, 128, 256, 32, MASK_NONE>(lds, src, qf, O, m, l, 0, 8, 0, 0, dvoff, 0u, nullptr, 0.0625f * LOG2E);
        const float inv = 1.f / xhalf_sum(l);
        bf16_t* op = oxb + (size_t)qrow * D + hd * 256 + dvoff;
#pragma unroll
        for (int dt = 0; dt < 4; ++dt)
#pragma unroll
            for (int g = 0; g < 4; ++g)
                *(u32x2*)(op + 32 * dt + 8 * g + 4 * h) = (u32x2){pk_bf16(O[dt][4 * g] * inv, O[dt][4 * g + 1] * inv), pk_bf16(O[dt][4 * g + 2] * inv, O[dt][4 * g + 3] * inv)};
    }
}
}

__device__ __forceinline__ void ph_pe_bias(const Params& p, float* peb) {
    GT_DECL
    const int gwv = (tid >> 6) * (int)gridDim.x + (int)blockIdx.x;
    for (int w = gwv; w < 2 * 2 * 64; w += NW) {
        const int c = w & 63, lj = w >> 6;
        const float* pe = p.in[IN_NPE] + (size_t)lj * 2048; const float* w1 = p.in[IN_NW1] + (size_t)lj * 2048 * 64 + c;
        float acc = 0.f;
        for (int i = 0; i < 32; ++i) { const int k = lane + 64 * i; acc += pe[k] * w1[(size_t)k * 64]; }
        acc = wave_sum(acc);
        if (lane == 0) peb[w] = acc;
    }
}
__device__ __forceinline__ void ph_cmp_mfma(const Params& p, int l, const bf16_t* nkvb, const bf16_t* w1t, const float* peb, bf16_t* kcb, bf16_t* vct, LAS unsigned char* lds) {
    const int tid = tid_(), lane = tid & 63, r = lane & 31, h = lane >> 5, wave = tid >> 6;
    LAS float* red = (LAS float*)lds;
    for (int u = (int)blockIdx.x; u < 128; u += (int)gridDim.x) {
        const int rt = u & 3, g = (u >> 2) & 1, b = (u >> 3) & 7, j = u >> 6;
        const int n = rt * 32 + r, nc = n < NBC ? n : NBC - 1;
        const bf16_t* xrow = nkvb + (size_t)(b * SEQ + nc * 16) * 768 + j * 128 + g * 64;
        const bf16_t* w1 = w1t + (size_t)j * 64 * 2048;
        fa::f32x16 acc[2];
#pragma unroll
        for (int ct = 0; ct < 2; ++ct)
#pragma unroll
            for (int i = 0; i < 16; ++i) acc[ct][i] = 0.f;
#pragma unroll 2
        for (int pp = 0; pp < 4; ++pp) {
            const int pos = wave * 4 + pp;
#pragma unroll
            for (int s4 = 0; s4 < 4; ++s4) {
                const bf16x8_t bfr = *(const bf16x8_t*)(xrow + (size_t)pos * 768 + s4 * 16 + 8 * h);
                const int kk = pos * 64 + s4 * 16 + 8 * h;
#pragma unroll
                for (int ct = 0; ct < 2; ++ct) {
                    const bf16x8_t afr = *(const bf16x8_t*)(w1 + (size_t)(32 * ct + r) * 2048 + kk);
                    acc[ct] = FA_MFMA(afr, bfr, acc[ct]);
                }
            }
        }
        __syncthreads();
#pragma unroll
        for (int ct = 0; ct < 2; ++ct)
#pragma unroll
            for (int i = 0; i < 16; ++i) red[((wave * 2 + ct) * 16 + i) * 64 + lane] = acc[ct][i];
        __syncthreads();
        if (wave != 0) continue;
#pragma unroll 1
        for (int w8 = 1; w8 < 8; ++w8) {
#pragma unroll
            for (int ct = 0; ct < 2; ++ct)
#pragma unroll
                for (int i = 0; i < 16; ++i) acc[ct][i] += red[((w8 * 2 + ct) * 16 + i) * 64 + lane];
        }
        const float* pb = peb + (l * 2 + j) * 64;
#pragma unroll
        for (int ct = 0; ct < 2; ++ct)
#pragma unroll
            for (int g4 = 0; g4 < 4; ++g4) {
                const f32x4 bv = *(const f32x4*)(pb + 32 * ct + 8 * g4 + 4 * h);
                acc[ct][4 * g4 + 0] = gelu_tanh(acc[ct][4 * g4 + 0] + bv.x); acc[ct][4 * g4 + 1] = gelu_tanh(acc[ct][4 * g4 + 1] + bv.y);
                acc[ct][4 * g4 + 2] = gelu_tanh(acc[ct][4 * g4 + 2] + bv.z); acc[ct][4 * g4 + 3] = gelu_tanh(acc[ct][4 * g4 + 3] + bv.w);
            }
        const float* w2 = p.in[IN_NW2] + (size_t)(l * 2 + j) * 64 * 64;
        fa::f32x16 o[2];
#pragma unroll
        for (int ct = 0; ct < 2; ++ct)
#pragma unroll
            for (int i = 0; i < 16; ++i) o[ct][i] = 0.f;
#pragma unroll
        for (int ct = 0; ct < 2; ++ct)
#pragma unroll
            for (int s = 0; s < 2; ++s) {
                const bf16x8_t pbk = pack8f(acc[ct][8 * s + 0], acc[ct][8 * s + 1], acc[ct][8 * s + 2], acc[ct][8 * s + 3], acc[ct][8 * s + 4], acc[ct][8 * s + 5], acc[ct][8 * s + 6], acc[ct][8 * s + 7]);
#pragma unroll
                for (int ct2 = 0; ct2 < 2; ++ct2) {
                    const float* wp = w2 + (size_t)(32 * ct + 16 * s + 4 * h) * 64 + 32 * ct2 + r;
                    const bf16x8_t afr = pack8f(wp[0], wp[64], wp[128], wp[192], wp[512], wp[576], wp[640], wp[704]);
                    o[ct2] = FA_MFMA(afr, pbk, o[ct2]);
                }
            }
        const bool valid = n < NBC;
        if (j == 0) {
            bf16_t* kr = kcb + ((size_t)(b * 2 + g) * 128 + n) * 64;
#pragma unroll
            for (int ct2 = 0; ct2 < 2; ++ct2)
#pragma unroll
                for (int g4 = 0; g4 < 4; ++g4)
                    *(u32x2*)(kr + 32 * ct2 + 8 * g4 + 4 * h) = valid ? (u32x2){pk_bf16(o[ct2][4 * g4], o[ct2][4 * g4 + 1]), pk_bf16(o[ct2][4 * g4 + 2], o[ct2][4 * g4 + 3])} : (u32x2){0u, 0u};
        } else {
            bf16_t* vc = vct + (size_t)(b * 2 + g) * 64 * 128 + n;
#pragma unroll
            for (int ct2 = 0; ct2 < 2; ++ct2)
#pragma unroll
                for (int i = 0; i < 16; ++i) vc[(size_t)(32 * ct2 + (i & 3) + 8 * (i >> 2) + 4 * h) * 128] = valid ? f2bf(o[ct2][i]) : (bf16_t)0;
        }
    }
}
constexpr int LDS_CBIAS = 135168;
__device__ __forceinline__ void ph_nsa_cmp_mfma(const Params& p, const float* proj, const bf16_t* nqb, const bf16_t* kcb, const bf16_t* vct, float* impp, float* ycat, LAS unsigned char* lds) {
    const int tid = tid_(), lane = tid & 63, wave = tid >> 6;
    const int r = lane & 31, h = lane >> 5;
    LAS float* bt = (LAS float*)(lds + LDS_CBIAS);
    constexpr int KS = 144, VS = 264;
    LAS unsigned char* kl = lds;
    LAS unsigned char* vl = lds + 18432;
    for (int i = tid; i < 768; i += NTHR) bt[i] = p.in[IN_RELB][t5_bucket(i & 127) * 6 + (i >> 7)] * fa::LOG2E;
    for (int bu = (int)((blockIdx.x + 64u) % gridDim.x); bu < NB * 6 * 8; bu += (int)gridDim.x) {
        const int q8 = bu & 7, bh = bu >> 3, hh = bh % 6, b = bh / 6, g = hh / 3;
        __syncthreads();
        {
            const bf16_t* ksrc = kcb + (size_t)(b * 2 + g) * 128 * 64; const bf16_t* vsrc = vct + (size_t)(b * 2 + g) * 64 * 128;
#pragma unroll
            for (int i = 0; i < 2; ++i) { const int c = tid + 512 * i, row = c >> 3, cc = c & 7;
                *(LAS u32x4*)(kl + row * KS + cc * 16) = *(const u32x4*)(ksrc + (size_t)row * 64 + cc * 8); }
#pragma unroll
            for (int i = 0; i < 2; ++i) { const int c = tid + 512 * i, row = c >> 4, cc = c & 15;
                *(LAS u32x4*)(vl + row * VS + cc * 16) = *(const u32x4*)(vsrc + (size_t)row * 128 + cc * 8); }
        }
        const int qg = q8 * 8 + wave;
        const int s = qg * 32 + r; const size_t t = (size_t)b * SEQ + s;
        const bf16_t* qp = nqb + t * 384 + hh * 64;
        bf16x8_t qf[4];
#pragma unroll
        for (int ks = 0; ks < 4; ++ks) qf[ks] = *(const bf16x8_t*)(qp + 16 * ks + 8 * h);
        const float gate_logit = proj[t * INLD + O_NG + hh];
        __syncthreads();
        fa::f32x16 S[4];
#pragma unroll
        for (int mt = 0; mt < 4; ++mt) {
#pragma unroll
            for (int i = 0; i < 16; ++i) S[mt][i] = 0.f;
#pragma unroll
            for (int ks = 0; ks < 4; ++ks) {
                const bf16x8_t a = *(const LAS bf16x8_t*)(kl + (32 * mt + r) * KS + (2 * ks + h) * 16);
                S[mt] = FA_MFMA(a, qf[ks], S[mt]);
            }
        }
        const LAS float* bth = bt + hh * 128;
        const int qrel = s - 31 - 64 * h;
        float tmax = fa::NEG_S;
#pragma unroll
        for (int mt = 0; mt < 4; ++mt)
#pragma unroll
            for (int i = 0; i < 16; ++i) {
                const int dist = qrel - 16 * (32 * mt + (i & 3) + 8 * (i >> 2));
                const int di = dist < 0 ? 0 : (dist > 127 ? 127 : dist);
                const float v = dist >= 0 ? S[mt][i] * (0.125f * fa::LOG2E) + bth[di] : fa::NEG_S;
                S[mt][i] = v; tmax = fmaxf(tmax, v);
            }
        tmax = xhalf_max(tmax);
        const float mx = fmaxf(tmax, fa::M_INIT);
        float ps = 0.f;
#pragma unroll
        for (int mt = 0; mt < 4; ++mt)
#pragma unroll
            for (int i = 0; i < 16; ++i) { const float pv = __builtin_amdgcn_exp2f(S[mt][i] - mx); S[mt][i] = pv; ps += pv; }
        ps = xhalf_sum(ps);
        const float inv = ps > 0.f ? 1.f / ps : 0.f;
        {
            float own[16]; float prev = 0.f;
#pragma unroll
            for (int mt = 0; mt < 4; ++mt)
#pragma unroll
                for (int g4 = 0; g4 < 4; ++g4) {
                    const float qs = (S[mt][4 * g4] + S[mt][4 * g4 + 1]) + (S[mt][4 * g4 + 2] + S[mt][4 * g4 + 3]);
                    const auto sw = __builtin_amdgcn_permlane32_swap(__float_as_uint(S[mt][4 * g4 + 3]), __float_as_uint(S[mt][4 * g4 + 3]), false, false);
                    const float rl = __uint_as_float(h ? sw[0] : sw[1]);
                    const float extra = h ? rl : prev;
                    prev = rl;
                    own[4 * mt + g4] = (qs + extra) * inv;
                }
            float* ip = impp + ((size_t)(b * 6 + hh) * 32) * SEQ + s;
#pragma unroll
            for (int j = 0; j < 16; ++j) ip[(size_t)(2 * j + h) * SEQ] = own[j];
        }
        fa::f32x16 O[2];
#pragma unroll
        for (int dt = 0; dt < 2; ++dt)
#pragma unroll
            for (int i = 0; i < 16; ++i) O[dt][i] = 0.f;
#pragma unroll
        for (int mt = 0; mt < 4; ++mt)
#pragma unroll
            for (int s2 = 0; s2 < 2; ++s2) {
                const bf16x8_t pbk = pack8f(S[mt][8 * s2 + 0], S[mt][8 * s2 + 1], S[mt][8 * s2 + 2], S[mt][8 * s2 + 3], S[mt][8 * s2 + 4], S[mt][8 * s2 + 5], S[mt][8 * s2 + 6], S[mt][8 * s2 + 7]);
#pragma unroll
                for (int dt = 0; dt < 2; ++dt) {
                    const LAS unsigned char* vp = vl + (32 * dt + r) * VS + (32 * mt + 16 * s2 + 4 * h) * 2;
                    const u32x2 lo = *(const LAS u32x2*)vp, hi = *(const LAS u32x2*)(vp + 16);
                    const u32x4 av = {lo.x, lo.y, hi.x, hi.y};
                    O[dt] = FA_MFMA(__builtin_bit_cast(bf16x8_t, av), pbk, O[dt]);
                }
            }
        const float gate = sigmoidf_(gate_logit) * inv;
        float* op = ycat + t * D + 640 + hh * 64;
#pragma unroll
        for (int dt = 0; dt < 2; ++dt)
#pragma unroll
            for (int g4 = 0; g4 < 4; ++g4)
                *(f32x4*)(op + 32 * dt + 8 * g4 + 4 * h) = (f32x4){O[dt][4 * g4] * gate, O[dt][4 * g4 + 1] * gate, O[dt][4 * g4 + 2] * gate, O[dt][4 * g4 + 3] * gate};
    }
    __syncthreads();
}

__device__ __forceinline__ void cvt_layer(const Params& p, int l, int which, CvtCursor& cur, bf16_t* WB, LAS float* scr, int gwv, int nwv, int lane) {
    bf16_t* wl = WB + (size_t)l * WL_SIZE;
    if (which != 2) cvt_matrix<true>(cur, p.in[IN_XWKV] + (size_t)l * D * 2048, D, 2048, wl + WL_XWKV, D, 2048, 0, scr, gwv, nwv, lane);
    if (which == 1) return;
    cvt_matrix<false>(cur, p.in[IN_WIN] + (size_t)l * D * INC, D, INC, wl + WL_WIN, D, 1792, 0, scr, gwv, nwv, lane, l ? p.in[IN_MIXN] + D : nullptr);
    cvt_matrix<true>(cur, p.in[IN_MWUQ] + (size_t)l * 192 * 576, 192, 576, wl + WL_WUQ, 256, 768, 0, scr, gwv, nwv, lane);
    cvt_matrix<true>(cur, p.in[IN_MWUKV] + (size_t)l * 128 * 768, 128, 768, wl + WL_WUKV, 256, 768, 0, scr, gwv, nwv, lane);
    cvt_matrix<true>(cur, p.in[IN_SGLU] + (size_t)l * 256 * 256, 256, 256, wl + WL_WGLU, 256, 256, 0, scr, gwv, nwv, lane);
    cvt_matrix<true>(cur, p.in[IN_WOUT] + (size_t)l * D * D, D, D, wl + WL_WOUT, D, D, 0, scr, gwv, nwv, lane);
    cvt_matrix<true>(cur, p.in[IN_XWQ] + (size_t)l * D * D, D, D, wl + WL_XWQ, D, D, 0, scr, gwv, nwv, lane, p.in[IN_XN] + (size_t)l * D);
    cvt_matrix<true>(cur, p.in[IN_XWO] + (size_t)l * D * D, D, D, wl + WL_XWO, D, D, 0, scr, gwv, nwv, lane);
    cvt_matrix<true>(cur, p.in[IN_NW1] + (size_t)(l * 2) * 2048 * 64, 2048, 64, wl + WL_CW1, 2048, 64, 0, scr, gwv, nwv, lane);
    cvt_matrix<true>(cur, p.in[IN_NW1] + (size_t)(l * 2 + 1) * 2048 * 64, 2048, 64, wl + WL_CW1 + 64 * 2048, 2048, 64, 0, scr, gwv, nwv, lane);
}
__device__ __forceinline__ void ph_convert_small(const Params& p, bf16_t* WB, LAS unsigned char* lds) {
    GT_DECL
    LAS float* scr = (LAS float*)(lds + (tid >> 6) * 16384);
    CvtCursor cur{0};
    cvt_layer(p, 0, 0, cur, WB, scr, gw, NW, lane);
    cvt_layer(p, 1, 1, cur, WB, scr, gw, NW, lane);
    cvt_matrix<true>(cur, p.in[IN_DWG], D, FFD, WB + WD_GU, D, FFD, 1, scr, gw, NW, lane, p.in[IN_FFN]);
    cvt_matrix<true>(cur, p.in[IN_DWU], D, FFD, WB + WD_GU, D, FFD, 2, scr, gw, NW, lane, p.in[IN_FFN]);
    cvt_matrix<true>(cur, p.in[IN_DWD], FFD, D, WB + WD_DN, FFD, D, 0, scr, gw, NW, lane);
}
__device__ __forceinline__ void ph_convert_l1(const Params& p, bf16_t* WB, LAS unsigned char* lds) {
    const int half = (int)gridDim.x / 2;
    if ((int)blockIdx.x < half) return;
    const int tid = tid_(), lane = tid & 63;
    LAS float* scr = (LAS float*)(lds + (tid >> 6) * 16384);
    CvtCursor cur{0};
    cvt_layer(p, 1, 2, cur, WB, scr, ((int)blockIdx.x - half) * (NTHR / 64) + (tid >> 6), ((int)gridDim.x - half) * (NTHR / 64), lane);
}
__device__ __forceinline__ void ph_convert_moe(const Params& p, bf16_t* MW, LAS unsigned char* lds, int e_lo, int e_hi, bool skip0) {
    const int tid = tid_(), lane = tid & 63;
    if (skip0 && blockIdx.x == 0) return;
    const int gwv = ((int)blockIdx.x - (skip0 ? 1 : 0)) * (NTHR / 64) + (tid >> 6), nwv = ((int)gridDim.x - (skip0 ? 1 : 0)) * (NTHR / 64);
    LAS float* scr = (LAS float*)(lds + (tid >> 6) * 16384);
    CvtCursor cur{0};
    for (int e = e_lo; e < e_hi; ++e) {
        bf16_t* we = MW + (size_t)e * ME_SIZE;
        cvt_matrix<true>(cur, p.in[IN_MWG] + (size_t)e * D * FFE, D, FFE, we + ME_GU, D, FFE, 1, scr, gwv, nwv, lane);
        cvt_matrix<true>(cur, p.in[IN_MWU] + (size_t)e * D * FFE, D, FFE, we + ME_GU, D, FFE, 2, scr, gwv, nwv, lane);
        cvt_matrix<true>(cur, p.in[IN_MWD] + (size_t)e * FFE * D, FFE, D, we + ME_DN, FFE, D, 0, scr, gwv, nwv, lane);
    }
}

constexpr int LDS_BYTES = 147456;
constexpr int LDS_MISC = 131072;
enum { P_PRO = 0, P_PROJ0, L0_BASE, L0_GU = L0_BASE + 8, L0_DN, L1_PROJ, L1_BASE, L1_ROUTE = L1_BASE + 8, L1_SORT, M_BASE, P_FINAL = M_BASE + 2 * MOE_NR, NPHASE };

__global__ void __launch_bounds__(NTHR, 2) fwd_kernel(Params p) {
    extern __shared__ __attribute__((aligned(16))) unsigned char lds_raw[];
    LAS unsigned char* lds = (LAS unsigned char*)lds_raw;
    volatile LAS unsigned* misc = (volatile LAS unsigned*)(lds + LDS_MISC);
    if (threadIdx.x < 64) misc[threadIdx.x] = 0u;
    __syncthreads();
    unsigned char* ws = p.ws;
    unsigned* ctl = (unsigned*)(ws + WS_CTL);
    XcdBarrier bar; bar.bar = ctl + 4096; bar.x = 0; bar.st = nullptr;
    const int lo = p.ph_lo, hi = p.ph_hi;
    if (hi - lo > 1) bar = xcd_barrier_post(ctl + 4096, misc + 8);
#define PH(k) if (lo <= (k) && (k) < hi)
#define ENDPH(k) if ((k) + 1 < hi) xcd_barrier(bar);

    bf16_t* HB = (bf16_t*)(ws + WS_H);
    bf16_t* XNB = (bf16_t*)(ws + WS_XNB);
    bf16_t* CQNB = (bf16_t*)(ws + XB_CQN);
    bf16_t* CKVNB = (bf16_t*)(ws + XB_CKVN);
    bf16_t* YPREB = (bf16_t*)(ws + XB_YPRE);
    bf16_t* YCATB = (bf16_t*)(ws + WS_XNB);
    bf16_t* KVXB = (bf16_t*)(ws + WS_KVX);
    float* PROJ = (float*)(ws + BG_PROJ);
    bf16_t* NKVB = (bf16_t*)(ws + BG_NKVB);
    bf16_t* QMB = (bf16_t*)(ws + BG_QMLA);
    bf16_t* NQB = (bf16_t*)(ws + BG_NQB);
    bf16_t* KVMB = (bf16_t*)(ws + BG_KVMB);
    bf16_t* KRB = (bf16_t*)(ws + BG_KRB);
    float* YCAT = (float*)(ws + BG_YCAT);
    bf16_t* MEMNB = (bf16_t*)(ws + BG_MEMN);
    bf16_t* QXB = (bf16_t*)(ws + BG_QX);
    bf16_t* OXB = (bf16_t*)(ws + BG_OX);
    bf16_t* ACTB = (bf16_t*)(ws + BG_ACT);
    bf16_t* MACTB = (bf16_t*)(ws + MOE_ACT);
    bf16_t* YSB = (bf16_t*)(ws + MOE_YS);
    float* YS2P = (float*)(ws + MOE_YS2P);
    float* IMPP = (float*)(ws + SM_IMPP);
    float* ROPE = (float*)(ws + SM_ROPE);
    f32x2* SSME = (f32x2*)(ws + SM_SSME);
    bf16_t* KCB = (bf16_t*)(ws + SM_KC);
    bf16_t* VCT = (bf16_t*)(ws + SM_KC + 512 * 1024);
    float* PEB = (float*)(ws + SM_HID);
    unsigned* SEL = (unsigned*)(ws + SM_SEL);
    int* TOPI = (int*)(ws + SM_TOPI);
    float* TOPW = (float*)(ws + SM_TOPW);
    int* POS = (int*)(ws + SM_POS);
    int* RSRC = (int*)(ws + SM_RSRC);
    int* TEXP = (int*)(ws + SM_TEXP);
    bf16_t* WB = (bf16_t*)(ws + WS_WBS);
    bf16_t* MW = (bf16_t*)(ws + MOE_W);
#define QCTR(k) (ctl + 8192 + 64 * (k))
#define PG8_RUN_ROT(ROT, EPI_T, GATH, Aptr, Btptr, Kval, ridx, texp_, estr, nM_, nN_, pm0_, ...) do { \
    pg8::Gemm g_{Aptr, Btptr, Kval, ridx, texp_, estr}; pg8::StaticOrder S_; S_.init(nM_, nN_, (int)gridDim.x, (int)((blockIdx.x + gridDim.x - (ROT)) % gridDim.x), pm0_); \
    EPI_T E_{__VA_ARGS__}; pg8::gemm_phase<EPI_T, GATH>(lds, g_, S_, E_); } while (0)
#define PG8_RUN(...) PG8_RUN_ROT(0, __VA_ARGS__)
#define PG8_RUN_SPLITK(EPI_T, Aptr, Btptr, Kslice, ld_, nks_, texp_, estr, nM_, nNr_, pm0_, ...) do { \
    pg8::Gemm g_{Aptr, Btptr, Kslice, nullptr, texp_, estr, ld_, nks_, nNr_}; pg8::StaticOrder S_; S_.init(nM_, (nNr_) * (nks_), (int)gridDim.x, (int)blockIdx.x, pm0_); \
    EPI_T E_{__VA_ARGS__}; pg8::gemm_phase<EPI_T, false>(lds, g_, S_, E_); } while (0)

    float* SSQ = (float*)(ws + SM_KROPE);
    PH(P_PRO) {
        ph_rope_table(ROPE);
        ph_pe_bias(p, PEB);
        ph_rms(p.in[IN_MEM], p.in[IN_MEMN], MEMNB, NB * 256);
        ph_rms(p.in[IN_MEM], p.in[IN_MEMN] + D, MEMNB + (size_t)NB * 256 * D, NB * 256);
        ph_rms(p.in[IN_X], p.in[IN_MIXN], XNB, T);
        ph_convert_small(p, WB, lds);
        ENDPH(P_PRO)
    }
    PH(P_PROJ0) {
        PG8_RUN(pg8::EpiProj, false, XNB, WB + WL_WIN, D, nullptr, nullptr, 0, 64, 7, 0, PROJ, INLD, NKVB, nullptr, NQB);
        PG8_RUN_ROT(192, pg8::EpiBf16, false, MEMNB, WB + WL_XWKV, D, nullptr, nullptr, 0, 8, 8, 0, KVXB, 2048);
        ENDPH(P_PROJ0)
    }
#define LAYER_BODY(l, B0, HIN, XO_EPI, EXTRA_XQ) \
    PH(B0 + 0) { ph_mla_prep(PROJ, p.in[IN_MQN] + (l) * 192, p.in[IN_MKVN] + (l) * 128, ROPE, CQNB, CKVNB, KRB); ph_ssm1(p, l, PROJ, SSME, lds); ph_cmp_mfma(p, l, NKVB, WB + (size_t)(l) * WL_SIZE + WL_CW1, PEB, KCB, VCT, lds); ENDPH(B0 + 0) } \
    PH(B0 + 1) { PG8_RUN(pg8::EpiBf16, false, CQNB, WB + (size_t)(l) * WL_SIZE + WL_WUQ, 256, nullptr, nullptr, 0, 64, 3, 0, QMB, 768); \
                 PG8_RUN_ROT(64, pg8::EpiBf16, false, CKVNB, WB + (size_t)(l) * WL_SIZE + WL_WUKV, 256, nullptr, nullptr, 0, 64, 3, 0, KVMB, 768); \
                 ph_nsa_cmp_mfma(p, PROJ, NQB, KCB, VCT, IMPP, YCAT, lds); ph_ssm2(p, l, PROJ, SSME, YPREB, lds); ENDPH(B0 + 1) } \
    PH(B0 + 2) { PG8_RUN(pg8::EpiGlu, false, YPREB, WB + (size_t)(l) * WL_SIZE + WL_WGLU, 256, nullptr, nullptr, 0, 64, 1, 0, YCAT, D, YPREB); KVX1_HERE \
                 fa::ph_attn_merged(lds, QCTR(3 * (l)), QMB, KVMB, KRB, ROPE, PROJ, NQB, NKVB, IMPP, p.in[IN_RELB], YCAT); ENDPH(B0 + 2) } \
    PH(B0 + 3) { ph_group_norm(YCAT, p.in[IN_OUTN] + (l) * D, YCATB); ENDPH(B0 + 3) } \
    PH(B0 + 4) { PG8_RUN(pg8::EpiResNorm, false, YCATB, WB + (size_t)(l) * WL_SIZE + WL_WOUT, D, nullptr, nullptr, 0, 64, 4, 0, HB, HIN, D, SSQ); ENDPH(B0 + 4) } \
    PH(B0 + 5) { PG8_RUN(pg8::EpiBf16, false, HB, WB + (size_t)(l) * WL_SIZE + WL_XWQ, D, nullptr, nullptr, 0, 64, 4, 0, QXB, D, SSQ); EXTRA_XQ ENDPH(B0 + 5) } \
    PH(B0 + 6) { fa::ph_xattn_mfma(lds, QCTR(3 * (l) + 2), QXB, KVXB + (size_t)(l) * 2048 * 2048, OXB); ENDPH(B0 + 6) } \
    PH(B0 + 7) { XO_EPI ENDPH(B0 + 7) }

#define KVX1_HERE PG8_RUN_ROT(64, pg8::EpiBf16, false, MEMNB + (size_t)NB * 256 * D, WB + WL_SIZE + WL_XWKV, D, nullptr, nullptr, 0, 8, 8, 0, KVXB + (size_t)2048 * 2048, 2048);
    LAYER_BODY(0, L0_BASE, p.in[IN_X], PG8_RUN(pg8::EpiResNorm, false, OXB, WB + WL_XWO, D, nullptr, nullptr, 0, 64, 4, 0, HB, nullptr, D, SSQ);, )
    PH(L0_GU) { PG8_RUN(pg8::EpiSwiglu, false, HB, WB + WD_GU, D, nullptr, nullptr, 0, 64, 22, 0, ACTB, FFD, 0, SSQ); ph_convert_l1(p, WB, lds); ENDPH(L0_GU) }
    PH(L0_DN) { PG8_RUN(pg8::EpiResNorm, false, ACTB, WB + WD_DN, FFD, nullptr, nullptr, 0, 64, 4, 0, HB, nullptr, D, SSQ); ENDPH(L0_DN) }
    PH(L1_PROJ) { PG8_RUN(pg8::EpiProj, false, HB, WB + WL_SIZE + WL_WIN, D, nullptr, nullptr, 0, 64, 7, 0, PROJ, INLD, NKVB, SSQ, NQB); ENDPH(L1_PROJ) }
#undef KVX1_HERE
#define KVX1_HERE
    LAYER_BODY(1, L1_BASE, nullptr, PG8_RUN(pg8::EpiResNorm, false, OXB, WB + WL_SIZE + WL_XWO, D, nullptr, nullptr, 0, 64, 4, 0, HB, nullptr, D, nullptr);, ph_convert_moe(p, MW, lds, 0, 6, false);)
    PH(L1_ROUTE) { ph_moe_route(HB, p.in[IN_FFN] + D, p.in[IN_ROUTER], XNB, TOPI, TOPW); ENDPH(L1_ROUTE) }
    PH(L1_SORT) { ph_moe_sort((LAS int*)lds, TOPI, POS, RSRC, TEXP); ph_convert_moe(p, MW, lds, 6, NE, true); ENDPH(L1_SORT) }
#define MOE_ROUND(r) \
    PH(M_BASE + 2 * (r)) { const int ntl_ = TEXP[160] - (r) * MOE_RT; const int nm_ = ntl_ < 0 ? 0 : (ntl_ > MOE_RT ? MOE_RT : ntl_); \
        PG8_RUN(pg8::EpiSwiglu, true, XNB, MW + ME_GU, D, RSRC, TEXP, ME_SIZE, nm_, 28, (r) * MOE_RT, MACTB, FFE, (r) * MOE_RT * 256, nullptr); ENDPH(M_BASE + 2 * (r)) } \
    PH(M_BASE + 1 + 2 * (r)) { const int ntl_ = TEXP[160] - (r) * MOE_RT; const int nm_ = ntl_ < 0 ? 0 : (ntl_ > MOE_RT ? MOE_RT : ntl_); \
        PG8_RUN(pg8::EpiBf16, false, MACTB - (size_t)(r) * MOE_RT * 256 * FFE, MW + ME_DN, FFE, nullptr, TEXP, ME_SIZE, nm_, 4, (r) * MOE_RT, YSB, D); ENDPH(M_BASE + 1 + 2 * (r)) }
    MOE_ROUND(0) MOE_ROUND(1)
    PH(M_BASE + 4) { const int ntl_ = TEXP[160] - 2 * MOE_RT; const int nm_ = ntl_ < 0 ? 0 : (ntl_ > MOE_RT ? MOE_RT : ntl_);
        PG8_RUN(pg8::EpiSwiglu, true, XNB, MW + ME_GU, D, RSRC, TEXP, ME_SIZE, nm_, 28, 2 * MOE_RT, MACTB, FFE, 2 * MOE_RT * 256, nullptr); ENDPH(M_BASE + 4) }
    PH(M_BASE + 5) { const int ntl_ = TEXP[160] - 2 * MOE_RT; const int nm_ = ntl_ < 0 ? 0 : (ntl_ > MOE_RT ? MOE_RT : ntl_);
        PG8_RUN_SPLITK(pg8::EpiF32Slab, MACTB - (size_t)2 * MOE_RT * 256 * FFE, MW + ME_DN, FFE / 4, FFE, 4, TEXP, ME_SIZE, nm_, 4, 2 * MOE_RT, YS2P, D, (size_t)2048 * D, 2 * MOE_RT * 256); ENDPH(M_BASE + 5) }
    PH(P_FINAL) { ph_moe_combine_final(HB, YSB, YS2P, POS, TOPW, p.in[IN_FINAL], p.out); }
}

extern "C" void kernel_launch(void* const* d_in, const int* in_sizes, int n_in, void* d_out, int out_size, void* d_ws, size_t ws_size, hipStream_t stream) {
    static int grid = 0;
    if (grid == 0) {
        if (n_in != 37 || out_size != T * D || ws_size < WS_END) { fprintf(stderr, "kernel_launch: unexpected shapes: n_in %d out %d ws %zu (need %zu)\n", n_in, out_size, ws_size, (size_t)WS_END); grid = -1; return; }
        int dev = 0, cus = 0;
        if (hipGetDevice(&dev) != hipSuccess || hipDeviceGetAttribute(&cus, hipDeviceAttributeMultiprocessorCount, dev) != hipSuccess) { grid = -1; return; }
        if (hipFuncSetAttribute((const void*)fwd_kernel, hipFuncAttributeMaxDynamicSharedMemorySize, LDS_BYTES) != hipSuccess) { fprintf(stderr, "kernel_launch: hipFuncSetAttribute failed\n"); grid = -1; return; }
        int per_cu = 0;
        if (hipOccupancyMaxActiveBlocksPerMultiprocessor(&per_cu, (const void*)fwd_kernel, NTHR, LDS_BYTES) != hipSuccess || per_cu < 1) fprintf(stderr, "kernel_launch: occupancy query says %d\n", per_cu);
        (void)hipGetLastError();
        grid = cus;
    }
    if (grid < 0) return;
    (void)hipMemsetAsync((char*)d_ws + WS_CTL, 0, CTL_BYTES, stream);
    Params p{};
    for (int i = 0; i < 37; ++i) p.in[i] = (const float*)d_in[i];
    p.out = (float*)d_out; p.ws = (unsigned char*)d_ws;
#if MK_ONE_LAUNCH
    p.ph_lo = 0; p.ph_hi = NPHASE;
    hipLaunchKernelGGL(fwd_kernel, dim3(grid), dim3(NTHR), LDS_BYTES, stream, p);
#else
    for (int k = 0; k < NPHASE; ++k) { p.ph_lo = k; p.ph_hi = k + 1; hipLaunchKernelGGL(fwd_kernel, dim3(grid), dim3(NTHR), LDS_BYTES, stream, p); }
#endif
}
```

```cpp
#include <hip/hip_runtime.h>
#include <cstdio>
#include <cstdint>

#ifndef MK_ONE_LAUNCH
#define MK_ONE_LAUNCH 1
#endif

#define LAS __attribute__((address_space(3)))
typedef float f32x4 __attribute__((ext_vector_type(4)));
typedef float f32x2 __attribute__((ext_vector_type(2)));
typedef unsigned short bf16_t;
typedef unsigned u32x2 __attribute__((ext_vector_type(2)));
typedef unsigned u32x4 __attribute__((ext_vector_type(4)));
typedef __bf16 bf16v2_t __attribute__((ext_vector_type(2)));
__device__ __forceinline__ unsigned pk_bf16(float lo, float hi) { const f32x2 v = {lo, hi}; return __builtin_bit_cast(unsigned, __builtin_convertvector(v, bf16v2_t)); }
__device__ __forceinline__ bf16_t f2bf(float f) { return (bf16_t)(pk_bf16(f, 0.f) & 0xffffu); }
__device__ __forceinline__ float bf2f(bf16_t b) { return __uint_as_float(((unsigned)b) << 16); }
__device__ __forceinline__ float bflo(unsigned u) { return __uint_as_float(u << 16); }
__device__ __forceinline__ float bfhi(unsigned u) { return __uint_as_float(u & 0xffff0000u); }
typedef short bf16x8_t __attribute__((ext_vector_type(8)));
typedef __bf16 bfv8_t __attribute__((ext_vector_type(8)));
typedef float f32x8_t __attribute__((ext_vector_type(8)));
__device__ __forceinline__ bf16x8_t pack8f(float a0, float a1, float a2, float a3, float a4, float a5, float a6, float a7) {
    const f32x8_t v = {a0, a1, a2, a3, a4, a5, a6, a7};
    return __builtin_bit_cast(bf16x8_t, __builtin_convertvector(v, bfv8_t));
}
__device__ __forceinline__ float xhalf_max(float x) { const auto r = __builtin_amdgcn_permlane32_swap(__float_as_uint(x), __float_as_uint(x), false, false); return fmaxf(__uint_as_float(r[0]), __uint_as_float(r[1])); }
__device__ __forceinline__ float xhalf_sum(float x) { const auto r = __builtin_amdgcn_permlane32_swap(__float_as_uint(x), __float_as_uint(x), false, false); return __uint_as_float(r[0]) + __uint_as_float(r[1]); }
__device__ __forceinline__ int tid_() { int t = threadIdx.x; asm volatile("" : "+v"(t)); return t; }

constexpr int NB = 8, SEQ = 2048, T = NB * SEQ, D = 1024;
constexpr int INC = 1778, INLD = 1792;
constexpr int O_U = 0, O_CQ = 256, O_CKV = 448, O_KR = 576, O_NQ = 608, O_NKV = 992, O_NG = 1760;
constexpr int NBC = 127;
constexpr int FFD = 2816, FFE = 3584, NE = 8;
constexpr int MOE_ROWS = 2 * T + NE * 256;
constexpr int MOE_TILES = MOE_ROWS / 256;
constexpr int MOE_NR = 3, MOE_RT = 64;
constexpr float EPS = 1e-6f;
constexpr int NTHR = 512;

constexpr size_t MiB = 1u << 20;
constexpr size_t WS_CTL = 0, CTL_BYTES = 1 * MiB;
constexpr size_t WS_SMALL = 1 * MiB;
constexpr size_t SM_ROPE = WS_SMALL;
constexpr size_t SM_SSME = SM_ROPE + 256 * 1024;
constexpr size_t SM_KC = SM_SSME + 2 * MiB;
constexpr size_t SM_HID = SM_KC + 2 * MiB;
constexpr size_t SM_SEL = SM_HID + 2 * MiB;
constexpr size_t SM_TOPI = SM_SEL + 256 * 1024;
constexpr size_t SM_TOPW = SM_TOPI + 256 * 1024;
constexpr size_t SM_POS = SM_TOPW + 256 * 1024;
constexpr size_t SM_RSRC = SM_POS + 256 * 1024;
constexpr size_t SM_TEXP = SM_RSRC + 256 * 1024;
constexpr size_t SM_KROPE = SM_TEXP + 256 * 1024;
constexpr size_t SM_IMPP = SM_KROPE + 2 * MiB;
static_assert(SM_IMPP + 12 * MiB <= 25 * MiB, "small region");
constexpr size_t WS_H = 25 * MiB;
constexpr size_t WS_XNB = 89 * MiB;
constexpr size_t XB_CQN = WS_XNB, XB_CKVN = WS_XNB + 8 * MiB, XB_YPRE = WS_XNB + 16 * MiB;
constexpr size_t WS_WBS = 121 * MiB;
constexpr size_t WS_KVX = 169 * MiB;
constexpr size_t WS_R = 201 * MiB;
constexpr size_t BG_PROJ = WS_R, BG_NKVB = WS_R + 112 * MiB, BG_QMLA = WS_R + 136 * MiB, BG_NQB = WS_R + 160 * MiB, BG_KVMB = WS_R + 184 * MiB, BG_YCAT = WS_R + 208 * MiB, BG_KRB = WS_R + 272 * MiB;
constexpr size_t BG_MEMN = WS_R + 275 * MiB;
constexpr size_t BG_QX = WS_R, BG_OX = WS_R + 64 * MiB;
constexpr size_t BG_ACT = WS_R;
constexpr size_t MOE_ACT = 121 * MiB;
constexpr size_t MOE_YS = 233 * MiB;
constexpr size_t MOE_YS2P = 297 * MiB;
constexpr size_t MOE_W = 331 * MiB;
constexpr size_t WS_END = 499 * MiB;

constexpr size_t WL_WIN = 0, WL_WUQ = WL_WIN + (size_t)1792 * 1024, WL_WUKV = WL_WUQ + 768 * 256, WL_WGLU = WL_WUKV + 768 * 256, WL_WOUT = WL_WGLU + 256 * 256,
                 WL_XWQ = WL_WOUT + 1024 * 1024, WL_XWKV = WL_XWQ + 1024 * 1024, WL_XWO = WL_XWKV + 2048 * 1024, WL_CW1 = WL_XWO + 1024 * 1024, WL_SIZE = WL_CW1 + 2 * 64 * 2048;
constexpr size_t WD_GU = 2 * WL_SIZE, WD_DN = WD_GU + (size_t)5632 * 1024, W_SMALL_END = WD_DN + (size_t)1024 * 2816;
static_assert(W_SMALL_END * 2 <= 48 * MiB, "small weights fit");
constexpr size_t ME_GU = 0, ME_DN = (size_t)7168 * 1024, ME_SIZE = ME_DN + (size_t)1024 * 3584;
static_assert(MOE_W + ME_SIZE * 8 * 2 <= WS_END, "moe weights fit");
#ifndef USE_PG8
#define USE_PG8 2
#endif

#define XB_TMO      128
#define XB_XCNT(j)  (256  + 64 * (j))
#define XB_XSUB(j)  (1280 + 64 * (j))
#define XB_XGEN(j)  (2304 + 64 * (j))
#define XB_TOP      3328
#define XB_TOPGEN   3392
#define XCD_BAR_WORDS 3456
#define XB_SPIN_CAP (1u << 22)
__device__ __forceinline__ unsigned xb_ld(unsigned* p)              { return __hip_atomic_load(p, __ATOMIC_RELAXED, __HIP_MEMORY_SCOPE_AGENT); }
__device__ __forceinline__ unsigned xb_add(unsigned* p, unsigned v) { return __hip_atomic_fetch_add(p, v, __ATOMIC_RELAXED, __HIP_MEMORY_SCOPE_AGENT); }
__device__ __forceinline__ unsigned xb_xcc_id() { return (unsigned)__builtin_amdgcn_s_getreg((3 << 11) | 20) & 0xFu; }
#define XB_SPIN(cond, bar) do { unsigned _sp = 0; while (cond) { __builtin_amdgcn_s_sleep(1); \
    if ((++_sp & 255u) == 0u) { if (xb_ld(&(bar)[XB_TMO])) break; if (_sp > XB_SPIN_CAP) { atomicAdd(&(bar)[XB_TMO], 1u); break; } } } } while (0)
struct XcdBarrier { unsigned* bar; unsigned x; volatile LAS unsigned* st; };
__device__ __forceinline__ XcdBarrier xcd_barrier_post(unsigned* bar, volatile LAS unsigned* st) {
    XcdBarrier b; b.bar = bar; b.x = xb_xcc_id(); b.st = st;
    if (threadIdx.x == 0) (void)xb_add(&bar[XB_XCNT(b.x)], 1u);
    return b;
}
__device__ __forceinline__ void xcd_barrier_complete(unsigned* bar, unsigned x, unsigned& nloc, unsigned& nx) {
    const unsigned G = gridDim.x * gridDim.y * gridDim.z;
    unsigned sum, cnt, mine, sp = 0u;
    for (;;) {
        sum = 0u; cnt = 0u; mine = 0u;
#pragma unroll
        for (unsigned j = 0; j < 16; ++j) { const unsigned c = xb_ld(&bar[XB_XCNT(j)]); sum += c; cnt += (c > 0u) ? 1u : 0u; mine = (j == x) ? c : mine; }
        if (sum == G) break;
        __builtin_amdgcn_s_sleep(1);
        if ((++sp & 255u) == 0u) { if (xb_ld(&bar[XB_TMO])) break; if (sp > XB_SPIN_CAP) { atomicAdd(&bar[XB_TMO], 1u); break; } }
    }
    nloc = mine > 0u ? mine : 1u; nx = cnt > 0u ? cnt : 1u;
}
__device__ __forceinline__ void xcd_barrier(const XcdBarrier& b) {
    asm volatile("s_waitcnt vmcnt(0)" ::: "memory");
    __syncthreads();
    if (threadIdx.x == 0) {
        unsigned* bar = b.bar;
        __builtin_amdgcn_s_waitcnt(0);
        unsigned nloc = b.st[0], nx = b.st[1];
        if (nloc == 0u) { xcd_barrier_complete(bar, b.x, nloc, nx); b.st[0] = nloc; b.st[1] = nx; }
        const unsigned old = xb_add(&bar[XB_XSUB(b.x)], 1u);
        const unsigned gen = old / nloc;
        if (old + 1u == (gen + 1u) * nloc) {
            __builtin_amdgcn_fence(__ATOMIC_RELEASE, "agent");
            asm volatile("s_waitcnt vmcnt(0)" ::: "memory");
            const unsigned og = xb_add(&bar[XB_TOP], 1u);
            const unsigned tg = og / nx;
            if (og + 1u == (tg + 1u) * nx) xb_add(&bar[XB_TOPGEN], 1u);
            else XB_SPIN(xb_ld(&bar[XB_TOPGEN]) == tg, bar);
            __builtin_amdgcn_fence(__ATOMIC_ACQUIRE, "agent");
            xb_add(&bar[XB_XGEN(b.x)], 1u);
            asm volatile("s_waitcnt vmcnt(0)" ::: "memory");
        } else {
            XB_SPIN(xb_ld(&bar[XB_XGEN(b.x)]) == gen, bar);
            __builtin_amdgcn_fence(__ATOMIC_ACQUIRE, "agent");
            asm volatile("s_waitcnt vmcnt(0)" ::: "memory");
        }
    }
    __syncthreads();
}

template <int CTRL> __device__ __forceinline__ float dpp_mov(float v) { return __uint_as_float(__builtin_amdgcn_update_dpp(0u, __float_as_uint(v), CTRL, 0xf, 0xf, true)); }
__device__ __forceinline__ float wave_sum(float v) {
    v += dpp_mov<0xB1>(v); v += dpp_mov<0x4E>(v); v += dpp_mov<0x124>(v); v += dpp_mov<0x128>(v);
    v += __shfl_xor(v, 16);
    const auto r = __builtin_amdgcn_permlane32_swap(__float_as_uint(v), __float_as_uint(v), false, false);
    return __uint_as_float(r[0]) + __uint_as_float(r[1]);
}
__device__ __forceinline__ float wave_max(float v) {
    v = fmaxf(v, dpp_mov<0xB1>(v)); v = fmaxf(v, dpp_mov<0x4E>(v)); v = fmaxf(v, dpp_mov<0x124>(v)); v = fmaxf(v, dpp_mov<0x128>(v));
    v = fmaxf(v, __shfl_xor(v, 16));
    const auto r = __builtin_amdgcn_permlane32_swap(__float_as_uint(v), __float_as_uint(v), false, false);
    return fmaxf(__uint_as_float(r[0]), __uint_as_float(r[1]));
}
__device__ __forceinline__ float sigmoidf_(float x) { return __builtin_amdgcn_rcpf(1.f + __expf(-x)); }
__device__ __forceinline__ float gelu_tanh(float x) {
    const float u = 0.7978845608028654f * (x + 0.044715f * x * x * x);
    const float th = 1.f - 2.f * __builtin_amdgcn_rcpf(__expf(2.f * u) + 1.f);
    return 0.5f * x * (1.f + th);
}
__device__ __forceinline__ void sincos_d(double ang, float& s, float& c) {
    double rev = ang * 0.15915494309189535;
    rev -= floor(rev);
    const float r = (float)rev;
    s = __builtin_amdgcn_sinf(r); c = __builtin_amdgcn_cosf(r);
}
__device__ __forceinline__ int t5_bucket(int dist) {
    const int n = dist < 0 ? 0 : dist;
    if (n < 16) return n;
    const int lg = 16 + (int)(__logf((float)n * 0.0625f) * (16.0f / 2.0794415416798357f));
    return lg < 31 ? lg : 31;
}

struct Params {
    const float* in[37];
    float* out;
    unsigned char* ws;
    int ph_lo, ph_hi;
};
#define IN_X 0
#define IN_MEM 1
#define IN_WIN 2
#define IN_WOUT 3
#define IN_MIXN 4
#define IN_OUTN 5
#define IN_SARE 6
#define IN_SAIM 7
#define IN_SBRE 8
#define IN_SBIM 9
#define IN_SCRE 10
#define IN_SCIM 11
#define IN_SD 12
#define IN_SLDT 13
#define IN_SGLU 14
#define IN_MQN 15
#define IN_MWUQ 16
#define IN_MKVN 17
#define IN_MWUKV 18
#define IN_NPE 19
#define IN_NW1 20
#define IN_NW2 21
#define IN_RELB 22
#define IN_XN 23
#define IN_MEMN 24
#define IN_XWQ 25
#define IN_XWKV 26
#define IN_XWO 27
#define IN_FFN 28
#define IN_DWG 29
#define IN_DWU 30
#define IN_DWD 31
#define IN_ROUTER 32
#define IN_MWG 33
#define IN_MWU 34
#define IN_MWD 35
#define IN_FINAL 36

#define GT_DECL const int tid = tid_(), lane = tid & 63; const int gt = blockIdx.x * NTHR + tid, NT = gridDim.x * NTHR; const int gw = gt >> 6, NW = NT >> 6; (void)lane; (void)gw; (void)NW; (void)gt; (void)NT;

__device__ __forceinline__ void ph_rms(const float* src, const float* gain, bf16_t* dst, int rows) {
    GT_DECL
    for (int r = gw; r < rows; r += NW) {
        const f32x4* x = (const f32x4*)(src + (size_t)r * D) + lane;
        f32x4 v[4]; float s = 0.f;
#pragma unroll
        for (int j = 0; j < 4; ++j) { v[j] = x[64 * j]; s += v[j].x * v[j].x + v[j].y * v[j].y + v[j].z * v[j].z + v[j].w * v[j].w; }
        const float rstd = rsqrtf(wave_sum(s) * (1.f / D) + EPS);
        u32x2* o = (u32x2*)(dst + (size_t)r * D) + lane; const f32x4* g = (const f32x4*)gain + lane;
#pragma unroll
        for (int j = 0; j < 4; ++j) { const f32x4 gg = g[64 * j]; o[64 * j] = (u32x2){pk_bf16(v[j].x * rstd * gg.x, v[j].y * rstd * gg.y), pk_bf16(v[j].z * rstd * gg.z, v[j].w * rstd * gg.w)}; }
    }
}

template <int MODE, bool CBF>
__device__ __forceinline__ void gemm_naive(LAS float* lds, const bf16_t* A, int lda, const int* rowidx,
                                           const float* B, const float* B2, int ldb, size_t bstride, const int* tile_exp,
                                           void* Cv, int ldc, const void* Rv, int ldr, int N, int K, int tm_lo, int tm_hi, int crow_off) {
    const int tid = tid_();
    LAS float* As = lds;
    LAS float* Bs = lds + 16 * 132;
    LAS float* B2s = Bs + 16 * 64;
    const int ntn = (N + 63) / 64, ntiles = (tm_hi - tm_lo) * ntn;
    const int ty = tid >> 4, tx = tid & 15;
    for (int tile = blockIdx.x; tile < ntiles; tile += gridDim.x) {
        const int tm = tm_lo + tile / ntn, tn = tile % ntn;
        const int row0 = tm * 128, n0 = tn * 64;
        const float* Bp = B; const float* B2p = B2;
        if (tile_exp) { const int e = tile_exp[row0 >> 8]; if (e < 0) continue; Bp = B + (size_t)e * bstride; if (MODE == 2) B2p = B2 + (size_t)e * bstride; }
        float acc[4][4], acc2[4][4];
#pragma unroll
        for (int i = 0; i < 4; ++i)
#pragma unroll
            for (int j = 0; j < 4; ++j) { acc[i][j] = 0.f; acc2[i][j] = 0.f; }
        const int ar = tid >> 2, ak = (tid & 3) * 4;
        const int arow = rowidx ? rowidx[row0 + ar] : (row0 + ar);
        const bf16_t* Ap = A + (size_t)arow * lda + ak;
        for (int k0 = 0; k0 < K; k0 += 16) {
            const u32x2 av = *(const u32x2*)(Ap + k0);
            As[(ak + 0) * 132 + ar] = bflo(av.x); As[(ak + 1) * 132 + ar] = bfhi(av.x); As[(ak + 2) * 132 + ar] = bflo(av.y); As[(ak + 3) * 132 + ar] = bfhi(av.y);
#pragma unroll
            for (int i = 0; i < 2; ++i) {
                const int e = tid + i * 512, kk = e >> 6, nn = e & 63, col = n0 + nn;
                Bs[kk * 64 + nn] = col < N ? Bp[(size_t)(k0 + kk) * ldb + col] : 0.f;
                if (MODE == 2) B2s[kk * 64 + nn] = col < N ? B2p[(size_t)(k0 + kk) * ldb + col] : 0.f;
            }
            __syncthreads();
#pragma unroll
            for (int kk = 0; kk < 16; ++kk) {
                const f32x4 a = *(const LAS f32x4*)(As + kk * 132 + ty * 4);
                const f32x4 b = *(const LAS f32x4*)(Bs + kk * 64 + tx * 4);
                const float aa[4] = {a.x, a.y, a.z, a.w}, bb[4] = {b.x, b.y, b.z, b.w};
#pragma unroll
                for (int i = 0; i < 4; ++i)
#pragma unroll
                    for (int j = 0; j < 4; ++j) acc[i][j] += aa[i] * bb[j];
                if (MODE == 2) {
                    const f32x4 b2 = *(const LAS f32x4*)(B2s + kk * 64 + tx * 4);
                    const float bb2[4] = {b2.x, b2.y, b2.z, b2.w};
#pragma unroll
                    for (int i = 0; i < 4; ++i)
#pragma unroll
                        for (int j = 0; j < 4; ++j) acc2[i][j] += aa[i] * bb2[j];
                }
            }
            __syncthreads();
        }
#pragma unroll
        for (int i = 0; i < 4; ++i) {
            const int row = row0 + ty * 4 + i;
#pragma unroll
            for (int j = 0; j < 4; ++j) {
                const int col = n0 + tx * 4 + j;
                if (col < N) {
                    float v = acc[i][j];
                    if (MODE == 1) v += ((const float*)Rv)[(size_t)row * ldr + col];
                    if (MODE == 2) v = v * sigmoidf_(v) * acc2[i][j];
                    if (MODE == 3) v = bf2f(((const bf16_t*)Rv)[(size_t)row * ldr + col]) * sigmoidf_(v);
                    if (CBF) ((bf16_t*)Cv)[(size_t)(row - crow_off) * ldc + col] = f2bf(v);
                    else ((float*)Cv)[(size_t)(row - crow_off) * ldc + col] = v;
                }
            }
        }
    }
}

namespace pg8 {
#define PG8_LAS __attribute__((address_space(3)))
typedef short bf16x8 __attribute__((ext_vector_type(8)));
constexpr int BM = 256, BK = 64, HALF = 128, HTB = HALF * BK * 2, STAGE_BYTES = 8 * HTB, NXCD = 8, WGM = 8;
__host__ __device__ __forceinline__ int lds_byte(int r, int c) { const int st = (r >> 4) * 2 + (c >> 5), rr = r & 15, cc = c & 31, ob = rr * 64 + cc * 2; return st * 1024 + (ob ^ (((ob >> 9) & 1) << 5)); }
__host__ __device__ __forceinline__ void stage_rc(int b, int& R, int& C) { const int st = b / 1024, sb = b % 1024, swz = sb ^ (((sb >> 9) & 1) << 5); R = (st >> 1) * 16 + swz / 64; C = (st & 1) * 32 + (swz % 64) / 2; }
__host__ __device__ __forceinline__ int perm32(int rho) { const int n = rho >> 4, i = rho & 15; return 8 * (i >> 2) + 4 * n + (i & 3); }

struct Unit { int pm, pn, ks; };
struct Gemm { const bf16_t* A; const bf16_t* Bt; int K; const int* rowidx; const int* texp; size_t estride; int ld; int nks; int nNr; };

struct StaticOrder {
    int nM, nN, nwg, G, c, pm0;
    __device__ void init(int nM_, int nN_, int G_, int c_, int pm0_) { nM = nM_; nN = nN_; nwg = nM * nN; G = G_; c = c_; pm0 = pm0_; }
    __device__ bool next(int i, Unit& u) const {
        const long L = (long)i * G + c; if (L >= nwg) return false;
        int wgid = (int)L; { const int q = nwg / NXCD, r = nwg % NXCD, xcd = wgid % NXCD, off = wgid / NXCD; wgid = (xcd < r ? xcd * (q + 1) : r * (q + 1) + (xcd - r) * q) + off; }
        const int nig = WGM * nN, gid = wgid / nig, fm = gid * WGM, gsz = (nM - fm) < WGM ? (nM - fm) : WGM;
        u.pm = pm0 + fm + ((wgid % nig) % gsz); u.pn = (wgid % nig) / gsz; return true;
    }
};

__device__ __forceinline__ float row_rstd(const float* ssq, int row) {
    const f32x4* q = (const f32x4*)(ssq + (size_t)row * 16); const f32x4 a = q[0], b = q[1], c = q[2], d = q[3];
    const float s = ((a.x + a.y) + (a.z + a.w)) + ((b.x + b.y) + (b.z + b.w)) + ((c.x + c.y) + (c.z + c.w)) + ((d.x + d.y) + (d.z + d.w));
    return rsqrtf(s * (1.f / 1024.f) + EPS);
}
struct EpiF32 {
    static constexpr bool PERM = false;
    float* C; int ldc; const float* ssq;
    __device__ __forceinline__ void operator()(const f32x4 (&acc)[2][2][4][2], const Unit& u, int wr, int wc, int fr, int fq) const {
        const int row0 = u.pm * BM + wr * 64 + fr, col0 = u.pn * BM + wc * 32 + 4 * fq;
#pragma unroll
        for (int ai = 0; ai < 2; ++ai)
#pragma unroll
            for (int m = 0; m < 4; ++m) { const int row = row0 + ai * HALF + m * 16; float* rowp = C + (size_t)row * ldc + col0;
                const float rs = ssq ? row_rstd(ssq, row) : 1.f;
#pragma unroll
                for (int bj = 0; bj < 2; ++bj)
#pragma unroll
                    for (int n = 0; n < 2; ++n) *(f32x4*)(rowp + bj * HALF + n * 16) = acc[ai][bj][m][n] * rs; }
    }
};
struct EpiF32Slab {
    static constexpr bool PERM = false;
    float* C; int ldc; size_t slab; int rsub;
    __device__ __forceinline__ void operator()(const f32x4 (&acc)[2][2][4][2], const Unit& u, int wr, int wc, int fr, int fq) const {
        const int row0 = u.pm * BM - rsub + wr * 64 + fr, col0 = u.pn * BM + wc * 32 + 4 * fq;
        float* Cs = C + (size_t)u.ks * slab;
#pragma unroll
        for (int ai = 0; ai < 2; ++ai)
#pragma unroll
            for (int m = 0; m < 4; ++m) { float* rowp = Cs + (size_t)(row0 + ai * HALF + m * 16) * ldc + col0;
#pragma unroll
                for (int bj = 0; bj < 2; ++bj)
#pragma unroll
                    for (int n = 0; n < 2; ++n) *(f32x4*)(rowp + bj * HALF + n * 16) = acc[ai][bj][m][n]; }
    }
};
struct EpiProj {
    static constexpr bool PERM = false;
    float* C; int ldc; bf16_t* NK; const float* ssq; bf16_t* NQ;
    __device__ __forceinline__ void operator()(const f32x4 (&acc)[2][2][4][2], const Unit& u, int wr, int wc, int fr, int fq) const {
        const int row0 = u.pm * BM + wr * 64 + fr, col0 = u.pn * BM + wc * 32 + 4 * fq;
#pragma unroll
        for (int ai = 0; ai < 2; ++ai)
#pragma unroll
            for (int m = 0; m < 4; ++m) { const int row = row0 + ai * HALF + m * 16; float* rowp = C + (size_t)row * ldc + col0;
                const float rs = ssq ? row_rstd(ssq, row) : 1.f;
#pragma unroll
                for (int bj = 0; bj < 2; ++bj)
#pragma unroll
                    for (int n = 0; n < 2; ++n) { const f32x4 v = acc[ai][bj][m][n] * rs; const int col = col0 + bj * HALF + n * 16;
                        if (col >= 992 && col < 1760) *(u32x2*)(NK + (size_t)row * 768 + (col - 992)) = (u32x2){pk_bf16(v[0], v[1]), pk_bf16(v[2], v[3])};
                        else if (col >= 608 && col < 992) *(u32x2*)(NQ + (size_t)row * 384 + (col - 608)) = (u32x2){pk_bf16(v[0], v[1]), pk_bf16(v[2], v[3])};
                        else *(f32x4*)(rowp + bj * HALF + n * 16) = v; } }
    }
};
struct EpiResF32 {
    static constexpr bool PERM = false;
    float* C; const float* R; int ld;
    __device__ __forceinline__ void operator()(const f32x4 (&acc)[2][2][4][2], const Unit& u, int wr, int wc, int fr, int fq) const {
        const int row0 = u.pm * BM + wr * 64 + fr, col0 = u.pn * BM + wc * 32 + 4 * fq;
#pragma unroll
        for (int ai = 0; ai < 2; ++ai)
#pragma unroll
            for (int m = 0; m < 4; ++m) { const size_t ro = (size_t)(row0 + ai * HALF + m * 16) * ld + col0;
                f32x4 rv[2][2];
#pragma unroll
                for (int bj = 0; bj < 2; ++bj)
#pragma unroll
                    for (int n = 0; n < 2; ++n) rv[bj][n] = *(const f32x4*)(R + ro + bj * HALF + n * 16);
#pragma unroll
                for (int bj = 0; bj < 2; ++bj)
#pragma unroll
                    for (int n = 0; n < 2; ++n) *(f32x4*)(C + ro + bj * HALF + n * 16) = rv[bj][n] + acc[ai][bj][m][n]; }
    }
};
struct EpiResNorm {
    static constexpr bool PERM = true;
    bf16_t* HB; const float* Rf; int ld; float* ssq;
    __device__ __forceinline__ void operator()(const f32x4 (&acc)[2][2][4][2], const Unit& u, int wr, int wc, int fr, int fq) const {
        const int row0 = u.pm * BM + wr * 64 + fr, col0 = u.pn * BM + wc * 32 + 8 * fq;
#pragma unroll
        for (int ai = 0; ai < 2; ++ai)
#pragma unroll
            for (int m = 0; m < 4; ++m) { const int row = row0 + ai * HALF + m * 16; const size_t ro = (size_t)row * ld + col0;
                f32x4 r0[2], r1[2];
#pragma unroll
                for (int bj = 0; bj < 2; ++bj) {
                    if (Rf) { r0[bj] = *(const f32x4*)(Rf + ro + bj * HALF); r1[bj] = *(const f32x4*)(Rf + ro + bj * HALF + 4); }
                    else { const u32x4 hb = *(const u32x4*)(HB + ro + bj * HALF);
                        r0[bj] = (f32x4){bflo(hb.x), bfhi(hb.x), bflo(hb.y), bfhi(hb.y)}; r1[bj] = (f32x4){bflo(hb.z), bfhi(hb.z), bflo(hb.w), bfhi(hb.w)}; } }
                float sq = 0.f;
#pragma unroll
                for (int bj = 0; bj < 2; ++bj) { const f32x4 v0 = r0[bj] + acc[ai][bj][m][0], v1 = r1[bj] + acc[ai][bj][m][1];
                    *(u32x4*)(HB + ro + bj * HALF) = (u32x4){pk_bf16(v0[0], v0[1]), pk_bf16(v0[2], v0[3]), pk_bf16(v1[0], v1[1]), pk_bf16(v1[2], v1[3])};
                    sq += ((v0[0] * v0[0] + v0[1] * v0[1]) + (v0[2] * v0[2] + v0[3] * v0[3])) + ((v1[0] * v1[0] + v1[1] * v1[1]) + (v1[2] * v1[2] + v1[3] * v1[3])); }
                if (ssq) { sq += __shfl_xor(sq, 16); sq += __shfl_xor(sq, 32);
                    if (fq == 0) ssq[(size_t)row * 16 + u.pn * 4 + wc] = sq; } }
    }
};
struct EpiGlu {
    static constexpr bool PERM = false;
    float* Y; int ldy; const bf16_t* R;
    __device__ __forceinline__ void operator()(const f32x4 (&acc)[2][2][4][2], const Unit& u, int wr, int wc, int fr, int fq) const {
        const int row0 = u.pm * BM + wr * 64 + fr, col0 = u.pn * BM + wc * 32 + 4 * fq;
#pragma unroll
        for (int ai = 0; ai < 2; ++ai)
#pragma unroll
            for (int m = 0; m < 4; ++m) { const int row = row0 + ai * HALF + m * 16;
#pragma unroll
                for (int bj = 0; bj < 2; ++bj)
#pragma unroll
                    for (int n = 0; n < 2; ++n) { const int col = col0 + bj * HALF + n * 16;
                        const u32x2 r2 = *(const u32x2*)(R + (size_t)row * 256 + col); const f32x4 a = acc[ai][bj][m][n];
                        *(f32x4*)(Y + (size_t)row * ldy + col) = (f32x4){bflo(r2.x) * sigmoidf_(a[0]), bfhi(r2.x) * sigmoidf_(a[1]), bflo(r2.y) * sigmoidf_(a[2]), bfhi(r2.y) * sigmoidf_(a[3])}; } }
    }
};
struct EpiSwiglu {
    static constexpr bool PERM = true;
    bf16_t* O; int ldo; int rsub; const float* ssq;
    __device__ __forceinline__ void operator()(const f32x4 (&acc)[2][2][4][2], const Unit& u, int wr, int wc, int fr, int fq) const {
        const int row0 = u.pm * BM - rsub + wr * 64 + fr, col0 = u.pn * HALF + wc * 32 + 8 * fq;
#pragma unroll
        for (int ai = 0; ai < 2; ++ai)
#pragma unroll
            for (int m = 0; m < 4; ++m) { bf16_t* rowp = O + (size_t)(row0 + ai * HALF + m * 16) * ldo + col0;
                const float rs = ssq ? row_rstd(ssq, u.pm * BM + wr * 64 + fr + ai * HALF + m * 16) : 1.f;
                const f32x4 g0 = acc[ai][0][m][0] * rs, g1 = acc[ai][0][m][1] * rs, u0 = acc[ai][1][m][0] * rs, u1 = acc[ai][1][m][1] * rs;
                u32x4 w;
                w.x = pk_bf16(g0[0] * sigmoidf_(g0[0]) * u0[0], g0[1] * sigmoidf_(g0[1]) * u0[1]); w.y = pk_bf16(g0[2] * sigmoidf_(g0[2]) * u0[2], g0[3] * sigmoidf_(g0[3]) * u0[3]);
                w.z = pk_bf16(g1[0] * sigmoidf_(g1[0]) * u1[0], g1[1] * sigmoidf_(g1[1]) * u1[1]); w.w = pk_bf16(g1[2] * sigmoidf_(g1[2]) * u1[2], g1[3] * sigmoidf_(g1[3]) * u1[3]);
                *(u32x4*)rowp = w; }
    }
};
struct EpiBf16 {
    static constexpr bool PERM = true;
    bf16_t* O; int ldo; const float* ssq;
    __device__ __forceinline__ void operator()(const f32x4 (&acc)[2][2][4][2], const Unit& u, int wr, int wc, int fr, int fq) const {
        const int row0 = u.pm * BM + wr * 64 + fr, col0 = u.pn * BM + wc * 32 + 8 * fq;
#pragma unroll
        for (int ai = 0; ai < 2; ++ai)
#pragma unroll
            for (int m = 0; m < 4; ++m) { const int row = row0 + ai * HALF + m * 16; bf16_t* rowp = O + (size_t)row * ldo + col0;
                const float rs = ssq ? row_rstd(ssq, row) : 1.f;
#pragma unroll
                for (int bj = 0; bj < 2; ++bj) { const f32x4 v0 = acc[ai][bj][m][0] * rs, v1 = acc[ai][bj][m][1] * rs;
                    u32x4 w; w.x = pk_bf16(v0[0], v0[1]); w.y = pk_bf16(v0[2], v0[3]); w.z = pk_bf16(v1[0], v1[1]); w.w = pk_bf16(v1[2], v1[3]);
                    *(u32x4*)(rowp + bj * HALF) = w; } }
    }
};

template <class Epi, bool GATHER>
__device__ __forceinline__ void gemm_phase(PG8_LAS unsigned char* lds, const Gemm g, const StaticOrder& S, const Epi& E) {
    const int tid = tid_(), wid = __builtin_amdgcn_readfirstlane(tid >> 6), lane = tid & 63, wr = wid >> 2, wc = wid & 3, fr = lane & 15, fq = lane >> 4;
    const int K = g.ld ? g.ld : g.K, nt = g.K / BK;
    unsigned voffA[2], voffB[2]; int sR[2], sC[2];
#pragma unroll
    for (int i = 0; i < 2; ++i) { int R, C; stage_rc(tid * 16 + i * 8192, R, C); const int Rb = Epi::PERM ? ((R & ~31) + perm32(R & 31)) : R; sR[i] = R; sC[i] = C;
        voffA[i] = (unsigned)(R * K + C) * 2u; voffB[i] = (unsigned)(Rb * K + C) * 2u; }
    const size_t kstep = (size_t)(BK * 2);
    const size_t hstep = (size_t)HALF * K * 2;
    const size_t sstep = (size_t)g.K * 2;
    const size_t tstep = 2 * hstep;
    const unsigned ldsw = (unsigned)wid * 1024u;
    const int aoff = lds_byte(wr * 64 + fr, fq * 8), boff = lds_byte(wc * 32 + fr, fq * 8);
#define PG8_SA(b, h) (((b) * 2 + (h)) * HTB)
#define PG8_SB(b, h) ((4 + (b) * 2 + (h)) * HTB)
#define PG8_STAGE(bufoff, gbase, voff) do { _Pragma("unroll") for (int _i = 0; _i < 2; ++_i) \
        __builtin_amdgcn_global_load_lds((const unsigned*)((const char*)(gbase) + (voff)[_i]), (PG8_LAS unsigned*)(lds + (bufoff) + ldsw + _i * 8192), 16, 0, 0); } while (0)
#define PG8_LDA(dst, b, h) do { _Pragma("unroll") for (int m = 0; m < 4; ++m) _Pragma("unroll") for (int k = 0; k < 2; ++k) dst[m][k] = *(const PG8_LAS bf16x8*)(lds + PG8_SA(b, h) + aoff + m * 2048 + k * 1024); } while (0)
#define PG8_LDB(dst, b, h) do { _Pragma("unroll") for (int n = 0; n < 2; ++n) _Pragma("unroll") for (int k = 0; k < 2; ++k) dst[n][k] = *(const PG8_LAS bf16x8*)(lds + PG8_SB(b, h) + boff + n * 2048 + k * 1024); } while (0)
#define PG8_MMA(ai, bj, At, Bt) do { __builtin_amdgcn_s_setprio(1); _Pragma("unroll") for (int m = 0; m < 4; ++m) _Pragma("unroll") for (int n = 0; n < 2; ++n) _Pragma("unroll") for (int k = 0; k < 2; ++k) \
        acc[ai][bj][m][n] = __builtin_amdgcn_mfma_f32_16x16x32_bf16(Bt[n][k], At[m][k], acc[ai][bj][m][n], 0, 0, 0); __builtin_amdgcn_s_setprio(0); } while (0)
#define PG8_WAIT_V(n) asm volatile("s_waitcnt vmcnt(" #n ")" ::: "memory")
#define PG8_WAIT_L(n) asm volatile("s_waitcnt lgkmcnt(" #n ")" ::: "memory")
#define PG8_BAR __builtin_amdgcn_s_barrier()
#define PG8_SCHED __builtin_amdgcn_sched_barrier(0)
#define PG8_GOFF(v, u) do { _Pragma("unroll") for (int _h = 0; _h < 2; ++_h) _Pragma("unroll") for (int _i = 0; _i < 2; ++_i) \
        v[_h][_i] = (unsigned)(g.rowidx[(u).pm * BM + _h * HALF + sR[_i]] * K + sC[_i]) * 2u; } while (0)
    Unit cur, nxt; int ui = 0;
    if (!S.next(0, cur)) return;
    cur.ks = 0; if (g.nks > 1) { cur.ks = cur.pn / g.nNr; cur.pn -= cur.ks * g.nNr; }
    f32x4 acc[2][2][4][2];
#pragma unroll
    for (int a = 0; a < 2; ++a)
#pragma unroll
        for (int b = 0; b < 2; ++b)
#pragma unroll
            for (int m = 0; m < 4; ++m)
#pragma unroll
                for (int n = 0; n < 2; ++n) acc[a][b][m][n] = (f32x4){0.f, 0.f, 0.f, 0.f};
    bf16x8 At[4][2], B0[2][2], B1[2][2];
    unsigned vAc[2][2], vAn[2][2];
    if constexpr (GATHER) { PG8_GOFF(vAc, cur); }
    const char* gA = (const char*)g.A;
    const char* cA = gA + (GATHER ? (size_t)0 : (size_t)cur.pm * tstep + (size_t)cur.ks * sstep);
    const char* cB = (const char*)g.Bt + (size_t)cur.pn * tstep + (size_t)cur.ks * sstep + (g.texp ? (size_t)g.texp[cur.pm] * g.estride * 2 : (size_t)0);
    PG8_STAGE(PG8_SB(0, 0), cB, voffB); PG8_STAGE(PG8_SB(0, 1), cB + hstep, voffB);
    if constexpr (GATHER) { PG8_STAGE(PG8_SA(0, 0), gA, vAc[0]); PG8_STAGE(PG8_SA(0, 1), gA, vAc[1]); }
    else { PG8_STAGE(PG8_SA(0, 0), cA, voffA); PG8_STAGE(PG8_SA(0, 1), cA + hstep, voffA); }
    if (wr == 1) PG8_BAR;
    PG8_WAIT_V(2); PG8_BAR;
    PG8_STAGE(PG8_SB(1, 0), cB + kstep, voffB);
    if constexpr (GATHER) { PG8_STAGE(PG8_SA(1, 0), gA + kstep, vAc[0]); } else { PG8_STAGE(PG8_SA(1, 0), cA + kstep, voffA); }
    PG8_STAGE(PG8_SB(1, 1), cB + hstep + kstep, voffB);
    PG8_WAIT_V(6); PG8_BAR;
    for (;;) {
        const bool has_next = S.next(ui + 1, nxt);
        nxt.ks = 0; if (has_next && g.nks > 1) { nxt.ks = nxt.pn / g.nNr; nxt.pn -= nxt.ks * g.nNr; }
        const char* nA = (has_next && !GATHER) ? gA + (size_t)nxt.pm * tstep + (size_t)nxt.ks * sstep : cA;
        const char* nB = has_next ? (const char*)g.Bt + (size_t)nxt.pn * tstep + (size_t)nxt.ks * sstep + (g.texp ? (size_t)g.texp[nxt.pm] * g.estride * 2 : (size_t)0) : cB;
        if constexpr (GATHER) { if (has_next) { PG8_GOFF(vAn, nxt); } else {
#pragma unroll
            for (int h = 0; h < 2; ++h)
#pragma unroll
                for (int i = 0; i < 2; ++i) vAn[h][i] = vAc[h][i]; } }
        for (int t = 0; t < nt; t += 2) {
            const bool last = (t == nt - 2);
            const char* a1 = cA + (size_t)(t + 1) * kstep;
            const char* a2 = last ? nA : cA + (size_t)(t + 2) * kstep; const char* b2 = last ? nB : cB + (size_t)(t + 2) * kstep;
            const char* a3 = a2 + kstep; const char* b3 = b2 + kstep;
            unsigned v2[2][2];
            if constexpr (GATHER) {
#pragma unroll
                for (int h = 0; h < 2; ++h)
#pragma unroll
                    for (int i = 0; i < 2; ++i) v2[h][i] = last ? vAn[h][i] : vAc[h][i]; }
#define PG8_STA1(buf) do { if constexpr (GATHER) { PG8_STAGE(buf, a1, vAc[1]); } else { PG8_STAGE(buf, a1 + hstep, voffA); } } while (0)
#define PG8_STA2(buf, h) do { if constexpr (GATHER) { PG8_STAGE(buf, a2, v2[h]); } else { PG8_STAGE(buf, a2 + (h) * hstep, voffA); } } while (0)
#define PG8_STA3(buf) do { if constexpr (GATHER) { PG8_STAGE(buf, a3, v2[0]); } else { PG8_STAGE(buf, a3, voffA); } } while (0)
            PG8_LDB(B0, 0, 0); PG8_LDB(B1, 0, 1); PG8_SCHED; PG8_LDA(At, 0, 0); PG8_STA1(PG8_SA(1, 1));
            PG8_WAIT_V(8); PG8_WAIT_L(0); PG8_BAR; PG8_MMA(0, 0, At, B0); PG8_MMA(0, 1, At, B1); PG8_BAR; PG8_SCHED;
            PG8_LDA(At, 0, 1); PG8_STAGE(PG8_SB(0, 0), b2, voffB); PG8_STAGE(PG8_SB(0, 1), b2 + hstep, voffB); PG8_STA2(PG8_SA(0, 0), 0);
            PG8_WAIT_V(8); PG8_WAIT_L(0); PG8_BAR; PG8_MMA(1, 0, At, B0); PG8_MMA(1, 1, At, B1); PG8_BAR; PG8_SCHED;
            PG8_LDB(B0, 1, 0); PG8_LDB(B1, 1, 1); PG8_SCHED; PG8_LDA(At, 1, 0); PG8_STA2(PG8_SA(0, 1), 1);
            PG8_WAIT_V(8); PG8_WAIT_L(0); PG8_BAR; PG8_MMA(0, 0, At, B0); PG8_MMA(0, 1, At, B1); PG8_BAR; PG8_SCHED;
            PG8_LDA(At, 1, 1); PG8_STAGE(PG8_SB(1, 0), b3, voffB); PG8_STAGE(PG8_SB(1, 1), b3 + hstep, voffB); PG8_STA3(PG8_SA(1, 0));
            PG8_WAIT_V(8); PG8_WAIT_L(0); PG8_BAR; PG8_MMA(1, 0, At, B0); PG8_MMA(1, 1, At, B1); PG8_BAR; PG8_SCHED;
        }
        if (wr == 0) PG8_BAR;
        E(acc, cur, wr, wc, fr, fq);
        if (!has_next) break;
#pragma unroll
        for (int a = 0; a < 2; ++a)
#pragma unroll
            for (int b = 0; b < 2; ++b)
#pragma unroll
                for (int m = 0; m < 4; ++m)
#pragma unroll
                    for (int n = 0; n < 2; ++n) acc[a][b][m][n] = (f32x4){0.f, 0.f, 0.f, 0.f};
        cur = nxt; cA = nA; cB = nB; ++ui;
        if constexpr (GATHER) {
#pragma unroll
            for (int h = 0; h < 2; ++h)
#pragma unroll
                for (int i = 0; i < 2; ++i) vAc[h][i] = vAn[h][i]; }
        if (wr == 1) PG8_BAR;
    }
    PG8_WAIT_V(0);
    PG8_BAR;
#undef PG8_SA
#undef PG8_SB
#undef PG8_STAGE
#undef PG8_LDA
#undef PG8_LDB
#undef PG8_MMA
#undef PG8_WAIT_V
#undef PG8_WAIT_L
#undef PG8_BAR
#undef PG8_SCHED
#undef PG8_GOFF
#undef PG8_STA1
#undef PG8_STA2
#undef PG8_STA3
}
}

struct CvtCursor { int base; };
template <bool VEC4>
__device__ __forceinline__ void cvt_matrix(CvtCursor& cur, const float* W, int K, int N, bf16_t* WT, int Kpad, int Npad, int mode, LAS float* scr, int gw, int NW, int lane, const float* kgain = nullptr) {
    const int nkb = Kpad / 64, nnb = Npad / 32, nitems = nkb * nnb;
    int first = (gw - cur.base % NW + NW) % NW;
    cur.base += nitems;
    for (int it = first; it < nitems; it += NW) {
        const int kb = it / nnb, nb = it % nnb, k0 = kb * 64, n0 = nb * 32;
        const int drow0 = mode == 0 ? n0 : (((n0 >> 7) << 8) + (n0 & 127) + (mode == 2 ? 128 : 0));
        if (VEC4) {
            const bool inr = (k0 < K) && (n0 < N);
#pragma unroll
            for (int i = 0; i < 8; ++i) {
                const int kk = i * 8 + (lane >> 3), nn = (lane & 7) * 4;
                f32x4 v = {0.f, 0.f, 0.f, 0.f};
                if (inr) { v = *(const f32x4*)(W + (size_t)(k0 + kk) * N + n0 + nn); if (kgain) v = v * kgain[k0 + kk]; }
                scr[kk * 33 + nn] = v.x; scr[kk * 33 + nn + 1] = v.y; scr[kk * 33 + nn + 2] = v.z; scr[kk * 33 + nn + 3] = v.w;
            }
        } else {
#pragma unroll 8
            for (int i = 0; i < 32; ++i) { const int kk = 2 * i + (lane >> 5), n = n0 + (lane & 31);
                scr[kk * 33 + (lane & 31)] = (k0 + kk < K && n < N) ? W[(size_t)(k0 + kk) * N + n] * (kgain ? kgain[k0 + kk] : 1.f) : 0.f; }
        }
        asm volatile("s_waitcnt lgkmcnt(0)" ::: "memory");
        const int c = lane & 7;
#pragma unroll
        for (int j = 0; j < 4; ++j) { const int n = (lane >> 3) + 8 * j; const LAS float* sp = scr + (8 * c) * 33 + n;
            u32x4 o; o.x = pk_bf16(sp[0 * 33], sp[1 * 33]); o.y = pk_bf16(sp[2 * 33], sp[3 * 33]); o.z = pk_bf16(sp[4 * 33], sp[5 * 33]); o.w = pk_bf16(sp[6 * 33], sp[7 * 33]);
            *(u32x4*)(WT + (size_t)(drow0 + n) * Kpad + k0 + 8 * c) = o; }
        asm volatile("s_waitcnt lgkmcnt(0)" ::: "memory");
    }
}

__device__ __forceinline__ void ph_rope_table(float* tab) {
    GT_DECL
    for (int i = gt; i < SEQ * 16; i += NT) {
        const int s = i >> 4, k = i & 15;
        const double inv = exp10(-0.25 * (double)k);
        float sn, cs; sincos_d((double)s * inv, sn, cs);
        tab[i] = cs; tab[SEQ * 16 + i] = sn;
    }
}

__device__ __forceinline__ void ph_mla_prep(const float* proj, const float* qn_g, const float* kvn_g, const float* rope, bf16_t* cqn, bf16_t* ckvn, bf16_t* krope) {
    GT_DECL
    const bool qa = lane < 48, ka = lane < 32;
    const f32x4 gq = qa ? *(const f32x4*)(qn_g + lane * 4) : (f32x4){0.f, 0.f, 0.f, 0.f};
    const f32x4 gk = ka ? *(const f32x4*)(kvn_g + lane * 4) : (f32x4){0.f, 0.f, 0.f, 0.f};
    for (int t = gw; t < T; t += NW) {
        const float* pr = proj + (size_t)t * INLD;
        const f32x4 a = qa ? *(const f32x4*)(pr + O_CQ + lane * 4) : (f32x4){0.f, 0.f, 0.f, 0.f};
        const f32x4 b = ka ? *(const f32x4*)(pr + O_CKV + lane * 4) : (f32x4){0.f, 0.f, 0.f, 0.f};
        float x1 = 0.f, x2 = 0.f, c = 0.f, sn = 0.f;
        if (lane < 16) { const int s = t & (SEQ - 1); c = rope[s * 16 + lane]; sn = rope[SEQ * 16 + s * 16 + lane]; x1 = pr[O_KR + lane]; x2 = pr[O_KR + 16 + lane]; }
        const float rs = rsqrtf(wave_sum((a.x * a.x + a.y * a.y) + (a.z * a.z + a.w * a.w)) * (1.f / 192.f) + EPS);
        const float rs2 = rsqrtf(wave_sum((b.x * b.x + b.y * b.y) + (b.z * b.z + b.w * b.w)) * (1.f / 128.f) + EPS);
        *(u32x2*)(cqn + (size_t)t * 256 + lane * 4) = (u32x2){pk_bf16(a.x * rs * gq.x, a.y * rs * gq.y), pk_bf16(a.z * rs * gq.z, a.w * rs * gq.w)};
        *(u32x2*)(ckvn + (size_t)t * 256 + lane * 4) = (u32x2){pk_bf16(b.x * rs2 * gk.x, b.y * rs2 * gk.y), pk_bf16(b.z * rs2 * gk.z, b.w * rs2 * gk.w)};
        if (lane < 16) { krope[(size_t)t * 32 + lane] = f2bf(x1 * c - x2 * sn); krope[(size_t)t * 32 + 16 + lane] = f2bf(x2 * c + x1 * sn); }
    }
}

struct SsmConst { float ab_r, ab_i, bb_r[16], bb_i[16]; double ang; float lrdt; };
__device__ __forceinline__ void ssm_consts(const Params& p, int l, int g, int lane, SsmConst& c) {
    const float dt = expf(p.in[IN_SLDT][l * 16 + g]);
    const float lr = p.in[IN_SARE][(l * 16 + g) * 64 + lane], li = p.in[IN_SAIM][(l * 16 + g) * 64 + lane];
    const float mag = expf(lr * dt);
    float sn, cs; sincos_d((double)li * (double)dt, sn, cs);
    c.ab_r = mag * cs; c.ab_i = mag * sn; c.ang = (double)li * (double)dt; c.lrdt = lr * dt;
    const float den = lr * lr + li * li, nr = c.ab_r - 1.f;
    const float f_r = (nr * lr + c.ab_i * li) / den, f_i = (c.ab_i * lr - nr * li) / den;
    const float* bre = p.in[IN_SBRE] + ((size_t)(l * 16 + g) * 64 + lane) * 16;
    const float* bim = p.in[IN_SBIM] + ((size_t)(l * 16 + g) * 64 + lane) * 16;
#pragma unroll
    for (int k4 = 0; k4 < 4; ++k4) { const f32x4 br4 = *(const f32x4*)(bre + 4 * k4), bi4 = *(const f32x4*)(bim + 4 * k4);
        const float brr[4] = {br4.x, br4.y, br4.z, br4.w}, bii[4] = {bi4.x, bi4.y, bi4.z, bi4.w};
#pragma unroll
        for (int q = 0; q < 4; ++q) { c.bb_r[4 * k4 + q] = f_r * brr[q] - f_i * bii[q]; c.bb_i[4 * k4 + q] = f_r * bii[q] + f_i * brr[q]; } }
}
__device__ __forceinline__ void ph_ssm1(const Params& p, int l, const float* proj, f32x2* E, LAS unsigned char* lds) {
    GT_DECL
    LAS float* ut = (LAS float*)(lds + (tid >> 6) * 16384 + 9216);
    const int nblk = (int)gridDim.x, half_w = (nblk / 2) * (NTHR / 64);
    const bool even_split = (nblk & 1) || (NB * 32 * 16 != 4 * half_w);
    const int wv = gw;
    const int my_first = even_split ? wv : (wv < half_w ? wv : half_w + (wv - half_w) * 3);
    const int my_count = even_split ? 0 : (wv < half_w ? 1 : 3);
    for (int it = 0; even_split ? (my_first + it * NW < NB * 32 * 16) : (it < my_count); ++it) {
        const int w = even_split ? my_first + it * NW : my_first + it;
        const int g = w & 15, k = (w >> 4) & 31, b = w >> 9;
        const float* up = proj + (size_t)(b * SEQ + k * 64) * INLD + O_U + g * 16;
        {
            const f32x4* ur = (const f32x4*)(up + (size_t)lane * INLD);
            const f32x4 u0 = ur[0], u1 = ur[1], u2 = ur[2], u3 = ur[3];
            LAS f32x4* ud = (LAS f32x4*)(ut + lane * 16);
            ud[0] = u0; ud[1] = u1; ud[2] = u2; ud[3] = u3;
        }
        SsmConst c; ssm_consts(p, l, g, lane, c);
        float hr = 0.f, hi = 0.f;
        asm volatile("s_waitcnt lgkmcnt(0)" ::: "memory");
        for (int j = 0; j < 64; ++j) {
            float br = 0.f, bi = 0.f;
            const LAS f32x4* uj4 = (const LAS f32x4*)(ut + j * 16);
            const f32x4 ua = uj4[0], ub = uj4[1], uc = uj4[2], ud4 = uj4[3];
            const float uu[16] = {ua.x, ua.y, ua.z, ua.w, ub.x, ub.y, ub.z, ub.w, uc.x, uc.y, uc.z, uc.w, ud4.x, ud4.y, ud4.z, ud4.w};
#pragma unroll
            for (int q = 0; q < 16; ++q) { const float u = uu[q]; br += u * c.bb_r[q]; bi += u * c.bb_i[q]; }
            const float nr = c.ab_r * hr - c.ab_i * hi + br, ni = c.ab_r * hi + c.ab_i * hr + bi;
            hr = nr; hi = ni;
        }
        E[(size_t)w * 64 + lane] = (f32x2){hr, hi};
    }
}
__device__ __forceinline__ void ph_ssm2(const Params& p, int l, const float* proj, const f32x2* E, bf16_t* ypre, LAS unsigned char* lds) {
    GT_DECL
    constexpr int HSTR = 272;
    LAS unsigned char* hb = lds + (tid >> 6) * 16384;
    LAS float* ut = (LAS float*)(lds + (tid >> 6) * 16384 + 9216);
    LAS bf16_t* yt = (LAS bf16_t*)(lds + (tid >> 6) * 16384 + 13312);
    const int fr = lane & 15, fq = lane >> 4;
    for (int w = gw; w < NB * 32 * 16; w += NW) {
        const int g = w & 15, k = (w >> 4) & 31, b = w >> 9;
        SsmConst c; ssm_consts(p, l, g, lane, c);
        float l64r, l64i; { float sn, cs; sincos_d(c.ang * 64.0, sn, cs); const float m = expf(64.f * c.lrdt); l64r = m * cs; l64i = m * sn; }
        float hr = 0.f, hi = 0.f;
        for (int kk0 = 0; kk0 < k; kk0 += 8) {
            f32x2 ev[8];
#pragma unroll
            for (int q = 0; q < 8; ++q) { const int kk = kk0 + q < k ? kk0 + q : k - 1; ev[q] = E[(size_t)(((b * 32 + kk) * 16) + g) * 64 + lane]; }
#pragma unroll
            for (int q = 0; q < 8; ++q) if (kk0 + q < k) {
                const float nr = l64r * hr - l64i * hi + ev[q].x, ni = l64r * hi + l64i * hr + ev[q].y;
                hr = nr; hi = ni;
            }
        }
        bf16x8_t cb[4];
        {
            const float* cre = p.in[IN_SCRE] + ((size_t)(l * 16 + g) * 16 + fr) * 64;
            const float* cim = p.in[IN_SCIM] + ((size_t)(l * 16 + g) * 16 + fr) * 64;
#pragma unroll
            for (int s = 0; s < 4; ++s) {
                const f32x4 vr = *(const f32x4*)(cre + 16 * s + 4 * fq), vi = *(const f32x4*)(cim + 16 * s + 4 * fq);
                cb[s] = pack8f(vr.x, -vi.x, vr.y, -vi.y, vr.z, -vi.z, vr.w, -vi.w);
            }
        }
        const float dd = p.in[IN_SD][l * 256 + g * 16 + fr];
        const float* up = proj + (size_t)(b * SEQ + k * 64) * INLD + O_U + g * 16;
        {
            const f32x4* ur = (const f32x4*)(up + (size_t)lane * INLD);
            const f32x4 u0 = ur[0], u1 = ur[1], u2 = ur[2], u3 = ur[3];
            LAS f32x4* ud = (LAS f32x4*)(ut + lane * 16);
            ud[0] = u0; ud[1] = u1; ud[2] = u2; ud[3] = u3;
        }
        asm volatile("s_waitcnt lgkmcnt(0)" ::: "memory");
        for (int half = 0; half < 2; ++half) {
            for (int j = 0; j < 32; ++j) {
                float br = 0.f, bi = 0.f;
                const LAS f32x4* uj4 = (const LAS f32x4*)(ut + (half * 32 + j) * 16);
                const f32x4 ua = uj4[0], ub = uj4[1], uc = uj4[2], ud4 = uj4[3];
                const float uu[16] = {ua.x, ua.y, ua.z, ua.w, ub.x, ub.y, ub.z, ub.w, uc.x, uc.y, uc.z, uc.w, ud4.x, ud4.y, ud4.z, ud4.w};
#pragma unroll
                for (int q = 0; q < 16; ++q) { const float u = uu[q]; br += u * c.bb_r[q]; bi += u * c.bb_i[q]; }
                const float nr = c.ab_r * hr - c.ab_i * hi + br, ni = c.ab_r * hi + c.ab_i * hr + bi;
                hr = nr; hi = ni;
                *(LAS unsigned*)(hb + j * HSTR + lane * 4) = pk_bf16(hr, hi);
            }
            asm volatile("s_waitcnt lgkmcnt(0)" ::: "memory");
#pragma unroll
            for (int mt = 0; mt < 2; ++mt) {
                f32x4 acc = {0.f, 0.f, 0.f, 0.f};
#pragma unroll
                for (int s = 0; s < 4; ++s) {
                    const bf16x8_t a = *(const LAS bf16x8_t*)(hb + (16 * mt + fr) * HSTR + (32 * s + 8 * fq) * 2);
                    acc = __builtin_amdgcn_mfma_f32_16x16x32_bf16(a, cb[s], acc, 0, 0, 0);
                }
#pragma unroll
                for (int rg = 0; rg < 4; ++rg) {
                    const int step = half * 32 + 16 * mt + 4 * fq + rg;
                    const float u = ut[step * 16 + fr];
                    yt[step * 16 + fr] = f2bf(gelu_tanh(acc[rg] + dd * u));
                }
            }
            asm volatile("s_waitcnt lgkmcnt(0)" ::: "memory");
        }
        {
            const LAS u32x4* yr = (const LAS u32x4*)(yt + lane * 16);
            const u32x4 y0 = yr[0], y1 = yr[1];
            u32x4* yo = (u32x4*)(ypre + (size_t)(b * SEQ + k * 64 + lane) * 256 + g * 16);
            yo[0] = y0; yo[1] = y1;
        }
        asm volatile("s_waitcnt lgkmcnt(0)" ::: "memory");
    }
}

__device__ __forceinline__ void ph_cmp1(const Params& p, int l, const float* proj, float* hid) {
    GT_DECL
    const int total = 2 * NB * NBC * 2 * 64;
    for (int i = gt; i < total; i += NT) {
        const int c = i & 63, row = (i >> 6) % (NB * NBC * 2), j = (i >> 6) / (NB * NBC * 2);
        const int g = row & 1, n = (row >> 1) % NBC, b = (row >> 1) / NBC;
        const float* w1 = p.in[IN_NW1] + (size_t)(l * 2 + j) * 2048 * 64;
        const float* pe = p.in[IN_NPE] + (size_t)(l * 2 + j) * 32 * 64;
        float acc = 0.f;
        for (int pos = 0; pos < 32; ++pos) {
            const float* kv = proj + (size_t)(b * SEQ + n * 16 + pos) * INLD + O_NKV + j * 128 + g * 64;
            for (int d = 0; d < 64; ++d) acc += (kv[d] + pe[pos * 64 + d]) * w1[(size_t)(pos * 64 + d) * 64 + c];
        }
        hid[i] = gelu_tanh(acc);
    }
}
__device__ __forceinline__ void ph_cmp2(const Params& p, int l, const float* hid, float* kc) {
    GT_DECL
    const int total = 2 * NB * NBC * 2 * 64;
    for (int i = gt; i < total; i += NT) {
        const int c = i & 63, j = (i >> 6) / (NB * NBC * 2);
        const float* w2 = p.in[IN_NW2] + (size_t)(l * 2 + j) * 64 * 64;
        const float* h = hid + (size_t)(i >> 6) * 64;
        float acc = 0.f;
        for (int k = 0; k < 64; ++k) acc += h[k] * w2[k * 64 + c];
        kc[i] = acc;
    }
}

__device__ __forceinline__ void ph_mla_attn(const float* qmla, const float* kvmla, const float* krope, const float* rope, float* ycat) {
    GT_DECL
    const float scale = 0.10206207261596575f;
    for (int w = gw; w < 6 * (T / 64); w += NW) {
        const int h = __builtin_amdgcn_readfirstlane(w % 6), tb = __builtin_amdgcn_readfirstlane(w / 6);
        const int t = tb * 64 + lane, s = t & (SEQ - 1), b = __builtin_amdgcn_readfirstlane(t >> 11);
        float q[96];
        const float* qp = qmla + (size_t)t * 768 + h * 96;
#pragma unroll
        for (int d = 0; d < 64; ++d) q[d] = qp[d] * scale;
#pragma unroll
        for (int d = 0; d < 16; ++d) {
            const float c = rope[s * 16 + d], sn = rope[SEQ * 16 + s * 16 + d];
            const float x1 = qp[64 + d], x2 = qp[80 + d];
            q[64 + d] = (x1 * c - x2 * sn) * scale; q[80 + d] = (x2 * c + x1 * sn) * scale;
        }
        const int jmax = __builtin_amdgcn_readfirstlane((tb * 64 + 63) & (SEQ - 1));
        for (int half = 0; half < 2; ++half) {
            float acc[32];
#pragma unroll
            for (int d = 0; d < 32; ++d) acc[d] = 0.f;
            float m = -1e30f, lsum = 0.f;
            for (int j = 0; j <= jmax; ++j) {
                const float* kp = kvmla + (size_t)(b * SEQ + j) * 768 + h * 128;
                const float* rp = krope + (size_t)(b * SEQ + j) * 32;
                float sc = 0.f;
#pragma unroll
                for (int d = 0; d < 64; ++d) sc += q[d] * kp[d];
#pragma unroll
                for (int d = 0; d < 32; ++d) sc += q[64 + d] * rp[d];
                const bool ok = j <= s;
                const float mn = ok ? fmaxf(m, sc) : m;
                const float corr = __expf(m - mn), pj = ok ? __expf(sc - mn) : 0.f;
                lsum = lsum * corr + pj; m = mn;
#pragma unroll
                for (int d = 0; d < 32; ++d) acc[d] = acc[d] * corr + pj * kp[64 + half * 32 + d];
            }
            const float inv = 1.f / lsum;
            float* o = ycat + (size_t)t * D + 256 + h * 64 + half * 32;
#pragma unroll
            for (int d = 0; d < 32; ++d) o[d] = acc[d] * inv;
        }
    }
}

__device__ __forceinline__ void ph_nsa_cmp(const Params& p, const float* proj, const float* kc, float* impp, float* ycat) {
    GT_DECL
    const float* relb = p.in[IN_RELB];
    for (int w = gw; w < 6 * (T / 64); w += NW) {
        const int hh = __builtin_amdgcn_readfirstlane(w % 6), tb = __builtin_amdgcn_readfirstlane(w / 6);
        const int g = hh / 3;
        const int t = tb * 64 + lane, s = t & (SEQ - 1), b = __builtin_amdgcn_readfirstlane(t >> 11);
        float q[64];
        const float* qp = proj + (size_t)t * INLD + O_NQ + hh * 64;
#pragma unroll
        for (int d = 0; d < 64; ++d) q[d] = qp[d] * 0.125f;
        const int nvis = s >= 31 ? ((s - 31) >> 4) + 1 : 0;
        const int smax = (tb * 64 + 63) & (SEQ - 1);
        const int nmax = __builtin_amdgcn_readfirstlane(smax >= 31 ? ((smax - 31) >> 4) + 1 : 0);
        const float* kcb = kc + (size_t)b * NBC * 128 + g * 64;
        const float* vcb = kc + (size_t)NB * NBC * 128 + (size_t)b * NBC * 128 + g * 64;
        float m = -1e30f, lsum = 0.f;
        for (int n = 0; n < nmax; ++n) {
            const float* kp = kcb + n * 128;
            float sc = 0.f;
#pragma unroll
            for (int d = 0; d < 64; ++d) sc += q[d] * kp[d];
            const bool ok = n < nvis;
            sc += relb[t5_bucket(s - (n * 16 + 31)) * 6 + hh];
            const float mn = ok ? fmaxf(m, sc) : m;
            lsum = lsum * __expf(m - mn) + (ok ? __expf(sc - mn) : 0.f); m = mn;
        }
        const float inv = nvis > 0 ? 1.f / lsum : 0.f;
        float acc[64];
#pragma unroll
        for (int d = 0; d < 64; ++d) acc[d] = 0.f;
        const int mmax = (nmax + 4) >> 2;
        for (int mb = 0; mb < 32; ++mb) {
            float im = 0.f;
            if (mb < mmax) {
                for (int dn = -1; dn < 4; ++dn) {
                    const int n = 4 * mb + dn;
                    if (n < 0 || n >= nmax) continue;
                    const float* kp = kcb + n * 128;
                    float sc = 0.f;
#pragma unroll
                    for (int d = 0; d < 64; ++d) sc += q[d] * kp[d];
                    sc += relb[t5_bucket(s - (n * 16 + 31)) * 6 + hh];
                    const float pn = (n < nvis) ? __expf(sc - m) * inv : 0.f;
                    im += pn;
                    if (dn >= 0) { const float* vp = vcb + n * 128;
#pragma unroll
                        for (int d = 0; d < 64; ++d) acc[d] += pn * vp[d]; }
                }
            }
            impp[((size_t)t * 6 + hh) * 32 + mb] = im;
        }
        const float gate = sigmoidf_(proj[(size_t)t * INLD + O_NG + 0 * 6 + hh]);
        float* o = ycat + (size_t)t * D + 640 + hh * 64;
#pragma unroll
        for (int d = 0; d < 64; ++d) o[d] = gate * acc[d];
    }
}
__device__ __forceinline__ unsigned nsa_topk_mask(const float* ip  , int cur) {
    float imp[32];
#pragma unroll
    for (int m = 0; m < 32; ++m) imp[m] = (ip[(size_t)m * SEQ] + ip[(size_t)(32 + m) * SEQ]) + ip[(size_t)(64 + m) * SEQ];
#pragma unroll
    for (int m = 0; m < 32; ++m) {
        const bool forced = (m == 0) || (m == cur) || (m == cur - 1);
        const bool future = m > cur;
        imp[m] = forced ? 1e9f : (future ? -1e9f : imp[m]);
    }
    unsigned mask = 0u;
#pragma unroll
    for (int k = 0; k < 8; ++k) {
        float best = -3e38f; int bi = 0;
#pragma unroll
        for (int m = 0; m < 32; ++m) { const bool free_ = !((mask >> m) & 1u); if (free_ && imp[m] > best) { best = imp[m]; bi = m; } }
        mask |= 1u << bi;
    }
    return mask;
}
__device__ __forceinline__ void ph_nsa_selwin(const Params& p, const float* proj, const unsigned* sel, float* ycat) {
    GT_DECL
    const float* relb = p.in[IN_RELB];
    for (int w = gw; w < 6 * (T / 64); w += NW) {
        const int hh = w % 6, tb = w / 6, g = hh / 3;
        const int t = tb * 64 + lane, s = t & (SEQ - 1), b = t >> 11, cur = s >> 6;
        float q[64];
        const float* qp = proj + (size_t)t * INLD + O_NQ + hh * 64;
#pragma unroll
        for (int d = 0; d < 64; ++d) q[d] = qp[d] * 0.125f;
        const unsigned mask = sel[t * 2 + g];
        float* o = ycat + (size_t)t * D + 640 + hh * 64;
        const float gs = sigmoidf_(proj[(size_t)t * INLD + O_NG + 1 * 6 + hh]), gwn = sigmoidf_(proj[(size_t)t * INLD + O_NG + 2 * 6 + hh]);
        for (int half = 0; half < 2; ++half) {
        {
            float acc[32];
#pragma unroll
            for (int d = 0; d < 32; ++d) acc[d] = 0.f;
            float m = -1e30f, lsum = 0.f;
            for (int mb = 0; mb < 32; ++mb) {
                const bool on = ((mask >> mb) & 1u) && mb <= cur;
                if (!__any(on)) continue;
                for (int j = 0; j < 64; ++j) {
                    const int kpos = mb * 64 + j;
                    const bool ok = on && kpos <= s;
                    if (ok) {
                        const float* kp = proj + (size_t)(b * SEQ + kpos) * INLD + O_NKV + 2 * 128 + g * 64;
                        const float* vp = kp + 128 + half * 32;
                        float sc = 0.f;
#pragma unroll
                        for (int d = 0; d < 64; ++d) sc += q[d] * kp[d];
                        sc += relb[t5_bucket(s - kpos) * 6 + hh];
                        const float mn = fmaxf(m, sc), corr = __expf(m - mn), pj = __expf(sc - mn);
                        lsum = lsum * corr + pj; m = mn;
#pragma unroll
                        for (int d = 0; d < 32; ++d) acc[d] = acc[d] * corr + pj * vp[d];
                    }
                }
            }
            const float inv = gs / lsum;
#pragma unroll
            for (int d = 0; d < 32; ++d) o[half * 32 + d] += acc[d] * inv;
        }
        {
            float acc[32];
#pragma unroll
            for (int d = 0; d < 32; ++d) acc[d] = 0.f;
            float m = -1e30f, lsum = 0.f;
            for (int j = 0; j < 256; ++j) {
                const int kpos = s - 255 + j;
                if (kpos >= 0) {
                    const float* kp = proj + (size_t)(b * SEQ + kpos) * INLD + O_NKV + 4 * 128 + g * 64;
                    const float* vp = kp + 128 + half * 32;
                    float sc = 0.f;
#pragma unroll
                    for (int d = 0; d < 64; ++d) sc += q[d] * kp[d];
                    sc += relb[t5_bucket(s - kpos) * 6 + hh];
                    const float mn = fmaxf(m, sc), corr = __expf(m - mn), pj = __expf(sc - mn);
                    lsum = lsum * corr + pj; m = mn;
#pragma unroll
                    for (int d = 0; d < 32; ++d) acc[d] = acc[d] * corr + pj * vp[d];
                }
            }
            const float inv = gwn / lsum;
#pragma unroll
            for (int d = 0; d < 32; ++d) o[half * 32 + d] += acc[d] * inv;
        }
        }
    }
}

__device__ __forceinline__ void ph_group_norm(const float* ycat, const float* gain, bf16_t* yb) {
    GT_DECL
    const f32x4 ga = *(const f32x4*)(gain + lane * 4);
    f32x2 gb[3], gc[3];
#pragma unroll
    for (int i = 0; i < 3; ++i) { gb[i] = *(const f32x2*)(gain + 256 + lane * 6 + 2 * i); gc[i] = *(const f32x2*)(gain + 640 + lane * 6 + 2 * i); }
    for (int t = gw; t < T; t += NW) {
        const float* y = ycat + (size_t)t * D; bf16_t* o = yb + (size_t)t * D;
        const f32x4 a = *(const f32x4*)(y + lane * 4);
        f32x2 b[3], c[3];
#pragma unroll
        for (int i = 0; i < 3; ++i) { b[i] = *(const f32x2*)(y + 256 + lane * 6 + 2 * i); c[i] = *(const f32x2*)(y + 640 + lane * 6 + 2 * i); }
        float sa = (a.x * a.x + a.y * a.y) + (a.z * a.z + a.w * a.w), sb = 0.f, sc = 0.f;
#pragma unroll
        for (int i = 0; i < 3; ++i) { sb += b[i].x * b[i].x + b[i].y * b[i].y; sc += c[i].x * c[i].x + c[i].y * c[i].y; }
        const float ra = rsqrtf(wave_sum(sa) * (1.f / 256.f) + EPS), rb = rsqrtf(wave_sum(sb) * (1.f / 384.f) + EPS), rc = rsqrtf(wave_sum(sc) * (1.f / 384.f) + EPS);
        *(u32x2*)(o + lane * 4) = (u32x2){pk_bf16(a.x * ra * ga.x, a.y * ra * ga.y), pk_bf16(a.z * ra * ga.z, a.w * ra * ga.w)};
#pragma unroll
        for (int i = 0; i < 3; ++i) {
            *(unsigned*)(o + 256 + lane * 6 + 2 * i) = pk_bf16(b[i].x * rb * gb[i].x, b[i].y * rb * gb[i].y);
            *(unsigned*)(o + 640 + lane * 6 + 2 * i) = pk_bf16(c[i].x * rc * gc[i].x, c[i].y * rc * gc[i].y);
        }
    }
}

__device__ __forceinline__ void ph_xattn(const float* qx, const float* kvx, bf16_t* ox) {
    GT_DECL
    for (int w = gw; w < T * 4; w += NW) {
        const int h = w & 3, t = w >> 2, b = t >> 11;
        const float* q = qx + (size_t)t * D + h * 256;
        const float* kb = kvx + (size_t)(b * 256) * 2048 + h * 256;
        float sc[4] = {0.f, 0.f, 0.f, 0.f};
        for (int d = 0; d < 256; d += 4) {
            const f32x4 qv = *(const f32x4*)(q + d);
#pragma unroll
            for (int i = 0; i < 4; ++i) { const f32x4 kv = *(const f32x4*)(kb + (size_t)(i * 64 + lane) * 2048 + d); sc[i] += qv.x * kv.x + qv.y * kv.y + qv.z * kv.z + qv.w * kv.w; }
        }
        float mx = -1e30f;
#pragma unroll
        for (int i = 0; i < 4; ++i) { sc[i] *= 0.0625f; mx = fmaxf(mx, sc[i]); }
        mx = wave_max(mx);
        float ls = 0.f;
#pragma unroll
        for (int i = 0; i < 4; ++i) { sc[i] = __expf(sc[i] - mx); ls += sc[i]; }
        ls = wave_sum(ls);
        const float inv = 1.f / ls;
        f32x4 o = {0.f, 0.f, 0.f, 0.f};
        const float* vb = kb + 1024 + lane * 4;
#pragma unroll
        for (int i = 0; i < 4; ++i)
            for (int j = 0; j < 64; ++j) {
                const float pj = __shfl(sc[i], j);
                const f32x4 vv = *(const f32x4*)(vb + (size_t)(i * 64 + j) * 2048);
                o.x += pj * vv.x; o.y += pj * vv.y; o.z += pj * vv.z; o.w += pj * vv.w;
            }
        *(u32x2*)(ox + (size_t)t * D + h * 256 + lane * 4) = (u32x2){pk_bf16(o.x * inv, o.y * inv), pk_bf16(o.z * inv, o.w * inv)};
    }
}

__device__ __forceinline__ void ph_moe_route(const bf16_t* h, const float* gain, const float* router, bf16_t* hn, int* topi, float* topw) {
    GT_DECL
    f32x4 ra[16], rb[16], gg4[4];
#pragma unroll
    for (int j = 0; j < 4; ++j) {
        gg4[j] = *((const f32x4*)gain + lane + 64 * j);
#pragma unroll
        for (int c = 0; c < 4; ++c) { const float* r = router + (size_t)(j * 256 + lane * 4 + c) * 8; ra[4 * j + c] = *(const f32x4*)r; rb[4 * j + c] = *(const f32x4*)(r + 4); }
    }
    for (int t = gw; t < T; t += NW) {
        const u32x2* x = (const u32x2*)(h + (size_t)t * D) + lane;
        f32x4 v[4]; float s = 0.f;
#pragma unroll
        for (int j = 0; j < 4; ++j) { const u32x2 xb = x[64 * j]; v[j] = (f32x4){bflo(xb.x), bfhi(xb.x), bflo(xb.y), bfhi(xb.y)}; s += v[j].x * v[j].x + v[j].y * v[j].y + v[j].z * v[j].z + v[j].w * v[j].w; }
        const float rstd = rsqrtf(wave_sum(s) * (1.f / D) + EPS);
        u32x2* o = (u32x2*)(hn + (size_t)t * D) + lane;
        float lg[8] = {0.f, 0.f, 0.f, 0.f, 0.f, 0.f, 0.f, 0.f};
#pragma unroll
        for (int j = 0; j < 4; ++j) {
            const f32x4 gg = gg4[j];
            const f32x4 y = {v[j].x * rstd * gg.x, v[j].y * rstd * gg.y, v[j].z * rstd * gg.z, v[j].w * rstd * gg.w};
            o[64 * j] = (u32x2){pk_bf16(y.x, y.y), pk_bf16(y.z, y.w)};
            const float yy[4] = {y.x, y.y, y.z, y.w};
#pragma unroll
            for (int c = 0; c < 4; ++c) {
                const f32x4 r0 = ra[4 * j + c], r1 = rb[4 * j + c];
                lg[0] += yy[c] * r0.x; lg[1] += yy[c] * r0.y; lg[2] += yy[c] * r0.z; lg[3] += yy[c] * r0.w;
                lg[4] += yy[c] * r1.x; lg[5] += yy[c] * r1.y; lg[6] += yy[c] * r1.z; lg[7] += yy[c] * r1.w;
            }
        }
#pragma unroll
        for (int e = 0; e < 8; ++e) lg[e] = wave_sum(lg[e]);
        float v0 = -3e38f; int i0 = 0;
#pragma unroll
        for (int e = 0; e < 8; ++e) if (lg[e] > v0) { v0 = lg[e]; i0 = e; }
        float v1 = -3e38f; int i1 = 0;
#pragma unroll
        for (int e = 0; e < 8; ++e) if (e != i0 && lg[e] > v1) { v1 = lg[e]; i1 = e; }
        const float e1 = __expf(v1 - v0), w0 = 1.f / (1.f + e1), w1 = e1 * w0;
        if (lane == 0) { topi[t * 2] = i0; topi[t * 2 + 1] = i1; topw[t * 2] = w0; topw[t * 2 + 1] = w1; }
    }
}
__device__ __forceinline__ void ph_moe_sort(LAS int* lds, const int* topi, int* pos, int* rsrc, int* texp) {
    if (blockIdx.x != 0) return;
    const int tid = tid_(), lane = tid & 63, wave = tid >> 6;
    LAS int* cnt = lds;
    LAS int* tot = lds + 8 * 512;
    int c[8];
#pragma unroll
    for (int k = 0; k < 8; ++k) c[k] = 0;
    for (int i = 0; i < 64; ++i) { const int e = topi[i * NTHR + tid];
#pragma unroll
        for (int k = 0; k < 8; ++k) c[k] += (e == k) ? 1 : 0; }
#pragma unroll
    for (int k = 0; k < 8; ++k) cnt[k * NTHR + tid] = c[k];
    __syncthreads();
    {
        int v[8]; int sum = 0;
#pragma unroll
        for (int j = 0; j < 8; ++j) { v[j] = cnt[wave * NTHR + lane * 8 + j]; sum += v[j]; }
        int incl = sum;
#pragma unroll
        for (int o = 1; o < 64; o <<= 1) { const int t = __shfl_up(incl, o); if (lane >= o) incl += t; }
        int run = incl - sum;
#pragma unroll
        for (int j = 0; j < 8; ++j) { cnt[wave * NTHR + lane * 8 + j] = run; run += v[j]; }
        if (lane == 63) tot[wave] = incl;
    }
    __syncthreads();
    if (tid == 0) { int off = 0; for (int e = 0; e < 8; ++e) { tot[8 + e] = off; off += (tot[e] + 255) & ~255; } tot[16] = off; texp[160] = off >> 8; }
    __syncthreads();
    if (tid < MOE_TILES) { const int r0 = tid * 256; int ex = -1;
        for (int e = 0; e < 8; ++e) { const int lo = tot[8 + e], hi = lo + ((tot[e] + 255) & ~255); if (r0 >= lo && r0 < hi) ex = e; }
        texp[tid] = ex; }
    for (int e = 0; e < 8; ++e) { const int lo = tot[8 + e] + tot[e], hi = tot[8 + e] + ((tot[e] + 255) & ~255); for (int r = lo + tid; r < hi; r += NTHR) rsrc[r] = 0; }
    int run[8];
#pragma unroll
    for (int k = 0; k < 8; ++k) run[k] = tot[8 + k] + cnt[k * NTHR + tid];
    for (int i = 0; i < 64; ++i) {
        const int idx = i * NTHR + tid, e = topi[idx];
        int r = 0;
#pragma unroll
        for (int k = 0; k < 8; ++k) { r = (e == k) ? run[k] : r; run[k] += (e == k) ? 1 : 0; }
        rsrc[r] = idx >> 1; pos[idx] = r;
    }
}
__device__ __forceinline__ f32x4 moe_row4(const bf16_t* ys, const float* ys2p, int r, int col) {
    if (r < 2 * MOE_RT * 256) { const u32x2 b2 = *(const u32x2*)(ys + (size_t)r * D + col); return (f32x4){bflo(b2.x), bfhi(b2.x), bflo(b2.y), bfhi(b2.y)}; }
    const float* q = ys2p + (size_t)(r - 2 * MOE_RT * 256) * D + col;
    return (*(const f32x4*)q + *(const f32x4*)(q + (size_t)2048 * D)) + (*(const f32x4*)(q + (size_t)2 * 2048 * D) + *(const f32x4*)(q + (size_t)3 * 2048 * D));
}
__device__ __forceinline__ void ph_moe_combine_final(const bf16_t* h, const bf16_t* ys, const float* ys2p, const int* pos, const float* topw, const float* gain, float* out) {
    GT_DECL
    for (int t = gw; t < T; t += NW) {
        const u32x2* x = (const u32x2*)(h + (size_t)t * D) + lane;
        const int r0 = pos[t * 2], r1 = pos[t * 2 + 1];
        const float w0 = topw[t * 2], w1 = topw[t * 2 + 1];
        f32x4 v[4]; float s = 0.f;
#pragma unroll
        for (int j = 0; j < 4; ++j) { const u32x2 xb = x[64 * j]; const f32x4 a = {bflo(xb.x), bfhi(xb.x), bflo(xb.y), bfhi(xb.y)};
            const f32x4 b = moe_row4(ys, ys2p, r0, 256 * j + 4 * lane), c = moe_row4(ys, ys2p, r1, 256 * j + 4 * lane);
            v[j] = (f32x4){a.x + w0 * b.x + w1 * c.x, a.y + w0 * b.y + w1 * c.y, a.z + w0 * b.z + w1 * c.z, a.w + w0 * b.w + w1 * c.w};
            s += v[j].x * v[j].x + v[j].y * v[j].y + v[j].z * v[j].z + v[j].w * v[j].w; }
        const float rstd = rsqrtf(wave_sum(s) * (1.f / D) + EPS);
        f32x4* o = (f32x4*)(out + (size_t)t * D) + lane; const f32x4* g = (const f32x4*)gain + lane;
#pragma unroll
        for (int j = 0; j < 4; ++j) { const f32x4 gg = g[64 * j]; o[64 * j] = (f32x4){v[j].x * rstd * gg.x, v[j].y * rstd * gg.y, v[j].z * rstd * gg.z, v[j].w * rstd * gg.w}; }
    }
}

namespace fa {
typedef short bf16x8 __attribute__((ext_vector_type(8)));
typedef __bf16 bfv8 __attribute__((ext_vector_type(8)));
typedef float f32x8 __attribute__((ext_vector_type(8)));
typedef float f32x16 __attribute__((ext_vector_type(16)));
typedef short s16x4 __attribute__((ext_vector_type(4)));
#define FA_MFMA(a, b, c) __builtin_amdgcn_mfma_f32_32x32x16_bf16((a), (b), (c), 0, 0, 0)
constexpr float LOG2E = 1.4426950408889634f;
constexpr float NEG_S = -1e30f, M_INIT = -1e20f;
enum { MASK_NONE = 0, MASK_CAUSAL = 1, MASK_WIN = 2, MASK_SEL = 3 };

__device__ __forceinline__ bf16x8 pack8(float a0, float a1, float a2, float a3, float a4, float a5, float a6, float a7) {
    const f32x8 v = {a0, a1, a2, a3, a4, a5, a6, a7};
    return __builtin_bit_cast(bf16x8, __builtin_convertvector(v, bfv8));
}
struct KVSrc { const bf16_t* K0; int ldk0; const bf16_t* K1; int ldk1; const bf16_t* V; int ldv; };

template <int DK, int DK0, int DVT, int KT>
struct Geo {
    static constexpr int KSTR = DK * 2 + 16, VSTR = (DVT == 64) ? 192 : (DVT * 2 + 64);
    static constexpr int KBUF = KT * KSTR, VBUF = KT * VSTR;
    static constexpr int NKC = KT * DK / 8 / 256, NVC = KT * DVT / 8 / 256;
    static constexpr int LDS_TILES = 2 * KBUF + 2 * VBUF;
    static_assert(NKC * 256 * 8 == KT * DK && NVC * 256 * 8 == KT * DVT && (VSTR / 4) % 64 % 32 == 16, "staging split / V stride");
};

template <int DK, int DK0, int DVW, int DVT, int KT, int MASK>
__device__ __forceinline__ void attn_pass(LAS unsigned char* lds, const KVSrc src, const bf16x8 (&qf)[DK / 16], f32x16 (&O)[DVW / 32], float& m, float& l,
                                          int kt_lo, int kt_hi, int qpos, int qw, int dvoff, unsigned selmask, const LAS float* biasT, float c1) {
    typedef Geo<DK, DK0, DVT, KT> G;
    const int tid = tid_(), lane = tid & 63, r = lane & 31, h = lane >> 5;
    u32x4 kreg[G::NKC]; u32x4 vreg[G::NVC];
    const int trq = (lane & 15) >> 2, trp = lane & 3, trblk = (lane >> 4) & 1;
#define FA_ISSUE(k0_) do { const int k0i_ = (k0_); \
    if (tid >= 256) { _Pragma("unroll") for (int i_ = 0; i_ < G::NKC; ++i_) { const int c_ = (tid - 256) + 256 * i_, key_ = c_ / (DK / 8), col_ = (c_ % (DK / 8)) * 8; \
        const bf16_t* p_ = (col_ < DK0) ? src.K0 + (size_t)(k0i_ + key_) * src.ldk0 + col_ : src.K1 + (size_t)(k0i_ + key_) * src.ldk1 + (col_ - DK0); \
        kreg[i_] = *(const u32x4*)p_; } } \
    else { _Pragma("unroll") for (int i_ = 0; i_ < G::NVC; ++i_) { const int c_ = tid + 256 * i_, key_ = c_ / (DVT / 8), cc_ = c_ % (DVT / 8); \
        vreg[i_] = *(const u32x4*)(src.V + (size_t)(k0i_ + key_) * src.ldv + cc_ * 8); } } } while (0)
#define FA_COMMIT(buf_) do { LAS unsigned char* kb_ = lds + (buf_) * G::KBUF; LAS unsigned char* vb_ = lds + 2 * G::KBUF + (buf_) * G::VBUF; \
    if (tid >= 256) { _Pragma("unroll") for (int i_ = 0; i_ < G::NKC; ++i_) { const int c_ = (tid - 256) + 256 * i_, key_ = c_ / (DK / 8), cc_ = c_ % (DK / 8); \
        *(LAS u32x4*)(kb_ + key_ * G::KSTR + cc_ * 16) = kreg[i_]; } } \
    else { _Pragma("unroll") for (int i_ = 0; i_ < G::NVC; ++i_) { const int c_ = tid + 256 * i_, key_ = c_ / (DVT / 8), cc_ = c_ % (DVT / 8); \
        *(LAS u32x4*)(vb_ + key_ * G::VSTR + cc_ * 16) = vreg[i_]; } } } while (0)
    if (kt_lo < kt_hi) { FA_ISSUE(kt_lo * KT); FA_COMMIT(0); }
    __syncthreads();
    for (int kt = kt_lo; kt < kt_hi; ++kt) {
        const int buf = (kt - kt_lo) & 1, k0 = kt * KT;
        if (kt + 1 < kt_hi) FA_ISSUE(k0 + KT);
        bool need = true, full = true;
        if (MASK == MASK_CAUSAL || MASK == MASK_SEL) { need = k0 <= qw + 31; full = (k0 + KT - 1 <= qw); }
        if (MASK == MASK_WIN) { need = (k0 <= qw + 31) && (k0 + KT - 1 >= qw - 255); full = (k0 + KT - 1 <= qw) && (k0 >= qw + 31 - 255); }
        if (need) {
            const LAS unsigned char* kb = lds + buf * G::KBUF; const LAS unsigned char* vb = lds + 2 * G::KBUF + buf * G::VBUF;
            f32x16 S[KT / 32];
#pragma unroll
            for (int mt = 0; mt < KT / 32; ++mt) {
#pragma unroll
                for (int i = 0; i < 16; ++i) S[mt][i] = 0.f;
#pragma unroll
                for (int s = 0; s < DK / 16; ++s) {
                    const bf16x8 a = *(const LAS bf16x8*)(kb + (32 * mt + r) * G::KSTR + (2 * s + h) * 16);
                    __builtin_amdgcn_s_setprio(1); S[mt] = FA_MFMA(a, qf[s], S[mt]); __builtin_amdgcn_s_setprio(0);
                }
            }
            const bool hasbias = (MASK == MASK_WIN || MASK == MASK_SEL);
            const bool near = hasbias && (qw - (k0 + KT - 1) < 127);
            const bool selok = (MASK == MASK_SEL) ? (((selmask >> (k0 >> 6)) & 1u) != 0u) : true;
            const float bfar = hasbias ? biasT[256] : 0.f;
            float tmax = NEG_S;
            bool raw = false;
            if (full && !near) {
                if (!hasbias && MASK != MASK_SEL) {
                    raw = true;
#pragma unroll
                    for (int mt = 0; mt < KT / 32; ++mt)
#pragma unroll
                        for (int i = 0; i < 16; ++i) tmax = fmaxf(tmax, S[mt][i]);
                    tmax *= c1;
                } else {
#pragma unroll
                    for (int mt = 0; mt < KT / 32; ++mt)
#pragma unroll
                        for (int i = 0; i < 16; ++i) { float v = S[mt][i] * c1 + bfar; if (MASK == MASK_SEL) v = selok ? v : NEG_S; S[mt][i] = v; tmax = fmaxf(tmax, v); }
                }
            } else if (hasbias) {
                const LAS float* tb = biasT + (383 - (qpos - k0 - 4 * h));
#pragma unroll
                for (int mt = 0; mt < KT / 32; ++mt)
#pragma unroll
                    for (int i = 0; i < 16; ++i) {
                        float v = S[mt][i] * c1 + tb[32 * mt + (i & 3) + 8 * (i >> 2)];
                        if (MASK == MASK_SEL) v = selok ? v : NEG_S;
                        v = fmaxf(v, NEG_S);
                        S[mt][i] = v; tmax = fmaxf(tmax, v);
                    }
            } else {
                const int qrel = qpos - k0 - 4 * h;
#pragma unroll
                for (int mt = 0; mt < KT / 32; ++mt)
#pragma unroll
                    for (int i = 0; i < 16; ++i) {
                        const int dist = qrel - (32 * mt + (i & 3) + 8 * (i >> 2));
                        bool ok = selok;
                        if (MASK != MASK_NONE) ok = ok && (dist >= 0);
                        if (MASK == MASK_WIN) ok = ok && (dist < 256);
                        float b = 0.f;
                        if (hasbias) { const int di = dist < 0 ? 0 : (dist > 127 ? 127 : dist); b = biasT[di]; }
                        const float v = ok ? S[mt][i] * c1 + b : NEG_S;
                        S[mt][i] = v; tmax = fmaxf(tmax, v);
                    }
            }
            tmax = xhalf_max(tmax);
            const float mn = fmaxf(m, tmax);
            const bool moved = mn > m;
            float ps = 0.f;
            if (raw) {
#pragma unroll
                for (int mt = 0; mt < KT / 32; ++mt)
#pragma unroll
                    for (int i = 0; i < 16; ++i) { const float pv = __builtin_amdgcn_exp2f(S[mt][i] * c1 - mn); S[mt][i] = pv; ps += pv; }
            } else {
#pragma unroll
                for (int mt = 0; mt < KT / 32; ++mt)
#pragma unroll
                    for (int i = 0; i < 16; ++i) { const float pv = __builtin_amdgcn_exp2f(S[mt][i] - mn); S[mt][i] = pv; ps += pv; }
            }
            if (__any(moved)) {
                const float alpha = __builtin_amdgcn_exp2f(m - mn);
                l *= alpha;
#pragma unroll
                for (int dt = 0; dt < DVW / 32; ++dt)
#pragma unroll
                    for (int i = 0; i < 16; ++i) O[dt][i] *= alpha;
            }
            m = mn;
            l += ps;
#pragma unroll
            for (int mt = 0; mt < KT / 32; ++mt)
#pragma unroll
                for (int s = 0; s < 2; ++s) {
                    const bf16x8 pb = pack8(S[mt][8 * s + 0], S[mt][8 * s + 1], S[mt][8 * s + 2], S[mt][8 * s + 3], S[mt][8 * s + 4], S[mt][8 * s + 5], S[mt][8 * s + 6], S[mt][8 * s + 7]);
#pragma unroll
                    for (int dt = 0; dt < DVW / 32; ++dt) {
                        const LAS unsigned char* vp = vb + (32 * mt + 16 * s + 4 * h + trq) * G::VSTR + (dvoff + 32 * dt + 16 * trblk + 4 * trp) * 2;
                        const s16x4 lo = __builtin_amdgcn_ds_read_tr16_b64_v4i16((LAS s16x4*)vp);
                        const s16x4 hi = __builtin_amdgcn_ds_read_tr16_b64_v4i16((LAS s16x4*)(vp + 8 * G::VSTR));
                        const bf16x8 av = __builtin_shufflevector(lo, hi, 0, 1, 2, 3, 4, 5, 6, 7);
                        O[dt] = FA_MFMA(av, pb, O[dt]);
                    }
                }
        }
        if (kt + 1 < kt_hi) FA_COMMIT(buf ^ 1);
        __syncthreads();
    }
#undef FA_ISSUE
#undef FA_COMMIT
}

__device__ __forceinline__ bf16x8 ld8f(const float* p) { const f32x4 a = *(const f32x4*)p, b = *(const f32x4*)(p + 4); return pack8(a.x, a.y, a.z, a.w, b.x, b.y, b.z, b.w); }

__device__ __forceinline__ int next_unit(unsigned* ctr, volatile LAS unsigned* uw) {
    __syncthreads();
    if (threadIdx.x == 0) *uw = atomicAdd(ctr, 1u);
    __syncthreads();
    return (int)*uw;
}
constexpr int LDS_BIAS = 98304, LDS_UW = 98304 + 1024;

__device__ __forceinline__ void mla_unit(LAS unsigned char* lds, int qb, int bh, const bf16_t* qmla, const bf16_t* kvmb, const bf16_t* krb, const float* rope, float* ycat) {
    const int tid = tid_(), lane = tid & 63, wave = tid >> 6, r = lane & 31, h = lane >> 5;
    {
        const int b = bh / 6, hd = bh % 6;
        const int qw = qb * 256 + wave * 32, qpos = qw + r;
        const bf16_t* qp = qmla + (size_t)(b * SEQ + qpos) * 768 + hd * 96;
        bf16x8 qf[6];
#pragma unroll
        for (int s = 0; s < 4; ++s) qf[s] = *(const bf16x8*)(qp + 16 * s + 8 * h);
        {
            const u32x4 r1 = *(const u32x4*)(qp + 64 + 8 * h), r2 = *(const u32x4*)(qp + 80 + 8 * h);
            const f32x4 x1a = {bflo(r1.x), bfhi(r1.x), bflo(r1.y), bfhi(r1.y)}, x1b = {bflo(r1.z), bfhi(r1.z), bflo(r1.w), bfhi(r1.w)};
            const f32x4 x2a = {bflo(r2.x), bfhi(r2.x), bflo(r2.y), bfhi(r2.y)}, x2b = {bflo(r2.z), bfhi(r2.z), bflo(r2.w), bfhi(r2.w)};
            const float* cs = rope + qpos * 16 + 8 * h; const float* sn = rope + SEQ * 16 + qpos * 16 + 8 * h;
            const f32x4 ca = *(const f32x4*)cs, cb = *(const f32x4*)(cs + 4), sa = *(const f32x4*)sn, sb = *(const f32x4*)(sn + 4);
            qf[4] = pack8(x1a.x * ca.x - x2a.x * sa.x, x1a.y * ca.y - x2a.y * sa.y, x1a.z * ca.z - x2a.z * sa.z, x1a.w * ca.w - x2a.w * sa.w,
                          x1b.x * cb.x - x2b.x * sb.x, x1b.y * cb.y - x2b.y * sb.y, x1b.z * cb.z - x2b.z * sb.z, x1b.w * cb.w - x2b.w * sb.w);
            qf[5] = pack8(x2a.x * ca.x + x1a.x * sa.x, x2a.y * ca.y + x1a.y * sa.y, x2a.z * ca.z + x1a.z * sa.z, x2a.w * ca.w + x1a.w * sa.w,
                          x2b.x * cb.x + x1b.x * sb.x, x2b.y * cb.y + x1b.y * sb.y, x2b.z * cb.z + x1b.z * sb.z, x2b.w * cb.w + x1b.w * sb.w);
        }
        KVSrc src; src.K0 = kvmb + (size_t)b * SEQ * 768 + hd * 128; src.ldk0 = 768; src.K1 = krb + (size_t)b * SEQ * 32; src.ldk1 = 32; src.V = kvmb + (size_t)b * SEQ * 768 + hd * 128 + 64; src.ldv = 768;
        f32x16 O[2];
#pragma unroll
        for (int dt = 0; dt < 2; ++dt)
#pragma unroll
            for (int i = 0; i < 16; ++i) O[dt][i] = 0.f;
        float m = M_INIT, l = 0.f;
        attn_pass<96, 64, 64, 64, 64, MASK_CAUSAL>(lds, src, qf, O, m, l, 0, (qb + 1) * 4, qpos, qw, 0, 0u, nullptr, 0.10206207261596575f * LOG2E);
        const float inv = 1.f / xhalf_sum(l);
        float* op = ycat + (size_t)(b * SEQ + qpos) * D + 256 + hd * 64;
#pragma unroll
        for (int dt = 0; dt < 2; ++dt)
#pragma unroll
            for (int g = 0; g < 4; ++g)
                *(f32x4*)(op + 32 * dt + 8 * g + 4 * h) = (f32x4){O[dt][4 * g] * inv, O[dt][4 * g + 1] * inv, O[dt][4 * g + 2] * inv, O[dt][4 * g + 3] * inv};
    }
}

__device__ __forceinline__ void selwin_unit(LAS unsigned char* lds, int qb, int bh, const float* proj, const bf16_t* nqb, const bf16_t* nkvb, const float* impp, const float* relb, float* ycat) {
    const int tid = tid_(), lane = tid & 63, wave = tid >> 6, r = lane & 31, h = lane >> 5;
    LAS float* biasT = (LAS float*)(lds + LDS_BIAS);
    {
        const int b = bh / 6, hh = bh % 6, g = hh / 3;
        { const int dist = 383 - tid; biasT[tid] = (dist < 0 || dist >= 256) ? NEG_S : relb[t5_bucket(dist > 127 ? 127 : dist) * 6 + hh] * LOG2E; }
        const int qw = qb * 256 + wave * 32, qpos = qw + r;
        const size_t trow = (size_t)(b * SEQ + qpos);
        const bf16_t* qp = nqb + trow * 384 + hh * 64;
        bf16x8 qf[4];
#pragma unroll
        for (int s = 0; s < 4; ++s) qf[s] = *(const bf16x8*)(qp + 16 * s + 8 * h);
        const unsigned selmask = nsa_topk_mask(impp + ((size_t)(b * 6 + g * 3) * 32) * SEQ + qpos, qpos >> 6);
        const bf16_t* kvb = nkvb + (size_t)b * SEQ * 768 + g * 64;
        f32x16 O[2], Os[2];
        float m, l;
        KVSrc src; src.K1 = nullptr; src.ldk1 = 0; src.ldk0 = 768; src.ldv = 768;
#pragma unroll
        for (int dt = 0; dt < 2; ++dt)
#pragma unroll
            for (int i = 0; i < 16; ++i) O[dt][i] = 0.f;
        m = M_INIT; l = 0.f;
        src.K0 = kvb + 2 * 128; src.V = kvb + 3 * 128;
        attn_pass<64, 64, 64, 64, 64, MASK_SEL>(lds, src, qf, O, m, l, 0, (qb + 1) * 4, qpos, qw, 0, selmask, biasT, 0.125f * LOG2E);
        {
            const float gs = sigmoidf_(proj[trow * INLD + O_NG + 6 + hh]) / xhalf_sum(l);
#pragma unroll
            for (int dt = 0; dt < 2; ++dt)
#pragma unroll
                for (int i = 0; i < 16; ++i) { Os[dt][i] = O[dt][i] * gs; O[dt][i] = 0.f; }
        }
        m = M_INIT; l = 0.f;
        src.K0 = kvb + 4 * 128; src.V = kvb + 5 * 128;
        attn_pass<64, 64, 64, 64, 64, MASK_WIN>(lds, src, qf, O, m, l, qb > 0 ? qb * 4 - 4 : 0, (qb + 1) * 4, qpos, qw, 0, 0u, biasT, 0.125f * LOG2E);
        const float gwn = sigmoidf_(proj[trow * INLD + O_NG + 12 + hh]) / xhalf_sum(l);
        float* op = ycat + trow * D + 640 + hh * 64;
#pragma unroll
        for (int dt = 0; dt < 2; ++dt)
#pragma unroll
            for (int gq = 0; gq < 4; ++gq) {
                float* o4 = op + 32 * dt + 8 * gq + 4 * h;
                const f32x4 old = *(const f32x4*)o4;
                *(f32x4*)o4 = (f32x4){old.x + Os[dt][4 * gq] + O[dt][4 * gq] * gwn, old.y + Os[dt][4 * gq + 1] + O[dt][4 * gq + 1] * gwn,
                                      old.z + Os[dt][4 * gq + 2] + O[dt][4 * gq + 2] * gwn, old.w + Os[dt][4 * gq + 3] + O[dt][4 * gq + 3] * gwn};
            }
    }
}

__device__ __forceinline__ void ph_attn_merged(LAS unsigned char* lds, unsigned* ctr, const bf16_t* qmla, const bf16_t* kvmb, const bf16_t* krb, const float* rope,
                                               const float* proj, const bf16_t* nqb, const bf16_t* nkvb, const float* impp, const float* relb, float* ycat) {
    volatile LAS unsigned* uw = (volatile LAS unsigned*)(lds + LDS_UW);
    for (;;) {
        const int u = next_unit(ctr, uw);
        if (u >= 16 * 48) break;
        const int grp = u / 48, bh = u % 48;
        const unsigned code = (unsigned)((0x7654736251430210ull >> (4 * (15 - grp))) & 0xfull);
        const bool is_mla = ((0x0ab7u >> (15 - grp)) & 1u) != 0u;
        if (is_mla) mla_unit(lds, (int)code, bh, qmla, kvmb, krb, rope, ycat);
        else selwin_unit(lds, (int)code, bh, proj, nqb, nkvb, impp, relb, ycat);
    }
}

__device__ __forceinline__ void ph_xattn_mfma(LAS unsigned char* lds, unsigned* ctr, const bf16_t* qx, const bf16_t* kvxb, bf16_t* oxb) {
    const int tid = tid_(), lane = tid & 63, wave = tid >> 6, r = lane & 31, h = lane >> 5;
    volatile LAS unsigned* uw = (volatile LAS unsigned*)(lds + LDS_UW);
    for (;;) {
        const int u = next_unit(ctr, uw);
        if (u >= (T / 128) * 4) break;
        const int hd = u & 3, tt = u >> 2, t0 = tt * 128, b = t0 >> 11;
        const int qw = t0 + (wave & 3) * 32, qrow = qw + r, dvoff = (wave >> 2) * 128;
        const bf16_t* qp = qx + (size_t)qrow * D + hd * 256;
        bf16x8 qf[16];
#pragma unroll
        for (int s = 0; s < 16; ++s) qf[s] = *(const bf16x8*)(qp + 16 * s + 8 * h);
        KVSrc src; src.K0 = kvxb + (size_t)(b * 256) * 2048 + hd * 256; src.ldk0 = 2048; src.K1 = nullptr; src.ldk1 = 0; src.V = src.K0 + 1024; src.ldv = 2048;
        f32x16 O[4];
#pragma unroll
        for (int dt = 0; dt < 4; ++dt)
#pragma unroll
            for (int i = 0; i < 16; ++i) O[dt][i] = 0.f;
        float m = M_INIT, l = 0.f;
        attn_pass<256, 256, 128, 256, 32, MASK_NONE>(lds, src, qf, O, m, l, 0, 8, 0, 0, dvoff, 0u, nullptr, 0.0625f * LOG2E);
        const float inv = 1.f / xhalf_sum(l);
        bf16_t* op = oxb + (size_t)qrow * D + hd * 256 + dvoff;
#pragma unroll
        for (int dt = 0; dt < 4; ++dt)
#pragma unroll
            for (int g = 0; g < 4; ++g)
                *(u32x2*)(op + 32 * dt + 8 * g + 4 * h) = (u32x2){pk_bf16(O[dt][4 * g] * inv, O[dt][4 * g + 1] * inv), pk_bf16(O[dt][4 * g + 2] * inv, O[dt][4 * g + 3] * inv)};
    }
}
}

__device__ __forceinline__ void ph_pe_bias(const Params& p, float* peb) {
    GT_DECL
    const int gwv = (tid >> 6) * (int)gridDim.x + (int)blockIdx.x;
    for (int w = gwv; w < 2 * 2 * 64; w += NW) {
        const int c = w & 63, lj = w >> 6;
        const float* pe = p.in[IN_NPE] + (size_t)lj * 2048; const float* w1 = p.in[IN_NW1] + (size_t)lj * 2048 * 64 + c;
        float acc = 0.f;
        for (int i = 0; i < 32; ++i) { const int k = lane + 64 * i; acc += pe[k] * w1[(size_t)k * 64]; }
        acc = wave_sum(acc);
        if (lane == 0) peb[w] = acc;
    }
}
__device__ __forceinline__ void ph_cmp_mfma(const Params& p, int l, const bf16_t* nkvb, const bf16_t* w1t, const float* peb, bf16_t* kcb, bf16_t* vct, LAS unsigned char* lds) {
    const int tid = tid_(), lane = tid & 63, r = lane & 31, h = lane >> 5, wave = tid >> 6;
    LAS float* red = (LAS float*)lds;
    for (int u = (int)blockIdx.x; u < 128; u += (int)gridDim.x) {
        const int rt = u & 3, g = (u >> 2) & 1, b = (u >> 3) & 7, j = u >> 6;
        const int n = rt * 32 + r, nc = n < NBC ? n : NBC - 1;
        const bf16_t* xrow = nkvb + (size_t)(b * SEQ + nc * 16) * 768 + j * 128 + g * 64;
        const bf16_t* w1 = w1t + (size_t)j * 64 * 2048;
        fa::f32x16 acc[2];
#pragma unroll
        for (int ct = 0; ct < 2; ++ct)
#pragma unroll
            for (int i = 0; i < 16; ++i) acc[ct][i] = 0.f;
#pragma unroll 2
        for (int pp = 0; pp < 4; ++pp) {
            const int pos = wave * 4 + pp;
#pragma unroll
            for (int s4 = 0; s4 < 4; ++s4) {
                const bf16x8_t bfr = *(const bf16x8_t*)(xrow + (size_t)pos * 768 + s4 * 16 + 8 * h);
                const int kk = pos * 64 + s4 * 16 + 8 * h;
#pragma unroll
                for (int ct = 0; ct < 2; ++ct) {
                    const bf16x8_t afr = *(const bf16x8_t*)(w1 + (size_t)(32 * ct + r) * 2048 + kk);
                    acc[ct] = FA_MFMA(afr, bfr, acc[ct]);
                }
            }
        }
        __syncthreads();
#pragma unroll
        for (int ct = 0; ct < 2; ++ct)
#pragma unroll
            for (int i = 0; i < 16; ++i) red[((wave * 2 + ct) * 16 + i) * 64 + lane] = acc[ct][i];
        __syncthreads();
        if (wave != 0) continue;
#pragma unroll 1
        for (int w8 = 1; w8 < 8; ++w8) {
#pragma unroll
            for (int ct = 0; ct < 2; ++ct)
#pragma unroll
                for (int i = 0; i < 16; ++i) acc[ct][i] += red[((w8 * 2 + ct) * 16 + i) * 64 + lane];
        }
        const float* pb = peb + (l * 2 + j) * 64;
#pragma unroll
        for (int ct = 0; ct < 2; ++ct)
#pragma unroll
            for (int g4 = 0; g4 < 4; ++g4) {
                const f32x4 bv = *(const f32x4*)(pb + 32 * ct + 8 * g4 + 4 * h);
                acc[ct][4 * g4 + 0] = gelu_tanh(acc[ct][4 * g4 + 0] + bv.x); acc[ct][4 * g4 + 1] = gelu_tanh(acc[ct][4 * g4 + 1] + bv.y);
                acc[ct][4 * g4 + 2] = gelu_tanh(acc[ct][4 * g4 + 2] + bv.z); acc[ct][4 * g4 + 3] = gelu_tanh(acc[ct][4 * g4 + 3] + bv.w);
            }
        const float* w2 = p.in[IN_NW2] + (size_t)(l * 2 + j) * 64 * 64;
        fa::f32x16 o[2];
#pragma unroll
        for (int ct = 0; ct < 2; ++ct)
#pragma unroll
            for (int i = 0; i < 16; ++i) o[ct][i] = 0.f;
#pragma unroll
        for (int ct = 0; ct < 2; ++ct)
#pragma unroll
            for (int s = 0; s < 2; ++s) {
                const bf16x8_t pbk = pack8f(acc[ct][8 * s + 0], acc[ct][8 * s + 1], acc[ct][8 * s + 2], acc[ct][8 * s + 3], acc[ct][8 * s + 4], acc[ct][8 * s + 5], acc[ct][8 * s + 6], acc[ct][8 * s + 7]);
#pragma unroll
                for (int ct2 = 0; ct2 < 2; ++ct2) {
                    const float* wp = w2 + (size_t)(32 * ct + 16 * s + 4 * h) * 64 + 32 * ct2 + r;
                    const bf16x8_t afr = pack8f(wp[0], wp[64], wp[128], wp[192], wp[512], wp[576], wp[640], wp[704]);
                    o[ct2] = FA_MFMA(afr, pbk, o[ct2]);
                }
            }
        const bool valid = n < NBC;
        if (j == 0) {
            bf16_t* kr = kcb + ((size_t)(b * 2 + g) * 128 + n) * 64;
#pragma unroll
            for (int ct2 = 0; ct2 < 2; ++ct2)
#pragma unroll
                for (int g4 = 0; g4 < 4; ++g4)
                    *(u32x2*)(kr + 32 * ct2 + 8 * g4 + 4 * h) = valid ? (u32x2){pk_bf16(o[ct2][4 * g4], o[ct2][4 * g4 + 1]), pk_bf16(o[ct2][4 * g4 + 2], o[ct2][4 * g4 + 3])} : (u32x2){0u, 0u};
        } else {
            bf16_t* vc = vct + (size_t)(b * 2 + g) * 64 * 128 + n;
#pragma unroll
            for (int ct2 = 0; ct2 < 2; ++ct2)
#pragma unroll
                for (int i = 0; i < 16; ++i) vc[(size_t)(32 * ct2 + (i & 3) + 8 * (i >> 2) + 4 * h) * 128] = valid ? f2bf(o[ct2][i]) : (bf16_t)0;
        }
    }
}
constexpr int LDS_CBIAS = 135168;
__device__ __forceinline__ void ph_nsa_cmp_mfma(const Params& p, const float* proj, const bf16_t* nqb, const bf16_t* kcb, const bf16_t* vct, float* impp, float* ycat, LAS unsigned char* lds) {
    const int tid = tid_(), lane = tid & 63, wave = tid >> 6;
    const int r = lane & 31, h = lane >> 5;
    LAS float* bt = (LAS float*)(lds + LDS_CBIAS);
    constexpr int KS = 144, VS = 264;
    LAS unsigned char* kl = lds;
    LAS unsigned char* vl = lds + 18432;
    for (int i = tid; i < 768; i += NTHR) bt[i] = p.in[IN_RELB][t5_bucket(i & 127) * 6 + (i >> 7)] * fa::LOG2E;
    for (int bu = (int)((blockIdx.x + 64u) % gridDim.x); bu < NB * 6 * 8; bu += (int)gridDim.x) {
        const int q8 = bu & 7, bh = bu >> 3, hh = bh % 6, b = bh / 6, g = hh / 3;
        __syncthreads();
        {
            const bf16_t* ksrc = kcb + (size_t)(b * 2 + g) * 128 * 64; const bf16_t* vsrc = vct + (size_t)(b * 2 + g) * 64 * 128;
#pragma unroll
            for (int i = 0; i < 2; ++i) { const int c = tid + 512 * i, row = c >> 3, cc = c & 7;
                *(LAS u32x4*)(kl + row * KS + cc * 16) = *(const u32x4*)(ksrc + (size_t)row * 64 + cc * 8); }
#pragma unroll
            for (int i = 0; i < 2; ++i) { const int c = tid + 512 * i, row = c >> 4, cc = c & 15;
                *(LAS u32x4*)(vl + row * VS + cc * 16) = *(const u32x4*)(vsrc + (size_t)row * 128 + cc * 8); }
        }
        const int qg = q8 * 8 + wave;
        const int s = qg * 32 + r; const size_t t = (size_t)b * SEQ + s;
        const bf16_t* qp = nqb + t * 384 + hh * 64;
        bf16x8_t qf[4];
#pragma unroll
        for (int ks = 0; ks < 4; ++ks) qf[ks] = *(const bf16x8_t*)(qp + 16 * ks + 8 * h);
        const float gate_logit = proj[t * INLD + O_NG + hh];
        __syncthreads();
        fa::f32x16 S[4];
#pragma unroll
        for (int mt = 0; mt < 4; ++mt) {
#pragma unroll
            for (int i = 0; i < 16; ++i) S[mt][i] = 0.f;
#pragma unroll
            for (int ks = 0; ks < 4; ++ks) {
                const bf16x8_t a = *(const LAS bf16x8_t*)(kl + (32 * mt + r) * KS + (2 * ks + h) * 16);
                S[mt] = FA_MFMA(a, qf[ks], S[mt]);
            }
        }
        const LAS float* bth = bt + hh * 128;
        const int qrel = s - 31 - 64 * h;
        float tmax = fa::NEG_S;
#pragma unroll
        for (int mt = 0; mt < 4; ++mt)
#pragma unroll
            for (int i = 0; i < 16; ++i) {
                const int dist = qrel - 16 * (32 * mt + (i & 3) + 8 * (i >> 2));
                const int di = dist < 0 ? 0 : (dist > 127 ? 127 : dist);
                const float v = dist >= 0 ? S[mt][i] * (0.125f * fa::LOG2E) + bth[di] : fa::NEG_S;
                S[mt][i] = v; tmax = fmaxf(tmax, v);
            }
        tmax = xhalf_max(tmax);
        const float mx = fmaxf(tmax, fa::M_INIT);
        float ps = 0.f;
#pragma unroll
        for (int mt = 0; mt < 4; ++mt)
#pragma unroll
            for (int i = 0; i < 16; ++i) { const float pv = __builtin_amdgcn_exp2f(S[mt][i] - mx); S[mt][i] = pv; ps += pv; }
        ps = xhalf_sum(ps);
        const float inv = ps > 0.f ? 1.f / ps : 0.f;
        {
            float own[16]; float prev = 0.f;
#pragma unroll
            for (int mt = 0; mt < 4; ++mt)
#pragma unroll
                for (int g4 = 0; g4 < 4; ++g4) {
                    const float qs = (S[mt][4 * g4] + S[mt][4 * g4 + 1]) + (S[mt][4 * g4 + 2] + S[mt][4 * g4 + 3]);
                    const auto sw = __builtin_amdgcn_permlane32_swap(__float_as_uint(S[mt][4 * g4 + 3]), __float_as_uint(S[mt][4 * g4 + 3]), false, false);
                    const float rl = __uint_as_float(h ? sw[0] : sw[1]);
                    const float extra = h ? rl : prev;
                    prev = rl;
                    own[4 * mt + g4] = (qs + extra) * inv;
                }
            float* ip = impp + ((size_t)(b * 6 + hh) * 32) * SEQ + s;
#pragma unroll
            for (int j = 0; j < 16; ++j) ip[(size_t)(2 * j + h) * SEQ] = own[j];
        }
        fa::f32x16 O[2];
#pragma unroll
        for (int dt = 0; dt < 2; ++dt)
#pragma unroll
            for (int i = 0; i < 16; ++i) O[dt][i] = 0.f;
#pragma unroll
        for (int mt = 0; mt < 4; ++mt)
#pragma unroll
            for (int s2 = 0; s2 < 2; ++s2) {
                const bf16x8_t pbk = pack8f(S[mt][8 * s2 + 0], S[mt][8 * s2 + 1], S[mt][8 * s2 + 2], S[mt][8 * s2 + 3], S[mt][8 * s2 + 4], S[mt][8 * s2 + 5], S[mt][8 * s2 + 6], S[mt][8 * s2 + 7]);
#pragma unroll
                for (int dt = 0; dt < 2; ++dt) {
                    const LAS unsigned char* vp = vl + (32 * dt + r) * VS + (32 * mt + 16 * s2 + 4 * h) * 2;
                    const u32x2 lo = *(const LAS u32x2*)vp, hi = *(const LAS u32x2*)(vp + 16);
                    const u32x4 av = {lo.x, lo.y, hi.x, hi.y};
                    O[dt] = FA_MFMA(__builtin_bit_cast(bf16x8_t, av), pbk, O[dt]);
                }
            }
        const float gate = sigmoidf_(gate_logit) * inv;
        float* op = ycat + t * D + 640 + hh * 64;
#pragma unroll
        for (int dt = 0; dt < 2; ++dt)
#pragma unroll
            for (int g4 = 0; g4 < 4; ++g4)
                *(f32x4*)(op + 32 * dt + 8 * g4 + 4 * h) = (f32x4){O[dt][4 * g4] * gate, O[dt][4 * g4 + 1] * gate, O[dt][4 * g4 + 2] * gate, O[dt][4 * g4 + 3] * gate};
    }
    __syncthreads();
}

__device__ __forceinline__ void cvt_layer(const Params& p, int l, int which, CvtCursor& cur, bf16_t* WB, LAS float* scr, int gwv, int nwv, int lane) {
    bf16_t* wl = WB + (size_t)l * WL_SIZE;
    if (which != 2) cvt_matrix<true>(cur, p.in[IN_XWKV] + (size_t)l * D * 2048, D, 2048, wl + WL_XWKV, D, 2048, 0, scr, gwv, nwv, lane);
    if (which == 1) return;
    cvt_matrix<false>(cur, p.in[IN_WIN] + (size_t)l * D * INC, D, INC, wl + WL_WIN, D, 1792, 0, scr, gwv, nwv, lane, l ? p.in[IN_MIXN] + D : nullptr);
    cvt_matrix<true>(cur, p.in[IN_MWUQ] + (size_t)l * 192 * 576, 192, 576, wl + WL_WUQ, 256, 768, 0, scr, gwv, nwv, lane);
    cvt_matrix<true>(cur, p.in[IN_MWUKV] + (size_t)l * 128 * 768, 128, 768, wl + WL_WUKV, 256, 768, 0, scr, gwv, nwv, lane);
    cvt_matrix<true>(cur, p.in[IN_SGLU] + (size_t)l * 256 * 256, 256, 256, wl + WL_WGLU, 256, 256, 0, scr, gwv, nwv, lane);
    cvt_matrix<true>(cur, p.in[IN_WOUT] + (size_t)l * D * D, D, D, wl + WL_WOUT, D, D, 0, scr, gwv, nwv, lane);
    cvt_matrix<true>(cur, p.in[IN_XWQ] + (size_t)l * D * D, D, D, wl + WL_XWQ, D, D, 0, scr, gwv, nwv, lane, p.in[IN_XN] + (size_t)l * D);
    cvt_matrix<true>(cur, p.in[IN_XWO] + (size_t)l * D * D, D, D, wl + WL_XWO, D, D, 0, scr, gwv, nwv, lane);
    cvt_matrix<true>(cur, p.in[IN_NW1] + (size_t)(l * 2) * 2048 * 64, 2048, 64, wl + WL_CW1, 2048, 64, 0, scr, gwv, nwv, lane);
    cvt_matrix<true>(cur, p.in[IN_NW1] + (size_t)(l * 2 + 1) * 2048 * 64, 2048, 64, wl + WL_CW1 + 64 * 2048, 2048, 64, 0, scr, gwv, nwv, lane);
}
__device__ __forceinline__ void ph_convert_small(const Params& p, bf16_t* WB, LAS unsigned char* lds) {
    GT_DECL
    LAS float* scr = (LAS float*)(lds + (tid >> 6) * 16384);
    CvtCursor cur{0};
    cvt_layer(p, 0, 0, cur, WB, scr, gw, NW, lane);
    cvt_layer(p, 1, 1, cur, WB, scr, gw, NW, lane);
    cvt_matrix<true>(cur, p.in[IN_DWG], D, FFD, WB + WD_GU, D, FFD, 1, scr, gw, NW, lane, p.in[IN_FFN]);
    cvt_matrix<true>(cur, p.in[IN_DWU], D, FFD, WB + WD_GU, D, FFD, 2, scr, gw, NW, lane, p.in[IN_FFN]);
    cvt_matrix<true>(cur, p.in[IN_DWD], FFD, D, WB + WD_DN, FFD, D, 0, scr, gw, NW, lane);
}
__device__ __forceinline__ void ph_convert_l1(const Params& p, bf16_t* WB, LAS unsigned char* lds) {
    const int half = (int)gridDim.x / 2;
    if ((int)blockIdx.x < half) return;
    const int tid = tid_(), lane = tid & 63;
    LAS float* scr = (LAS float*)(lds + (tid >> 6) * 16384);
    CvtCursor cur{0};
    cvt_layer(p, 1, 2, cur, WB, scr, ((int)blockIdx.x - half) * (NTHR / 64) + (tid >> 6), ((int)gridDim.x - half) * (NTHR / 64), lane);
}
__device__ __forceinline__ void ph_convert_moe(const Params& p, bf16_t* MW, LAS unsigned char* lds, int e_lo, int e_hi, bool skip0) {
    const int tid = tid_(), lane = tid & 63;
    if (skip0 && blockIdx.x == 0) return;
    const int gwv = ((int)blockIdx.x - (skip0 ? 1 : 0)) * (NTHR / 64) + (tid >> 6), nwv = ((int)gridDim.x - (skip0 ? 1 : 0)) * (NTHR / 64);
    LAS float* scr = (LAS float*)(lds + (tid >> 6) * 16384);
    CvtCursor cur{0};
    for (int e = e_lo; e < e_hi; ++e) {
        bf16_t* we = MW + (size_t)e * ME_SIZE;
        cvt_matrix<true>(cur, p.in[IN_MWG] + (size_t)e * D * FFE, D, FFE, we + ME_GU, D, FFE, 1, scr, gwv, nwv, lane);
        cvt_matrix<true>(cur, p.in[IN_MWU] + (size_t)e * D * FFE, D, FFE, we + ME_GU, D, FFE, 2, scr, gwv, nwv, lane);
        cvt_matrix<true>(cur, p.in[IN_MWD] + (size_t)e * FFE * D, FFE, D, we + ME_DN, FFE, D, 0, scr, gwv, nwv, lane);
    }
}

constexpr int LDS_BYTES = 147456;
constexpr int LDS_MISC = 131072;
enum { P_PRO = 0, P_PROJ0, L0_BASE, L0_GU = L0_BASE + 8, L0_DN, L1_PROJ, L1_BASE, L1_ROUTE = L1_BASE + 8, L1_SORT, M_BASE, P_FINAL = M_BASE + 2 * MOE_NR, NPHASE };

__global__ void __launch_bounds__(NTHR, 2) fwd_kernel(Params p) {
    extern __shared__ __attribute__((aligned(16))) unsigned char lds_raw[];
    LAS unsigned char* lds = (LAS unsigned char*)lds_raw;
    volatile LAS unsigned* misc = (volatile LAS unsigned*)(lds + LDS_MISC);
    if (threadIdx.x < 64) misc[threadIdx.x] = 0u;
    __syncthreads();
    unsigned char* ws = p.ws;
    unsigned* ctl = (unsigned*)(ws + WS_CTL);
    XcdBarrier bar; bar.bar = ctl + 4096; bar.x = 0; bar.st = nullptr;
    const int lo = p.ph_lo, hi = p.ph_hi;
    if (hi - lo > 1) bar = xcd_barrier_post(ctl + 4096, misc + 8);
#define PH(k) if (lo <= (k) && (k) < hi)
#define ENDPH(k) if ((k) + 1 < hi) xcd_barrier(bar);

    bf16_t* HB = (bf16_t*)(ws + WS_H);
    bf16_t* XNB = (bf16_t*)(ws + WS_XNB);
    bf16_t* CQNB = (bf16_t*)(ws + XB_CQN);
    bf16_t* CKVNB = (bf16_t*)(ws + XB_CKVN);
    bf16_t* YPREB = (bf16_t*)(ws + XB_YPRE);
    bf16_t* YCATB = (bf16_t*)(ws + WS_XNB);
    bf16_t* KVXB = (bf16_t*)(ws + WS_KVX);
    float* PROJ = (float*)(ws + BG_PROJ);
    bf16_t* NKVB = (bf16_t*)(ws + BG_NKVB);
    bf16_t* QMB = (bf16_t*)(ws + BG_QMLA);
    bf16_t* NQB = (bf16_t*)(ws + BG_NQB);
    bf16_t* KVMB = (bf16_t*)(ws + BG_KVMB);
    bf16_t* KRB = (bf16_t*)(ws + BG_KRB);
    float* YCAT = (float*)(ws + BG_YCAT);
    bf16_t* MEMNB = (bf16_t*)(ws + BG_MEMN);
    bf16_t* QXB = (bf16_t*)(ws + BG_QX);
    bf16_t* OXB = (bf16_t*)(ws + BG_OX);
    bf16_t* ACTB = (bf16_t*)(ws + BG_ACT);
    bf16_t* MACTB = (bf16_t*)(ws + MOE_ACT);
    bf16_t* YSB = (bf16_t*)(ws + MOE_YS);
    float* YS2P = (float*)(ws + MOE_YS2P);
    float* IMPP = (float*)(ws + SM_IMPP);
    float* ROPE = (float*)(ws + SM_ROPE);
    f32x2* SSME = (f32x2*)(ws + SM_SSME);
    bf16_t* KCB = (bf16_t*)(ws + SM_KC);
    bf16_t* VCT = (bf16_t*)(ws + SM_KC + 512 * 1024);
    float* PEB = (float*)(ws + SM_HID);
    unsigned* SEL = (unsigned*)(ws + SM_SEL);
    int* TOPI = (int*)(ws + SM_TOPI);
    float* TOPW = (float*)(ws + SM_TOPW);
    int* POS = (int*)(ws + SM_POS);
    int* RSRC = (int*)(ws + SM_RSRC);
    int* TEXP = (int*)(ws + SM_TEXP);
    bf16_t* WB = (bf16_t*)(ws + WS_WBS);
    bf16_t* MW = (bf16_t*)(ws + MOE_W);
#define QCTR(k) (ctl + 8192 + 64 * (k))
#define PG8_RUN_ROT(ROT, EPI_T, GATH, Aptr, Btptr, Kval, ridx, texp_, estr, nM_, nN_, pm0_, ...) do { \
    pg8::Gemm g_{Aptr, Btptr, Kval, ridx, texp_, estr}; pg8::StaticOrder S_; S_.init(nM_, nN_, (int)gridDim.x, (int)((blockIdx.x + gridDim.x - (ROT)) % gridDim.x), pm0_); \
    EPI_T E_{__VA_ARGS__}; pg8::gemm_phase<EPI_T, GATH>(lds, g_, S_, E_); } while (0)
#define PG8_RUN(...) PG8_RUN_ROT(0, __VA_ARGS__)
#define PG8_RUN_SPLITK(EPI_T, Aptr, Btptr, Kslice, ld_, nks_, texp_, estr, nM_, nNr_, pm0_, ...) do { \
    pg8::Gemm g_{Aptr, Btptr, Kslice, nullptr, texp_, estr, ld_, nks_, nNr_}; pg8::StaticOrder S_; S_.init(nM_, (nNr_) * (nks_), (int)gridDim.x, (int)blockIdx.x, pm0_); \
    EPI_T E_{__VA_ARGS__}; pg8::gemm_phase<EPI_T, false>(lds, g_, S_, E_); } while (0)

    float* SSQ = (float*)(ws + SM_KROPE);
    PH(P_PRO) {
        ph_rope_table(ROPE);
        ph_pe_bias(p, PEB);
        ph_rms(p.in[IN_MEM], p.in[IN_MEMN], MEMNB, NB * 256);
        ph_rms(p.in[IN_MEM], p.in[IN_MEMN] + D, MEMNB + (size_t)NB * 256 * D, NB * 256);
        ph_rms(p.in[IN_X], p.in[IN_MIXN], XNB, T);
        ph_convert_small(p, WB, lds);
        ENDPH(P_PRO)
    }
    PH(P_PROJ0) {
        PG8_RUN(pg8::EpiProj, false, XNB, WB + WL_WIN, D, nullptr, nullptr, 0, 64, 7, 0, PROJ, INLD, NKVB, nullptr, NQB);
        PG8_RUN_ROT(192, pg8::EpiBf16, false, MEMNB, WB + WL_XWKV, D, nullptr, nullptr, 0, 8, 8, 0, KVXB, 2048);
        ENDPH(P_PROJ0)
    }
#define LAYER_BODY(l, B0, HIN, XO_EPI, EXTRA_XQ) \
    PH(B0 + 0) { ph_mla_prep(PROJ, p.in[IN_MQN] + (l) * 192, p.in[IN_MKVN] + (l) * 128, ROPE, CQNB, CKVNB, KRB); ph_ssm1(p, l, PROJ, SSME, lds); ph_cmp_mfma(p, l, NKVB, WB + (size_t)(l) * WL_SIZE + WL_CW1, PEB, KCB, VCT, lds); ENDPH(B0 + 0) } \
    PH(B0 + 1) { PG8_RUN(pg8::EpiBf16, false, CQNB, WB + (size_t)(l) * WL_SIZE + WL_WUQ, 256, nullptr, nullptr, 0, 64, 3, 0, QMB, 768); \
                 PG8_RUN_ROT(64, pg8::EpiBf16, false, CKVNB, WB + (size_t)(l) * WL_SIZE + WL_WUKV, 256, nullptr, nullptr, 0, 64, 3, 0, KVMB, 768); \
                 ph_nsa_cmp_mfma(p, PROJ, NQB, KCB, VCT, IMPP, YCAT, lds); ph_ssm2(p, l, PROJ, SSME, YPREB, lds); ENDPH(B0 + 1) } \
    PH(B0 + 2) { PG8_RUN(pg8::EpiGlu, false, YPREB, WB + (size_t)(l) * WL_SIZE + WL_WGLU, 256, nullptr, nullptr, 0, 64, 1, 0, YCAT, D, YPREB); KVX1_HERE \
                 fa::ph_attn_merged(lds, QCTR(3 * (l)), QMB, KVMB, KRB, ROPE, PROJ, NQB, NKVB, IMPP, p.in[IN_RELB], YCAT); ENDPH(B0 + 2) } \
    PH(B0 + 3) { ph_group_norm(YCAT, p.in[IN_OUTN] + (l) * D, YCATB); ENDPH(B0 + 3) } \
    PH(B0 + 4) { PG8_RUN(pg8::EpiResNorm, false, YCATB, WB + (size_t)(l) * WL_SIZE + WL_WOUT, D, nullptr, nullptr, 0, 64, 4, 0, HB, HIN, D, SSQ); ENDPH(B0 + 4) } \
    PH(B0 + 5) { PG8_RUN(pg8::EpiBf16, false, HB, WB + (size_t)(l) * WL_SIZE + WL_XWQ, D, nullptr, nullptr, 0, 64, 4, 0, QXB, D, SSQ); EXTRA_XQ ENDPH(B0 + 5) } \
    PH(B0 + 6) { fa::ph_xattn_mfma(lds, QCTR(3 * (l) + 2), QXB, KVXB + (size_t)(l) * 2048 * 2048, OXB); ENDPH(B0 + 6) } \
    PH(B0 + 7) { XO_EPI ENDPH(B0 + 7) }

#define KVX1_HERE PG8_RUN_ROT(64, pg8::EpiBf16, false, MEMNB + (size_t)NB * 256 * D, WB + WL_SIZE + WL_XWKV, D, nullptr, nullptr, 0, 8, 8, 0, KVXB + (size_t)2048 * 2048, 2048);
    LAYER_BODY(0, L0_BASE, p.in[IN_X], PG8_RUN(pg8::EpiResNorm, false, OXB, WB + WL_XWO, D, nullptr, nullptr, 0, 64, 4, 0, HB, nullptr, D, SSQ);, )
    PH(L0_GU) { PG8_RUN(pg8::EpiSwiglu, false, HB, WB + WD_GU, D, nullptr, nullptr, 0, 64, 22, 0, ACTB, FFD, 0, SSQ); ph_convert_l1(p, WB, lds); ENDPH(L0_GU) }
    PH(L0_DN) { PG8_RUN(pg8::EpiResNorm, false, ACTB, WB + WD_DN, FFD, nullptr, nullptr, 0, 64, 4, 0, HB, nullptr, D, SSQ); ENDPH(L0_DN) }
    PH(L1_PROJ) { PG8_RUN(pg8::EpiProj, false, HB, WB + WL_SIZE + WL_WIN, D, nullptr, nullptr, 0, 64, 7, 0, PROJ, INLD, NKVB, SSQ, NQB); ENDPH(L1_PROJ) }
#undef KVX1_HERE
#define KVX1_HERE
    LAYER_BODY(1, L1_BASE, nullptr, PG8_RUN(pg8::EpiResNorm, false, OXB, WB + WL_SIZE + WL_XWO, D, nullptr, nullptr, 0, 64, 4, 0, HB, nullptr, D, nullptr);, ph_convert_moe(p, MW, lds, 0, 6, false);)
    PH(L1_ROUTE) { ph_moe_route(HB, p.in[IN_FFN] + D, p.in[IN_ROUTER], XNB, TOPI, TOPW); ENDPH(L1_ROUTE) }
    PH(L1_SORT) { ph_moe_sort((LAS int*)lds, TOPI, POS, RSRC, TEXP); ph_convert_moe(p, MW, lds, 6, NE, true); ENDPH(L1_SORT) }
#define MOE_ROUND(r) \
    PH(M_BASE + 2 * (r)) { const int ntl_ = TEXP[160] - (r) * MOE_RT; const int nm_ = ntl_ < 0 ? 0 : (ntl_ > MOE_RT ? MOE_RT : ntl_); \
        PG8_RUN(pg8::EpiSwiglu, true, XNB, MW + ME_GU, D, RSRC, TEXP, ME_SIZE, nm_, 28, (r) * MOE_RT, MACTB, FFE, (r) * MOE_RT * 256, nullptr); ENDPH(M_BASE + 2 * (r)) } \
    PH(M_BASE + 1 + 2 * (r)) { const int ntl_ = TEXP[160] - (r) * MOE_RT; const int nm_ = ntl_ < 0 ? 0 : (ntl_ > MOE_RT ? MOE_RT : ntl_); \
        PG8_RUN(pg8::EpiBf16, false, MACTB - (size_t)(r) * MOE_RT * 256 * FFE, MW + ME_DN, FFE, nullptr, TEXP, ME_SIZE, nm_, 4, (r) * MOE_RT, YSB, D); ENDPH(M_BASE + 1 + 2 * (r)) }
    MOE_ROUND(0) MOE_ROUND(1)
    PH(M_BASE + 4) { const int ntl_ = TEXP[160] - 2 * MOE_RT; const int nm_ = ntl_ < 0 ? 0 : (ntl_ > MOE_RT ? MOE_RT : ntl_);
        PG8_RUN(pg8::EpiSwiglu, true, XNB, MW + ME_GU, D, RSRC, TEXP, ME_SIZE, nm_, 28, 2 * MOE_RT, MACTB, FFE, 2 * MOE_RT * 256, nullptr); ENDPH(M_BASE + 4) }
    PH(M_BASE + 5) { const int ntl_ = TEXP[160] - 2 * MOE_RT; const int nm_ = ntl_ < 0 ? 0 : (ntl_ > MOE_RT ? MOE_RT : ntl_);
        PG8_RUN_SPLITK(pg8::EpiF32Slab, MACTB - (size_t)2 * MOE_RT * 256 * FFE, MW + ME_DN, FFE / 4, FFE, 4, TEXP, ME_SIZE, nm_, 4, 2 * MOE_RT, YS2P, D, (size_t)2048 * D, 2 * MOE_RT * 256); ENDPH(M_BASE + 5) }
    PH(P_FINAL) { ph_moe_combine_final(HB, YSB, YS2P, POS, TOPW, p.in[IN_FINAL], p.out); }
}

extern "C" void kernel_launch(void* const* d_in, const int* in_sizes, int n_in, void* d_out, int out_size, void* d_ws, size_t ws_size, hipStream_t stream) {
    static int grid = 0;
    if (grid == 0) {
        if (n_in != 37 || out_size != T * D || ws_size < WS_END) { fprintf(stderr, "kernel_launch: unexpected shapes: n_in %d out %d ws %zu (need %zu)\n", n_in, out_size, ws_size, (size_t)WS_END); grid = -1; return; }
        int dev = 0, cus = 0;
        if (hipGetDevice(&dev) != hipSuccess || hipDeviceGetAttribute(&cus, hipDeviceAttributeMultiprocessorCount, dev) != hipSuccess) { grid = -1; return; }
        if (hipFuncSetAttribute((const void*)fwd_kernel, hipFuncAttributeMaxDynamicSharedMemorySize, LDS_BYTES) != hipSuccess) { fprintf(stderr, "kernel_launch: hipFuncSetAttribute failed\n"); grid = -1; return; }
        int per_cu = 0;
        if (hipOccupancyMaxActiveBlocksPerMultiprocessor(&per_cu, (const void*)fwd_kernel, NTHR, LDS_BYTES) != hipSuccess || per_cu < 1) fprintf(stderr, "kernel_launch: occupancy query says %d\n", per_cu);
        (void)hipGetLastError();
        grid = cus;
    }
    if (grid < 0) return;
    (void)hipMemsetAsync((char*)d_ws + WS_CTL, 0, CTL_BYTES, stream);
    Params p{};
    for (int i = 0; i < 37; ++i) p.in[i] = (const float*)d_in[i];
    p.out = (float*)d_out; p.ws = (unsigned char*)d_ws;
#if MK_ONE_LAUNCH
    p.ph_lo = 0; p.ph_hi = NPHASE;
    hipLaunchKernelGGL(fwd_kernel, dim3(grid), dim3(NTHR), LDS_BYTES, stream, p);
#else
    for (int k = 0; k < NPHASE; ++k) { p.ph_lo = k; p.ph_hi = k + 1; hipLaunchKernelGGL(fwd_kernel, dim3(grid), dim3(NTHR), LDS_BYTES, stream, p); }
#endif
}
```

```cpp
#include <hip/hip_runtime.h>
#include <cstdio>
#include <cstdint>

#ifndef MK_ONE_LAUNCH
#define MK_ONE_LAUNCH 1
#endif

#define LAS __attribute__((address_space(3)))
typedef float f32x4 __attribute__((ext_vector_type(4)));
typedef float f32x2 __attribute__((ext_vector_type(2)));
typedef unsigned short bf16_t;
typedef unsigned u32x2 __attribute__((ext_vector_type(2)));
typedef unsigned u32x4 __attribute__((ext_vector_type(4)));
typedef __bf16 bf16v2_t __attribute__((ext_vector_type(2)));
__device__ __forceinline__ unsigned pk_bf16(float lo, float hi) { const f32x2 v = {lo, hi}; return __builtin_bit_cast(unsigned, __builtin_convertvector(v, bf16v2_t)); }
__device__ __forceinline__ bf16_t f2bf(float f) { return (bf16_t)(pk_bf16(f, 0.f) & 0xffffu); }
__device__ __forceinline__ float bf2f(bf16_t b) { return __uint_as_float(((unsigned)b) << 16); }
__device__ __forceinline__ float bflo(unsigned u) { return __uint_as_float(u << 16); }
__device__ __forceinline__ float bfhi(unsigned u) { return __uint_as_float(u & 0xffff0000u); }
typedef short bf16x8_t __attribute__((ext_vector_type(8)));
typedef __bf16 bfv8_t __attribute__((ext_vector_type(8)));
typedef float f32x8_t __attribute__((ext_vector_type(8)));
__device__ __forceinline__ bf16x8_t pack8f(float a0, float a1, float a2, float a3, float a4, float a5, float a6, float a7) {
    const f32x8_t v = {a0, a1, a2, a3, a4, a5, a6, a7};
    return __builtin_bit_cast(bf16x8_t, __builtin_convertvector(v, bfv8_t));
}
__device__ __forceinline__ float xhalf_max(float x) { const auto r = __builtin_amdgcn_permlane32_swap(__float_as_uint(x), __float_as_uint(x), false, false); return fmaxf(__uint_as_float(r[0]), __uint_as_float(r[1])); }
__device__ __forceinline__ float xhalf_sum(float x) { const auto r = __builtin_amdgcn_permlane32_swap(__float_as_uint(x), __float_as_uint(x), false, false); return __uint_as_float(r[0]) + __uint_as_float(r[1]); }
__device__ __forceinline__ int tid_() { int t = threadIdx.x; asm volatile("" : "+v"(t)); return t; }

constexpr int NB = 8, SEQ = 2048, T = NB * SEQ, D = 1024;
constexpr int INC = 1778, INLD = 1792;
constexpr int O_U = 0, O_CQ = 256, O_CKV = 448, O_KR = 576, O_NQ = 608, O_NKV = 992, O_NG = 1760;
constexpr int NBC = 127;
constexpr int FFD = 2816, FFE = 3584, NE = 8;
constexpr int MOE_ROWS = 2 * T + NE * 256;
constexpr int MOE_TILES = MOE_ROWS / 256;
constexpr int MOE_NR = 3, MOE_RT = 64;
constexpr float EPS = 1e-6f;
constexpr int NTHR = 512;

constexpr size_t MiB = 1u << 20;
constexpr size_t WS_CTL = 0, CTL_BYTES = 1 * MiB;
constexpr size_t WS_SMALL = 1 * MiB;
constexpr size_t SM_ROPE = WS_SMALL;
constexpr size_t SM_SSME = SM_ROPE + 256 * 1024;
constexpr size_t SM_KC = SM_SSME + 2 * MiB;
constexpr size_t SM_HID = SM_KC + 2 * MiB;
constexpr size_t SM_SEL = SM_HID + 2 * MiB;
constexpr size_t SM_TOPI = SM_SEL + 256 * 1024;
constexpr size_t SM_TOPW = SM_TOPI + 256 * 1024;
constexpr size_t SM_POS = SM_TOPW + 256 * 1024;
constexpr size_t SM_RSRC = SM_POS + 256 * 1024;
constexpr size_t SM_TEXP = SM_RSRC + 256 * 1024;
constexpr size_t SM_KROPE = SM_TEXP + 256 * 1024;
constexpr size_t SM_IMPP = SM_KROPE + 2 * MiB;
static_assert(SM_IMPP + 12 * MiB <= 25 * MiB, "small region");
constexpr size_t WS_H = 25 * MiB;
constexpr size_t WS_XNB = 89 * MiB;
constexpr size_t XB_CQN = WS_XNB, XB_CKVN = WS_XNB + 8 * MiB, XB_YPRE = WS_XNB + 16 * MiB;
constexpr size_t WS_WBS = 121 * MiB;
constexpr size_t WS_KVX = 169 * MiB;
constexpr size_t WS_R = 201 * MiB;
constexpr size_t BG_PROJ = WS_R, BG_NKVB = WS_R + 112 * MiB, BG_QMLA = WS_R + 136 * MiB, BG_NQB = WS_R + 160 * MiB, BG_KVMB = WS_R + 184 * MiB, BG_YCAT = WS_R + 208 * MiB, BG_KRB = WS_R + 272 * MiB;
constexpr size_t BG_MEMN = WS_R + 275 * MiB;
constexpr size_t BG_QX = WS_R, BG_OX = WS_R + 64 * MiB;
constexpr size_t BG_ACT = WS_R;
constexpr size_t MOE_ACT = 121 * MiB;
constexpr size_t MOE_YS = 233 * MiB;
constexpr size_t MOE_YS2P = 297 * MiB;
constexpr size_t MOE_W = 331 * MiB;
constexpr size_t WS_END = 499 * MiB;

constexpr size_t WL_WIN = 0, WL_WUQ = WL_WIN + (size_t)1792 * 1024, WL_WUKV = WL_WUQ + 768 * 256, WL_WGLU = WL_WUKV + 768 * 256, WL_WOUT = WL_WGLU + 256 * 256,
                 WL_XWQ = WL_WOUT + 1024 * 1024, WL_XWKV = WL_XWQ + 1024 * 1024, WL_XWO = WL_XWKV + 2048 * 1024, WL_CW1 = WL_XWO + 1024 * 1024, WL_SIZE = WL_CW1 + 2 * 64 * 2048;
constexpr size_t WD_GU = 2 * WL_SIZE, WD_DN = WD_GU + (size_t)5632 * 1024, W_SMALL_END = WD_DN + (size_t)1024 * 2816;
static_assert(W_SMALL_END * 2 <= 48 * MiB, "small weights fit");
constexpr size_t ME_GU = 0, ME_DN = (size_t)7168 * 1024, ME_SIZE = ME_DN + (size_t)1024 * 3584;
static_assert(MOE_W + ME_SIZE * 8 * 2 <= WS_END, "moe weights fit");
#ifndef USE_PG8
#define USE_PG8 2
#endif

#define XB_TMO      128
#define XB_XCNT(j)  (256  + 64 * (j))
#define XB_XSUB(j)  (1280 + 64 * (j))
#define XB_XGEN(j)  (2304 + 64 * (j))
#define XB_TOP      3328
#define XB_TOPGEN   3392
#define XCD_BAR_WORDS 3456
#define XB_SPIN_CAP (1u << 22)
__device__ __forceinline__ unsigned xb_ld(unsigned* p)              { return __hip_atomic_load(p, __ATOMIC_RELAXED, __HIP_MEMORY_SCOPE_AGENT); }
__device__ __forceinline__ unsigned xb_add(unsigned* p, unsigned v) { return __hip_atomic_fetch_add(p, v, __ATOMIC_RELAXED, __HIP_MEMORY_SCOPE_AGENT); }
__device__ __forceinline__ unsigned xb_xcc_id() { return (unsigned)__builtin_amdgcn_s_getreg((3 << 11) | 20) & 0xFu; }
#define XB_SPIN(cond, bar) do { unsigned _sp = 0; while (cond) { __builtin_amdgcn_s_sleep(1); \
    if ((++_sp & 255u) == 0u) { if (xb_ld(&(bar)[XB_TMO])) break; if (_sp > XB_SPIN_CAP) { atomicAdd(&(bar)[XB_TMO], 1u); break; } } } } while (0)
struct XcdBarrier { unsigned* bar; unsigned x; volatile LAS unsigned* st; };
__device__ __forceinline__ XcdBarrier xcd_barrier_post(unsigned* bar, volatile LAS unsigned* st) {
    XcdBarrier b; b.bar = bar; b.x = xb_xcc_id(); b.st = st;
    if (threadIdx.x == 0) (void)xb_add(&bar[XB_XCNT(b.x)], 1u);
    return b;
}
__device__ __forceinline__ void xcd_barrier_complete(unsigned* bar, unsigned x, unsigned& nloc, unsigned& nx) {
    const unsigned G = gridDim.x * gridDim.y * gridDim.z;
    unsigned sum, cnt, mine, sp = 0u;
    for (;;) {
        sum = 0u; cnt = 0u; mine = 0u;
#pragma unroll
        for (unsigned j = 0; j < 16; ++j) { const unsigned c = xb_ld(&bar[XB_XCNT(j)]); sum += c; cnt += (c > 0u) ? 1u : 0u; mine = (j == x) ? c : mine; }
        if (sum == G) break;
        __builtin_amdgcn_s_sleep(1);
        if ((++sp & 255u) == 0u) { if (xb_ld(&bar[XB_TMO])) break; if (sp > XB_SPIN_CAP) { atomicAdd(&bar[XB_TMO], 1u); break; } }
    }
    nloc = mine > 0u ? mine : 1u; nx = cnt > 0u ? cnt : 1u;
}
__device__ __forceinline__ void xcd_barrier(const XcdBarrier& b) {
    asm volatile("s_waitcnt vmcnt(0)" ::: "memory");
    __syncthreads();
    if (threadIdx.x == 0) {
        unsigned* bar = b.bar;
        __builtin_amdgcn_s_waitcnt(0);
        unsigned nloc = b.st[0], nx = b.st[1];
        if (nloc == 0u) { xcd_barrier_complete(bar, b.x, nloc, nx); b.st[0] = nloc; b.st[1] = nx; }
        const unsigned old = xb_add(&bar[XB_XSUB(b.x)], 1u);
        const unsigned gen = old / nloc;
        if (old + 1u == (gen + 1u) * nloc) {
            __builtin_amdgcn_fence(__ATOMIC_RELEASE, "agent");
            asm volatile("s_waitcnt vmcnt(0)" ::: "memory");
            const unsigned og = xb_add(&bar[XB_TOP], 1u);
            const unsigned tg = og / nx;
            if (og + 1u == (tg + 1u) * nx) xb_add(&bar[XB_TOPGEN], 1u);
            else XB_SPIN(xb_ld(&bar[XB_TOPGEN]) == tg, bar);
            __builtin_amdgcn_fence(__ATOMIC_ACQUIRE, "agent");
            xb_add(&bar[XB_XGEN(b.x)], 1u);
            asm volatile("s_waitcnt vmcnt(0)" ::: "memory");
        } else {
            XB_SPIN(xb_ld(&bar[XB_XGEN(b.x)]) == gen, bar);
            __builtin_amdgcn_fence(__ATOMIC_ACQUIRE, "agent");
            asm volatile("s_waitcnt vmcnt(0)" ::: "memory");
        }
    }
    __syncthreads();
}

template <int CTRL> __device__ __forceinline__ float dpp_mov(float v) { return __uint_as_float(__builtin_amdgcn_update_dpp(0u, __float_as_uint(v), CTRL, 0xf, 0xf, true)); }
__device__ __forceinline__ float wave_sum(float v) {
    v += dpp_mov<0xB1>(v); v += dpp_mov<0x4E>(v); v += dpp_mov<0x124>(v); v += dpp_mov<0x128>(v);
    v += __shfl_xor(v, 16);
    const auto r = __builtin_amdgcn_permlane32_swap(__float_as_uint(v), __float_as_uint(v), false, false);
    return __uint_as_float(r[0]) + __uint_as_float(r[1]);
}
__device__ __forceinline__ float wave_max(float v) {
    v = fmaxf(v, dpp_mov<0xB1>(v)); v = fmaxf(v, dpp_mov<0x4E>(v)); v = fmaxf(v, dpp_mov<0x124>(v)); v = fmaxf(v, dpp_mov<0x128>(v));
    v = fmaxf(v, __shfl_xor(v, 16));
    const auto r = __builtin_amdgcn_permlane32_swap(__float_as_uint(v), __float_as_uint(v), false, false);
    return fmaxf(__uint_as_float(r[0]), __uint_as_float(r[1]));
}
__device__ __forceinline__ float sigmoidf_(float x) { return __builtin_amdgcn_rcpf(1.f + __expf(-x)); }
__device__ __forceinline__ float gelu_tanh(float x) {
    const float u = 0.7978845608028654f * (x + 0.044715f * x * x * x);
    const float th = 1.f - 2.f * __builtin_amdgcn_rcpf(__expf(2.f * u) + 1.f);
    return 0.5f * x * (1.f + th);
}
__device__ __forceinline__ void sincos_d(double ang, float& s, float& c) {
    double rev = ang * 0.15915494309189535;
    rev -= floor(rev);
    const float r = (float)rev;
    s = __builtin_amdgcn_sinf(r); c = __builtin_amdgcn_cosf(r);
}
__device__ __forceinline__ int t5_bucket(int dist) {
    const int n = dist < 0 ? 0 : dist;
    if (n < 16) return n;
    const int lg = 16 + (int)(__logf((float)n * 0.0625f) * (16.0f / 2.0794415416798357f));
    return lg < 31 ? lg : 31;
}

struct Params {
    const float* in[37];
    float* out;
    unsigned char* ws;
    int ph_lo, ph_hi;
};
#define IN_X 0
#define IN_MEM 1
#define IN_WIN 2
#define IN_WOUT 3
#define IN_MIXN 4
#define IN_OUTN 5
#define IN_SARE 6
#define IN_SAIM 7
#define IN_SBRE 8
#define IN_SBIM 9
#define IN_SCRE 10
#define IN_SCIM 11
#define IN_SD 12
#define IN_SLDT 13
#define IN_SGLU 14
#define IN_MQN 15
#define IN_MWUQ 16
#define IN_MKVN 17
#define IN_MWUKV 18
#define IN_NPE 19
#define IN_NW1 20
#define IN_NW2 21
#define IN_RELB 22
#define IN_XN 23
#define IN_MEMN 24
#define IN_XWQ 25
#define IN_XWKV 26
#define IN_XWO 27
#define IN_FFN 28
#define IN_DWG 29
#define IN_DWU 30
#define IN_DWD 31
#define IN_ROUTER 32
#define IN_MWG 33
#define IN_MWU 34
#define IN_MWD 35
#define IN_FINAL 36

#define GT_DECL const int tid = tid_(), lane = tid & 63; const int gt = blockIdx.x * NTHR + tid, NT = gridDim.x * NTHR; const int gw = gt >> 6, NW = NT >> 6; (void)lane; (void)gw; (void)NW; (void)gt; (void)NT;

__device__ __forceinline__ void ph_rms(const float* src, const float* gain, bf16_t* dst, int rows) {
    GT_DECL
    for (int r = gw; r < rows; r += NW) {
        const f32x4* x = (const f32x4*)(src + (size_t)r * D) + lane;
        f32x4 v[4]; float s = 0.f;
#pragma unroll
        for (int j = 0; j < 4; ++j) { v[j] = x[64 * j]; s += v[j].x * v[j].x + v[j].y * v[j].y + v[j].z * v[j].z + v[j].w * v[j].w; }
        const float rstd = rsqrtf(wave_sum(s) * (1.f / D) + EPS);
        u32x2* o = (u32x2*)(dst + (size_t)r * D) + lane; const f32x4* g = (const f32x4*)gain + lane;
#pragma unroll
        for (int j = 0; j < 4; ++j) { const f32x4 gg = g[64 * j]; o[64 * j] = (u32x2){pk_bf16(v[j].x * rstd * gg.x, v[j].y * rstd * gg.y), pk_bf16(v[j].z * rstd * gg.z, v[j].w * rstd * gg.w)}; }
    }
}

template <int MODE, bool CBF>
__device__ __forceinline__ void gemm_naive(LAS float* lds, const bf16_t* A, int lda, const int* rowidx,
                                           const float* B, const float* B2, int ldb, size_t bstride, const int* tile_exp,
                                           void* Cv, int ldc, const void* Rv, int ldr, int N, int K, int tm_lo, int tm_hi, int crow_off) {
    const int tid = tid_();
    LAS float* As = lds;
    LAS float* Bs = lds + 16 * 132;
    LAS float* B2s = Bs + 16 * 64;
    const int ntn = (N + 63) / 64, ntiles = (tm_hi - tm_lo) * ntn;
    const int ty = tid >> 4, tx = tid & 15;
    for (int tile = blockIdx.x; tile < ntiles; tile += gridDim.x) {
        const int tm = tm_lo + tile / ntn, tn = tile % ntn;
        const int row0 = tm * 128, n0 = tn * 64;
        const float* Bp = B; const float* B2p = B2;
        if (tile_exp) { const int e = tile_exp[row0 >> 8]; if (e < 0) continue; Bp = B + (size_t)e * bstride; if (MODE == 2) B2p = B2 + (size_t)e * bstride; }
        float acc[4][4], acc2[4][4];
#pragma unroll
        for (int i = 0; i < 4; ++i)
#pragma unroll
            for (int j = 0; j < 4; ++j) { acc[i][j] = 0.f; acc2[i][j] = 0.f; }
        const int ar = tid >> 2, ak = (tid & 3) * 4;
        const int arow = rowidx ? rowidx[row0 + ar] : (row0 + ar);
        const bf16_t* Ap = A + (size_t)arow * lda + ak;
        for (int k0 = 0; k0 < K; k0 += 16) {
            const u32x2 av = *(const u32x2*)(Ap + k0);
            As[(ak + 0) * 132 + ar] = bflo(av.x); As[(ak + 1) * 132 + ar] = bfhi(av.x); As[(ak + 2) * 132 + ar] = bflo(av.y); As[(ak + 3) * 132 + ar] = bfhi(av.y);
#pragma unroll
            for (int i = 0; i < 2; ++i) {
                const int e = tid + i * 512, kk = e >> 6, nn = e & 63, col = n0 + nn;
                Bs[kk * 64 + nn] = col < N ? Bp[(size_t)(k0 + kk) * ldb + col] : 0.f;
                if (MODE == 2) B2s[kk * 64 + nn] = col < N ? B2p[(size_t)(k0 + kk) * ldb + col] : 0.f;
            }
            __syncthreads();
#pragma unroll
            for (int kk = 0; kk < 16; ++kk) {
                const f32x4 a = *(const LAS f32x4*)(As + kk * 132 + ty * 4);
                const f32x4 b = *(const LAS f32x4*)(Bs + kk * 64 + tx * 4);
                const float aa[4] = {a.x, a.y, a.z, a.w}, bb[4] = {b.x, b.y, b.z, b.w};
#pragma unroll
                for (int i = 0; i < 4; ++i)
#pragma unroll
                    for (int j = 0; j < 4; ++j) acc[i][j] += aa[i] * bb[j];
                if (MODE == 2) {
                    const f32x4 b2 = *(const LAS f32x4*)(B2s + kk * 64 + tx * 4);
                    const float bb2[4] = {b2.x, b2.y, b2.z, b2.w};
#pragma unroll
                    for (int i = 0; i < 4; ++i)
#pragma unroll
                        for (int j = 0; j < 4; ++j) acc2[i][j] += aa[i] * bb2[j];
                }
            }
            __syncthreads();
        }
#pragma unroll
        for (int i = 0; i < 4; ++i) {
            const int row = row0 + ty * 4 + i;
#pragma unroll
            for (int j = 0; j < 4; ++j) {
                const int col = n0 + tx * 4 + j;
                if (col < N) {
                    float v = acc[i][j];
                    if (MODE == 1) v += ((const float*)Rv)[(size_t)row * ldr + col];
                    if (MODE == 2) v = v * sigmoidf_(v) * acc2[i][j];
                    if (MODE == 3) v = bf2f(((const bf16_t*)Rv)[(size_t)row * ldr + col]) * sigmoidf_(v);
                    if (CBF) ((bf16_t*)Cv)[(size_t)(row - crow_off) * ldc + col] = f2bf(v);
                    else ((float*)Cv)[(size_t)(row - crow_off) * ldc + col] = v;
                }
            }
        }
    }
}

namespace pg8 {
#define PG8_LAS __attribute__((address_space(3)))
typedef short bf16x8 __attribute__((ext_vector_type(8)));
constexpr int BM = 256, BK = 64, HALF = 128, HTB = HALF * BK * 2, STAGE_BYTES = 8 * HTB, NXCD = 8, WGM = 8;
__host__ __device__ __forceinline__ int lds_byte(int r, int c) { const int st = (r >> 4) * 2 + (c >> 5), rr = r & 15, cc = c & 31, ob = rr * 64 + cc * 2; return st * 1024 + (ob ^ (((ob >> 9) & 1) << 5)); }
__host__ __device__ __forceinline__ void stage_rc(int b, int& R, int& C) { const int st = b / 1024, sb = b % 1024, swz = sb ^ (((sb >> 9) & 1) << 5); R = (st >> 1) * 16 + swz / 64; C = (st & 1) * 32 + (swz % 64) / 2; }
__host__ __device__ __forceinline__ int perm32(int rho) { const int n = rho >> 4, i = rho & 15; return 8 * (i >> 2) + 4 * n + (i & 3); }

struct Unit { int pm, pn, ks; };
struct Gemm { const bf16_t* A; const bf16_t* Bt; int K; const int* rowidx; const int* texp; size_t estride; int ld; int nks; int nNr; };

struct StaticOrder {
    int nM, nN, nwg, G, c, pm0;
    __device__ void init(int nM_, int nN_, int G_, int c_, int pm0_) { nM = nM_; nN = nN_; nwg = nM * nN; G = G_; c = c_; pm0 = pm0_; }
    __device__ bool next(int i, Unit& u) const {
        const long L = (long)i * G + c; if (L >= nwg) return false;
        int wgid = (int)L; { const int q = nwg / NXCD, r = nwg % NXCD, xcd = wgid % NXCD, off = wgid / NXCD; wgid = (xcd < r ? xcd * (q + 1) : r * (q + 1) + (xcd - r) * q) + off; }
        const int nig = WGM * nN, gid = wgid / nig, fm = gid * WGM, gsz = (nM - fm) < WGM ? (nM - fm) : WGM;
        u.pm = pm0 + fm + ((wgid % nig) % gsz); u.pn = (wgid % nig) / gsz; return true;
    }
};

__device__ __forceinline__ float row_rstd(const float* ssq, int row) {
    const f32x4* q = (const f32x4*)(ssq + (size_t)row * 16); const f32x4 a = q[0], b = q[1], c = q[2], d = q[3];
    const float s = ((a.x + a.y) + (a.z + a.w)) + ((b.x + b.y) + (b.z + b.w)) + ((c.x + c.y) + (c.z + c.w)) + ((d.x + d.y) + (d.z + d.w));
    return rsqrtf(s * (1.f / 1024.f) + EPS);
}
struct EpiF32 {
    static constexpr bool PERM = false;
    float* C; int ldc; const float* ssq;
    __device__ __forceinline__ void operator()(const f32x4 (&acc)[2][2][4][2], const Unit& u, int wr, int wc, int fr, int fq) const {
        const int row0 = u.pm * BM + wr * 64 + fr, col0 = u.pn * BM + wc * 32 + 4 * fq;
#pragma unroll
        for (int ai = 0; ai < 2; ++ai)
#pragma unroll
            for (int m = 0; m < 4; ++m) { const int row = row0 + ai * HALF + m * 16; float* rowp = C + (size_t)row * ldc + col0;
                const float rs = ssq ? row_rstd(ssq, row) : 1.f;
#pragma unroll
                for (int bj = 0; bj < 2; ++bj)
#pragma unroll
                    for (int n = 0; n < 2; ++n) *(f32x4*)(rowp + bj * HALF + n * 16) = acc[ai][bj][m][n] * rs; }
    }
};
struct EpiF32Slab {
    static constexpr bool PERM = false;
    float* C; int ldc; size_t slab; int rsub;
    __device__ __forceinline__ void operator()(const f32x4 (&acc)[2][2][4][2], const Unit& u, int wr, int wc, int fr, int fq) const {
        const int row0 = u.pm * BM - rsub + wr * 64 + fr, col0 = u.pn * BM + wc * 32 + 4 * fq;
        float* Cs = C + (size_t)u.ks * slab;
#pragma unroll
        for (int ai = 0; ai < 2; ++ai)
#pragma unroll
            for (int m = 0; m < 4; ++m) { float* rowp = Cs + (size_t)(row0 + ai * HALF + m * 16) * ldc + col0;
#pragma unroll
                for (int bj = 0; bj < 2; ++bj)
#pragma unroll
                    for (int n = 0; n < 2; ++n) *(f32x4*)(rowp + bj * HALF + n * 16) = acc[ai][bj][m][n]; }
    }
};
struct EpiProj {
    static constexpr bool PERM = true;
    float* C; int ldc; bf16_t* NK; const float* ssq; bf16_t* NQ;
    __device__ __forceinline__ void operator()(const f32x4 (&acc)[2][2][4][2], const Unit& u, int wr, int wc, int fr, int fq) const {
        const int row0 = u.pm * BM + wr * 64 + fr, col0 = u.pn * BM + wc * 32 + 8 * fq;
#pragma unroll
        for (int ai = 0; ai < 2; ++ai)
#pragma unroll
            for (int m = 0; m < 4; ++m) { const int row = row0 + ai * HALF + m * 16;
                const float rs = ssq ? row_rstd(ssq, row) : 1.f;
#pragma unroll
                for (int bj = 0; bj < 2; ++bj) { const f32x4 v0 = acc[ai][bj][m][0] * rs, v1 = acc[ai][bj][m][1] * rs; const int col = col0 + bj * HALF;
                    if (col >= 608 && col < 1760) {
                        const u32x4 w = {pk_bf16(v0[0], v0[1]), pk_bf16(v0[2], v0[3]), pk_bf16(v1[0], v1[1]), pk_bf16(v1[2], v1[3])};
                        if (col >= 992) *(u32x4*)(NK + (size_t)row * 768 + (col - 992)) = w; else *(u32x4*)(NQ + (size_t)row * 384 + (col - 608)) = w;
                    } else { float* cp = C + (size_t)row * ldc + col; *(f32x4*)cp = v0; *(f32x4*)(cp + 4) = v1; } } }
    }
};
struct EpiResF32 {
    static constexpr bool PERM = false;
    float* C; const float* R; int ld;
    __device__ __forceinline__ void operator()(const f32x4 (&acc)[2][2][4][2], const Unit& u, int wr, int wc, int fr, int fq) const {
        const int row0 = u.pm * BM + wr * 64 + fr, col0 = u.pn * BM + wc * 32 + 4 * fq;
#pragma unroll
        for (int ai = 0; ai < 2; ++ai)
#pragma unroll
            for (int m = 0; m < 4; ++m) { const size_t ro = (size_t)(row0 + ai * HALF + m * 16) * ld + col0;
                f32x4 rv[2][2];
#pragma unroll
                for (int bj = 0; bj < 2; ++bj)
#pragma unroll
                    for (int n = 0; n < 2; ++n) rv[bj][n] = *(const f32x4*)(R + ro + bj * HALF + n * 16);
#pragma unroll
                for (int bj = 0; bj < 2; ++bj)
#pragma unroll
                    for (int n = 0; n < 2; ++n) *(f32x4*)(C + ro + bj * HALF + n * 16) = rv[bj][n] + acc[ai][bj][m][n]; }
    }
};
struct EpiResNorm {
    static constexpr bool PERM = true;
    bf16_t* HB; const float* Rf; int ld; float* ssq;
    __device__ __forceinline__ void operator()(const f32x4 (&acc)[2][2][4][2], const Unit& u, int wr, int wc, int fr, int fq) const {
        const int row0 = u.pm * BM + wr * 64 + fr, col0 = u.pn * BM + wc * 32 + 8 * fq;
#pragma unroll
        for (int ai = 0; ai < 2; ++ai)
#pragma unroll
            for (int m = 0; m < 4; ++m) { const int row = row0 + ai * HALF + m * 16; const size_t ro = (size_t)row * ld + col0;
                f32x4 r0[2], r1[2];
#pragma unroll
                for (int bj = 0; bj < 2; ++bj) {
                    if (Rf) { r0[bj] = *(const f32x4*)(Rf + ro + bj * HALF); r1[bj] = *(const f32x4*)(Rf + ro + bj * HALF + 4); }
                    else { const u32x4 hb = *(const u32x4*)(HB + ro + bj * HALF);
                        r0[bj] = (f32x4){bflo(hb.x), bfhi(hb.x), bflo(hb.y), bfhi(hb.y)}; r1[bj] = (f32x4){bflo(hb.z), bfhi(hb.z), bflo(hb.w), bfhi(hb.w)}; } }
                float sq = 0.f;
#pragma unroll
                for (int bj = 0; bj < 2; ++bj) { const f32x4 v0 = r0[bj] + acc[ai][bj][m][0], v1 = r1[bj] + acc[ai][bj][m][1];
                    *(u32x4*)(HB + ro + bj * HALF) = (u32x4){pk_bf16(v0[0], v0[1]), pk_bf16(v0[2], v0[3]), pk_bf16(v1[0], v1[1]), pk_bf16(v1[2], v1[3])};
                    sq += ((v0[0] * v0[0] + v0[1] * v0[1]) + (v0[2] * v0[2] + v0[3] * v0[3])) + ((v1[0] * v1[0] + v1[1] * v1[1]) + (v1[2] * v1[2] + v1[3] * v1[3])); }
                if (ssq) { sq += __shfl_xor(sq, 16); sq += __shfl_xor(sq, 32);
                    if (fq == 0) ssq[(size_t)row * 16 + u.pn * 4 + wc] = sq; } }
    }
};
struct EpiGlu {
    static constexpr bool PERM = false;
    float* Y; int ldy; const bf16_t* R;
    __device__ __forceinline__ void operator()(const f32x4 (&acc)[2][2][4][2], const Unit& u, int wr, int wc, int fr, int fq) const {
        const int row0 = u.pm * BM + wr * 64 + fr, col0 = u.pn * BM + wc * 32 + 4 * fq;
#pragma unroll
        for (int ai = 0; ai < 2; ++ai)
#pragma unroll
            for (int m = 0; m < 4; ++m) { const int row = row0 + ai * HALF + m * 16;
#pragma unroll
                for (int bj = 0; bj < 2; ++bj)
#pragma unroll
                    for (int n = 0; n < 2; ++n) { const int col = col0 + bj * HALF + n * 16;
                        const u32x2 r2 = *(const u32x2*)(R + (size_t)row * 256 + col); const f32x4 a = acc[ai][bj][m][n];
                        *(f32x4*)(Y + (size_t)row * ldy + col) = (f32x4){bflo(r2.x) * sigmoidf_(a[0]), bfhi(r2.x) * sigmoidf_(a[1]), bflo(r2.y) * sigmoidf_(a[2]), bfhi(r2.y) * sigmoidf_(a[3])}; } }
    }
};
struct EpiSwiglu {
    static constexpr bool PERM = true;
    bf16_t* O; int ldo; int rsub; const float* ssq;
    __device__ __forceinline__ void operator()(const f32x4 (&acc)[2][2][4][2], const Unit& u, int wr, int wc, int fr, int fq) const {
        const int row0 = u.pm * BM - rsub + wr * 64 + fr, col0 = u.pn * HALF + wc * 32 + 8 * fq;
#pragma unroll
        for (int ai = 0; ai < 2; ++ai)
#pragma unroll
            for (int m = 0; m < 4; ++m) { bf16_t* rowp = O + (size_t)(row0 + ai * HALF + m * 16) * ldo + col0;
                const float rs = ssq ? row_rstd(ssq, u.pm * BM + wr * 64 + fr + ai * HALF + m * 16) : 1.f;
                const f32x4 g0 = acc[ai][0][m][0] * rs, g1 = acc[ai][0][m][1] * rs, u0 = acc[ai][1][m][0] * rs, u1 = acc[ai][1][m][1] * rs;
                u32x4 w;
                w.x = pk_bf16(g0[0] * sigmoidf_(g0[0]) * u0[0], g0[1] * sigmoidf_(g0[1]) * u0[1]); w.y = pk_bf16(g0[2] * sigmoidf_(g0[2]) * u0[2], g0[3] * sigmoidf_(g0[3]) * u0[3]);
                w.z = pk_bf16(g1[0] * sigmoidf_(g1[0]) * u1[0], g1[1] * sigmoidf_(g1[1]) * u1[1]); w.w = pk_bf16(g1[2] * sigmoidf_(g1[2]) * u1[2], g1[3] * sigmoidf_(g1[3]) * u1[3]);
                *(u32x4*)rowp = w; }
    }
};
struct EpiBf16 {
    static constexpr bool PERM = true;
    bf16_t* O; int ldo; const float* ssq;
    __device__ __forceinline__ void operator()(const f32x4 (&acc)[2][2][4][2], const Unit& u, int wr, int wc, int fr, int fq) const {
        const int row0 = u.pm * BM + wr * 64 + fr, col0 = u.pn * BM + wc * 32 + 8 * fq;
#pragma unroll
        for (int ai = 0; ai < 2; ++ai)
#pragma unroll
            for (int m = 0; m < 4; ++m) { const int row = row0 + ai * HALF + m * 16; bf16_t* rowp = O + (size_t)row * ldo + col0;
                const float rs = ssq ? row_rstd(ssq, row) : 1.f;
#pragma unroll
                for (int bj = 0; bj < 2; ++bj) { const f32x4 v0 = acc[ai][bj][m][0] * rs, v1 = acc[ai][bj][m][1] * rs;
                    u32x4 w; w.x = pk_bf16(v0[0], v0[1]); w.y = pk_bf16(v0[2], v0[3]); w.z = pk_bf16(v1[0], v1[1]); w.w = pk_bf16(v1[2], v1[3]);
                    *(u32x4*)(rowp + bj * HALF) = w; } }
    }
};

template <class Epi, bool GATHER>
__device__ __forceinline__ void gemm_phase(PG8_LAS unsigned char* lds, const Gemm g, const StaticOrder& S, const Epi& E) {
    const int tid = tid_(), wid = __builtin_amdgcn_readfirstlane(tid >> 6), lane = tid & 63, wr = wid >> 2, wc = wid & 3, fr = lane & 15, fq = lane >> 4;
    const int K = g.ld ? g.ld : g.K, nt = g.K / BK;
    unsigned voffA[2], voffB[2]; int sR[2], sC[2];
#pragma unroll
    for (int i = 0; i < 2; ++i) { int R, C; stage_rc(tid * 16 + i * 8192, R, C); const int Rb = Epi::PERM ? ((R & ~31) + perm32(R & 31)) : R; sR[i] = R; sC[i] = C;
        voffA[i] = (unsigned)(R * K + C) * 2u; voffB[i] = (unsigned)(Rb * K + C) * 2u; }
    const size_t kstep = (size_t)(BK * 2);
    const size_t hstep = (size_t)HALF * K * 2;
    const size_t sstep = (size_t)g.K * 2;
    const size_t tstep = 2 * hstep;
    const unsigned ldsw = (unsigned)wid * 1024u;
    const int aoff = lds_byte(wr * 64 + fr, fq * 8), boff = lds_byte(wc * 32 + fr, fq * 8);
#define PG8_SA(b, h) (((b) * 2 + (h)) * HTB)
#define PG8_SB(b, h) ((4 + (b) * 2 + (h)) * HTB)
#define PG8_STAGE(bufoff, gbase, voff) do { _Pragma("unroll") for (int _i = 0; _i < 2; ++_i) \
        __builtin_amdgcn_global_load_lds((const unsigned*)((const char*)(gbase) + (voff)[_i]), (PG8_LAS unsigned*)(lds + (bufoff) + ldsw + _i * 8192), 16, 0, 0); } while (0)
#define PG8_LDA(dst, b, h) do { _Pragma("unroll") for (int m = 0; m < 4; ++m) _Pragma("unroll") for (int k = 0; k < 2; ++k) dst[m][k] = *(const PG8_LAS bf16x8*)(lds + PG8_SA(b, h) + aoff + m * 2048 + k * 1024); } while (0)
#define PG8_LDB(dst, b, h) do { _Pragma("unroll") for (int n = 0; n < 2; ++n) _Pragma("unroll") for (int k = 0; k < 2; ++k) dst[n][k] = *(const PG8_LAS bf16x8*)(lds + PG8_SB(b, h) + boff + n * 2048 + k * 1024); } while (0)
#define PG8_MMA(ai, bj, At, Bt) do { __builtin_amdgcn_s_setprio(1); _Pragma("unroll") for (int m = 0; m < 4; ++m) _Pragma("unroll") for (int n = 0; n < 2; ++n) _Pragma("unroll") for (int k = 0; k < 2; ++k) \
        acc[ai][bj][m][n] = __builtin_amdgcn_mfma_f32_16x16x32_bf16(Bt[n][k], At[m][k], acc[ai][bj][m][n], 0, 0, 0); __builtin_amdgcn_s_setprio(0); } while (0)
#define PG8_WAIT_V(n) asm volatile("s_waitcnt vmcnt(" #n ")" ::: "memory")
#define PG8_WAIT_L(n) asm volatile("s_waitcnt lgkmcnt(" #n ")" ::: "memory")
#define PG8_BAR __builtin_amdgcn_s_barrier()
#define PG8_SCHED __builtin_amdgcn_sched_barrier(0)
#define PG8_GOFF(v, u) do { _Pragma("unroll") for (int _h = 0; _h < 2; ++_h) _Pragma("unroll") for (int _i = 0; _i < 2; ++_i) \
        v[_h][_i] = (unsigned)(g.rowidx[(u).pm * BM + _h * HALF + sR[_i]] * K + sC[_i]) * 2u; } while (0)
    Unit cur, nxt; int ui = 0;
    if (!S.next(0, cur)) return;
    cur.ks = 0; if (g.nks > 1) { cur.ks = cur.pn / g.nNr; cur.pn -= cur.ks * g.nNr; }
    f32x4 acc[2][2][4][2];
#pragma unroll
    for (int a = 0; a < 2; ++a)
#pragma unroll
        for (int b = 0; b < 2; ++b)
#pragma unroll
            for (int m = 0; m < 4; ++m)
#pragma unroll
                for (int n = 0; n < 2; ++n) acc[a][b][m][n] = (f32x4){0.f, 0.f, 0.f, 0.f};
    bf16x8 At[4][2], B0[2][2], B1[2][2];
    unsigned vAc[2][2], vAn[2][2];
    if constexpr (GATHER) { PG8_GOFF(vAc, cur); }
    const char* gA = (const char*)g.A;
    const char* cA = gA + (GATHER ? (size_t)0 : (size_t)cur.pm * tstep + (size_t)cur.ks * sstep);
    const char* cB = (const char*)g.Bt + (size_t)cur.pn * tstep + (size_t)cur.ks * sstep + (g.texp ? (size_t)g.texp[cur.pm] * g.estride * 2 : (size_t)0);
    PG8_STAGE(PG8_SB(0, 0), cB, voffB); PG8_STAGE(PG8_SB(0, 1), cB + hstep, voffB);
    if constexpr (GATHER) { PG8_STAGE(PG8_SA(0, 0), gA, vAc[0]); PG8_STAGE(PG8_SA(0, 1), gA, vAc[1]); }
    else { PG8_STAGE(PG8_SA(0, 0), cA, voffA); PG8_STAGE(PG8_SA(0, 1), cA + hstep, voffA); }
    if (wr == 1) PG8_BAR;
    PG8_WAIT_V(2); PG8_BAR;
    PG8_STAGE(PG8_SB(1, 0), cB + kstep, voffB);
    if constexpr (GATHER) { PG8_STAGE(PG8_SA(1, 0), gA + kstep, vAc[0]); } else { PG8_STAGE(PG8_SA(1, 0), cA + kstep, voffA); }
    PG8_STAGE(PG8_SB(1, 1), cB + hstep + kstep, voffB);
    PG8_WAIT_V(6); PG8_BAR;
    for (;;) {
        const bool has_next = S.next(ui + 1, nxt);
        nxt.ks = 0; if (has_next && g.nks > 1) { nxt.ks = nxt.pn / g.nNr; nxt.pn -= nxt.ks * g.nNr; }
        const char* nA = (has_next && !GATHER) ? gA + (size_t)nxt.pm * tstep + (size_t)nxt.ks * sstep : cA;
        const char* nB = has_next ? (const char*)g.Bt + (size_t)nxt.pn * tstep + (size_t)nxt.ks * sstep + (g.texp ? (size_t)g.texp[nxt.pm] * g.estride * 2 : (size_t)0) : cB;
        if constexpr (GATHER) { if (has_next) { PG8_GOFF(vAn, nxt); } else {
#pragma unroll
            for (int h = 0; h < 2; ++h)
#pragma unroll
                for (int i = 0; i < 2; ++i) vAn[h][i] = vAc[h][i]; } }
        for (int t = 0; t < nt; t += 2) {
            const bool last = (t == nt - 2);
            const char* a1 = cA + (size_t)(t + 1) * kstep;
            const char* a2 = last ? nA : cA + (size_t)(t + 2) * kstep; const char* b2 = last ? nB : cB + (size_t)(t + 2) * kstep;
            const char* a3 = a2 + kstep; const char* b3 = b2 + kstep;
            unsigned v2[2][2];
            if constexpr (GATHER) {
#pragma unroll
                for (int h = 0; h < 2; ++h)
#pragma unroll
                    for (int i = 0; i < 2; ++i) v2[h][i] = last ? vAn[h][i] : vAc[h][i]; }
#define PG8_STA1(buf) do { if constexpr (GATHER) { PG8_STAGE(buf, a1, vAc[1]); } else { PG8_STAGE(buf, a1 + hstep, voffA); } } while (0)
#define PG8_STA2(buf, h) do { if constexpr (GATHER) { PG8_STAGE(buf, a2, v2[h]); } else { PG8_STAGE(buf, a2 + (h) * hstep, voffA); } } while (0)
#define PG8_STA3(buf) do { if constexpr (GATHER) { PG8_STAGE(buf, a3, v2[0]); } else { PG8_STAGE(buf, a3, voffA); } } while (0)
            PG8_LDB(B0, 0, 0); PG8_LDB(B1, 0, 1); PG8_SCHED; PG8_LDA(At, 0, 0); PG8_STA1(PG8_SA(1, 1));
            PG8_WAIT_V(8); PG8_WAIT_L(0); PG8_BAR; PG8_MMA(0, 0, At, B0); PG8_MMA(0, 1, At, B1); PG8_BAR; PG8_SCHED;
            PG8_LDA(At, 0, 1); PG8_STAGE(PG8_SB(0, 0), b2, voffB); PG8_STAGE(PG8_SB(0, 1), b2 + hstep, voffB); PG8_STA2(PG8_SA(0, 0), 0);
            PG8_WAIT_V(8); PG8_WAIT_L(0); PG8_BAR; PG8_MMA(1, 0, At, B0); PG8_MMA(1, 1, At, B1); PG8_BAR; PG8_SCHED;
            PG8_LDB(B0, 1, 0); PG8_LDB(B1, 1, 1); PG8_SCHED; PG8_LDA(At, 1, 0); PG8_STA2(PG8_SA(0, 1), 1);
            PG8_WAIT_V(8); PG8_WAIT_L(0); PG8_BAR; PG8_MMA(0, 0, At, B0); PG8_MMA(0, 1, At, B1); PG8_BAR; PG8_SCHED;
            PG8_LDA(At, 1, 1); PG8_STAGE(PG8_SB(1, 0), b3, voffB); PG8_STAGE(PG8_SB(1, 1), b3 + hstep, voffB); PG8_STA3(PG8_SA(1, 0));
            PG8_WAIT_V(8); PG8_WAIT_L(0); PG8_BAR; PG8_MMA(1, 0, At, B0); PG8_MMA(1, 1, At, B1); PG8_BAR; PG8_SCHED;
        }
        if (wr == 0) PG8_BAR;
        E(acc, cur, wr, wc, fr, fq);
        if (!has_next) break;
#pragma unroll
        for (int a = 0; a < 2; ++a)
#pragma unroll
            for (int b = 0; b < 2; ++b)
#pragma unroll
                for (int m = 0; m < 4; ++m)
#pragma unroll
                    for (int n = 0; n < 2; ++n) acc[a][b][m][n] = (f32x4){0.f, 0.f, 0.f, 0.f};
        cur = nxt; cA = nA; cB = nB; ++ui;
        if constexpr (GATHER) {
#pragma unroll
            for (int h = 0; h < 2; ++h)
#pragma unroll
                for (int i = 0; i < 2; ++i) vAc[h][i] = vAn[h][i]; }
        if (wr == 1) PG8_BAR;
    }
    PG8_WAIT_V(0);
    PG8_BAR;
#undef PG8_SA
#undef PG8_SB
#undef PG8_STAGE
#undef PG8_LDA
#undef PG8_LDB
#undef PG8_MMA
#undef PG8_WAIT_V
#undef PG8_WAIT_L
#undef PG8_BAR
#undef PG8_SCHED
#undef PG8_GOFF
#undef PG8_STA1
#undef PG8_STA2
#undef PG8_STA3
}
}

struct CvtCursor { int base; };
template <bool VEC4>
__device__ __forceinline__ void cvt_matrix(CvtCursor& cur, const float* W, int K, int N, bf16_t* WT, int Kpad, int Npad, int mode, LAS float* scr, int gw, int NW, int lane, const float* kgain = nullptr) {
    const int nkb = Kpad / 64, nnb = Npad / 32, nitems = nkb * nnb;
    int first = (gw - cur.base % NW + NW) % NW;
    cur.base += nitems;
    for (int it = first; it < nitems; it += NW) {
        const int kb = it / nnb, nb = it % nnb, k0 = kb * 64, n0 = nb * 32;
        const int drow0 = mode == 0 ? n0 : (((n0 >> 7) << 8) + (n0 & 127) + (mode == 2 ? 128 : 0));
        if (VEC4) {
            const bool inr = (k0 < K) && (n0 < N);
#pragma unroll
            for (int i = 0; i < 8; ++i) {
                const int kk = i * 8 + (lane >> 3), nn = (lane & 7) * 4;
                f32x4 v = {0.f, 0.f, 0.f, 0.f};
                if (inr) { v = __builtin_nontemporal_load((const f32x4*)(W + (size_t)(k0 + kk) * N + n0 + nn)); if (kgain) v = v * kgain[k0 + kk]; }
                scr[kk * 33 + nn] = v.x; scr[kk * 33 + nn + 1] = v.y; scr[kk * 33 + nn + 2] = v.z; scr[kk * 33 + nn + 3] = v.w;
            }
        } else {
#pragma unroll 8
            for (int i = 0; i < 32; ++i) { const int kk = 2 * i + (lane >> 5), n = n0 + (lane & 31);
                scr[kk * 33 + (lane & 31)] = (k0 + kk < K && n < N) ? W[(size_t)(k0 + kk) * N + n] * (kgain ? kgain[k0 + kk] : 1.f) : 0.f; }
        }
        asm volatile("s_waitcnt lgkmcnt(0)" ::: "memory");
        const int c = lane & 7;
#pragma unroll
        for (int j = 0; j < 4; ++j) { const int n = (lane >> 3) + 8 * j; const LAS float* sp = scr + (8 * c) * 33 + n;
            u32x4 o; o.x = pk_bf16(sp[0 * 33], sp[1 * 33]); o.y = pk_bf16(sp[2 * 33], sp[3 * 33]); o.z = pk_bf16(sp[4 * 33], sp[5 * 33]); o.w = pk_bf16(sp[6 * 33], sp[7 * 33]);
            *(u32x4*)(WT + (size_t)(drow0 + n) * Kpad + k0 + 8 * c) = o; }
        asm volatile("s_waitcnt lgkmcnt(0)" ::: "memory");
    }
}

__device__ __forceinline__ void ph_rope_table(float* tab) {
    GT_DECL
    for (int i = gt; i < SEQ * 16; i += NT) {
        const int s = i >> 4, k = i & 15;
        const double inv = exp10(-0.25 * (double)k);
        float sn, cs; sincos_d((double)s * inv, sn, cs);
        tab[i] = cs; tab[SEQ * 16 + i] = sn;
    }
}

__device__ __forceinline__ void ph_mla_prep(const float* proj, const float* qn_g, const float* kvn_g, const float* rope, bf16_t* cqn, bf16_t* ckvn, bf16_t* krope) {
    GT_DECL
    const bool qa = lane < 48, ka = lane < 32;
    const f32x4 gq = qa ? *(const f32x4*)(qn_g + lane * 4) : (f32x4){0.f, 0.f, 0.f, 0.f};
    const f32x4 gk = ka ? *(const f32x4*)(kvn_g + lane * 4) : (f32x4){0.f, 0.f, 0.f, 0.f};
    for (int t = gw; t < T; t += NW) {
        const float* pr = proj + (size_t)t * INLD;
        const f32x4 a = qa ? *(const f32x4*)(pr + O_CQ + lane * 4) : (f32x4){0.f, 0.f, 0.f, 0.f};
        const f32x4 b = ka ? *(const f32x4*)(pr + O_CKV + lane * 4) : (f32x4){0.f, 0.f, 0.f, 0.f};
        float x1 = 0.f, x2 = 0.f, c = 0.f, sn = 0.f;
        if (lane < 16) { const int s = t & (SEQ - 1); c = rope[s * 16 + lane]; sn = rope[SEQ * 16 + s * 16 + lane]; x1 = pr[O_KR + lane]; x2 = pr[O_KR + 16 + lane]; }
        const float rs = rsqrtf(wave_sum((a.x * a.x + a.y * a.y) + (a.z * a.z + a.w * a.w)) * (1.f / 192.f) + EPS);
        const float rs2 = rsqrtf(wave_sum((b.x * b.x + b.y * b.y) + (b.z * b.z + b.w * b.w)) * (1.f / 128.f) + EPS);
        *(u32x2*)(cqn + (size_t)t * 256 + lane * 4) = (u32x2){pk_bf16(a.x * rs * gq.x, a.y * rs * gq.y), pk_bf16(a.z * rs * gq.z, a.w * rs * gq.w)};
        *(u32x2*)(ckvn + (size_t)t * 256 + lane * 4) = (u32x2){pk_bf16(b.x * rs2 * gk.x, b.y * rs2 * gk.y), pk_bf16(b.z * rs2 * gk.z, b.w * rs2 * gk.w)};
        if (lane < 16) { krope[(size_t)t * 32 + lane] = f2bf(x1 * c - x2 * sn); krope[(size_t)t * 32 + 16 + lane] = f2bf(x2 * c + x1 * sn); }
    }
}

struct SsmConst { float ab_r, ab_i, bb_r[16], bb_i[16]; double ang; float lrdt; };
__device__ __forceinline__ void ssm_consts(const Params& p, int l, int g, int lane, SsmConst& c) {
    const float dt = expf(p.in[IN_SLDT][l * 16 + g]);
    const float lr = p.in[IN_SARE][(l * 16 + g) * 64 + lane], li = p.in[IN_SAIM][(l * 16 + g) * 64 + lane];
    const float mag = expf(lr * dt);
    float sn, cs; sincos_d((double)li * (double)dt, sn, cs);
    c.ab_r = mag * cs; c.ab_i = mag * sn; c.ang = (double)li * (double)dt; c.lrdt = lr * dt;
    const float den = lr * lr + li * li, nr = c.ab_r - 1.f;
    const float f_r = (nr * lr + c.ab_i * li) / den, f_i = (c.ab_i * lr - nr * li) / den;
    const float* bre = p.in[IN_SBRE] + ((size_t)(l * 16 + g) * 64 + lane) * 16;
    const float* bim = p.in[IN_SBIM] + ((size_t)(l * 16 + g) * 64 + lane) * 16;
#pragma unroll
    for (int k4 = 0; k4 < 4; ++k4) { const f32x4 br4 = *(const f32x4*)(bre + 4 * k4), bi4 = *(const f32x4*)(bim + 4 * k4);
        const float brr[4] = {br4.x, br4.y, br4.z, br4.w}, bii[4] = {bi4.x, bi4.y, bi4.z, bi4.w};
#pragma unroll
        for (int q = 0; q < 4; ++q) { c.bb_r[4 * k4 + q] = f_r * brr[q] - f_i * bii[q]; c.bb_i[4 * k4 + q] = f_r * bii[q] + f_i * brr[q]; } }
}
__device__ __forceinline__ void ph_ssm1(const Params& p, int l, const float* proj, f32x2* E, LAS unsigned char* lds) {
    GT_DECL
    LAS float* ut = (LAS float*)(lds + (tid >> 6) * 16384 + 9216);
    const int nblk = (int)gridDim.x, half_w = (nblk / 2) * (NTHR / 64);
    const bool even_split = (nblk & 1) || (NB * 32 * 16 != 4 * half_w);
    const int wv = gw;
    const int my_first = even_split ? wv : (wv < half_w ? wv : half_w + (wv - half_w) * 3);
    const int my_count = even_split ? 0 : (wv < half_w ? 1 : 3);
    for (int it = 0; even_split ? (my_first + it * NW < NB * 32 * 16) : (it < my_count); ++it) {
        const int w = even_split ? my_first + it * NW : my_first + it;
        const int g = w & 15, k = (w >> 4) & 31, b = w >> 9;
        const float* up = proj + (size_t)(b * SEQ + k * 64) * INLD + O_U + g * 16;
        {
            const f32x4* ur = (const f32x4*)(up + (size_t)lane * INLD);
            const f32x4 u0 = ur[0], u1 = ur[1], u2 = ur[2], u3 = ur[3];
            LAS f32x4* ud = (LAS f32x4*)(ut + lane * 16);
            ud[0] = u0; ud[1] = u1; ud[2] = u2; ud[3] = u3;
        }
        SsmConst c; ssm_consts(p, l, g, lane, c);
        float hr = 0.f, hi = 0.f;
        asm volatile("s_waitcnt lgkmcnt(0)" ::: "memory");
        for (int j = 0; j < 64; ++j) {
            float br = 0.f, bi = 0.f;
            const LAS f32x4* uj4 = (const LAS f32x4*)(ut + j * 16);
            const f32x4 ua = uj4[0], ub = uj4[1], uc = uj4[2], ud4 = uj4[3];
            const float uu[16] = {ua.x, ua.y, ua.z, ua.w, ub.x, ub.y, ub.z, ub.w, uc.x, uc.y, uc.z, uc.w, ud4.x, ud4.y, ud4.z, ud4.w};
#pragma unroll
            for (int q = 0; q < 16; ++q) { const float u = uu[q]; br += u * c.bb_r[q]; bi += u * c.bb_i[q]; }
            const float nr = c.ab_r * hr - c.ab_i * hi + br, ni = c.ab_r * hi + c.ab_i * hr + bi;
            hr = nr; hi = ni;
        }
        E[(size_t)w * 64 + lane] = (f32x2){hr, hi};
    }
}
__device__ __forceinline__ void ph_ssm2(const Params& p, int l, const float* proj, const f32x2* E, bf16_t* ypre, LAS unsigned char* lds) {
    GT_DECL
    constexpr int HSTR = 272;
    LAS unsigned char* hb = lds + (tid >> 6) * 16384;
    LAS float* ut = (LAS float*)(lds + (tid >> 6) * 16384 + 9216);
    LAS bf16_t* yt = (LAS bf16_t*)(lds + (tid >> 6) * 16384 + 13312);
    const int fr = lane & 15, fq = lane >> 4;
    for (int w = gw; w < NB * 32 * 16; w += NW) {
        const int g = w & 15, k = (w >> 4) & 31, b = w >> 9;
        SsmConst c; ssm_consts(p, l, g, lane, c);
        float l64r, l64i; { float sn, cs; sincos_d(c.ang * 64.0, sn, cs); const float m = expf(64.f * c.lrdt); l64r = m * cs; l64i = m * sn; }
        float hr = 0.f, hi = 0.f;
        for (int kk0 = 0; kk0 < k; kk0 += 8) {
            f32x2 ev[8];
#pragma unroll
            for (int q = 0; q < 8; ++q) { const int kk = kk0 + q < k ? kk0 + q : k - 1; ev[q] = E[(size_t)(((b * 32 + kk) * 16) + g) * 64 + lane]; }
#pragma unroll
            for (int q = 0; q < 8; ++q) if (kk0 + q < k) {
                const float nr = l64r * hr - l64i * hi + ev[q].x, ni = l64r * hi + l64i * hr + ev[q].y;
                hr = nr; hi = ni;
            }
        }
        bf16x8_t cb[4];
        {
            const float* cre = p.in[IN_SCRE] + ((size_t)(l * 16 + g) * 16 + fr) * 64;
            const float* cim = p.in[IN_SCIM] + ((size_t)(l * 16 + g) * 16 + fr) * 64;
#pragma unroll
            for (int s = 0; s < 4; ++s) {
                const f32x4 vr = *(const f32x4*)(cre + 16 * s + 4 * fq), vi = *(const f32x4*)(cim + 16 * s + 4 * fq);
                cb[s] = pack8f(vr.x, -vi.x, vr.y, -vi.y, vr.z, -vi.z, vr.w, -vi.w);
            }
        }
        const float dd = p.in[IN_SD][l * 256 + g * 16 + fr];
        const float* up = proj + (size_t)(b * SEQ + k * 64) * INLD + O_U + g * 16;
        {
            const f32x4* ur = (const f32x4*)(up + (size_t)lane * INLD);
            const f32x4 u0 = ur[0], u1 = ur[1], u2 = ur[2], u3 = ur[3];
            LAS f32x4* ud = (LAS f32x4*)(ut + lane * 16);
            ud[0] = u0; ud[1] = u1; ud[2] = u2; ud[3] = u3;
        }
        asm volatile("s_waitcnt lgkmcnt(0)" ::: "memory");
        for (int half = 0; half < 2; ++half) {
            for (int j = 0; j < 32; ++j) {
                float br = 0.f, bi = 0.f;
                const LAS f32x4* uj4 = (const LAS f32x4*)(ut + (half * 32 + j) * 16);
                const f32x4 ua = uj4[0], ub = uj4[1], uc = uj4[2], ud4 = uj4[3];
                const float uu[16] = {ua.x, ua.y, ua.z, ua.w, ub.x, ub.y, ub.z, ub.w, uc.x, uc.y, uc.z, uc.w, ud4.x, ud4.y, ud4.z, ud4.w};
#pragma unroll
                for (int q = 0; q < 16; ++q) { const float u = uu[q]; br += u * c.bb_r[q]; bi += u * c.bb_i[q]; }
                const float nr = c.ab_r * hr - c.ab_i * hi + br, ni = c.ab_r * hi + c.ab_i * hr + bi;
                hr = nr; hi = ni;
                *(LAS unsigned*)(hb + j * HSTR + lane * 4) = pk_bf16(hr, hi);
            }
            asm volatile("s_waitcnt lgkmcnt(0)" ::: "memory");
#pragma unroll
            for (int mt = 0; mt < 2; ++mt) {
                f32x4 acc = {0.f, 0.f, 0.f, 0.f};
#pragma unroll
                for (int s = 0; s < 4; ++s) {
                    const bf16x8_t a = *(const LAS bf16x8_t*)(hb + (16 * mt + fr) * HSTR + (32 * s + 8 * fq) * 2);
                    acc = __builtin_amdgcn_mfma_f32_16x16x32_bf16(a, cb[s], acc, 0, 0, 0);
                }
#pragma unroll
                for (int rg = 0; rg < 4; ++rg) {
                    const int step = half * 32 + 16 * mt + 4 * fq + rg;
                    const float u = ut[step * 16 + fr];
                    yt[step * 16 + fr] = f2bf(gelu_tanh(acc[rg] + dd * u));
                }
            }
            asm volatile("s_waitcnt lgkmcnt(0)" ::: "memory");
        }
        {
            const LAS u32x4* yr = (const LAS u32x4*)(yt + lane * 16);
            const u32x4 y0 = yr[0], y1 = yr[1];
            u32x4* yo = (u32x4*)(ypre + (size_t)(b * SEQ + k * 64 + lane) * 256 + g * 16);
            yo[0] = y0; yo[1] = y1;
        }
        asm volatile("s_waitcnt lgkmcnt(0)" ::: "memory");
    }
}

__device__ __forceinline__ void ph_cmp1(const Params& p, int l, const float* proj, float* hid) {
    GT_DECL
    const int total = 2 * NB * NBC * 2 * 64;
    for (int i = gt; i < total; i += NT) {
        const int c = i & 63, row = (i >> 6) % (NB * NBC * 2), j = (i >> 6) / (NB * NBC * 2);
        const int g = row & 1, n = (row >> 1) % NBC, b = (row >> 1) / NBC;
        const float* w1 = p.in[IN_NW1] + (size_t)(l * 2 + j) * 2048 * 64;
        const float* pe = p.in[IN_NPE] + (size_t)(l * 2 + j) * 32 * 64;
        float acc = 0.f;
        for (int pos = 0; pos < 32; ++pos) {
            const float* kv = proj + (size_t)(b * SEQ + n * 16 + pos) * INLD + O_NKV + j * 128 + g * 64;
            for (int d = 0; d < 64; ++d) acc += (kv[d] + pe[pos * 64 + d]) * w1[(size_t)(pos * 64 + d) * 64 + c];
        }
        hid[i] = gelu_tanh(acc);
    }
}
__device__ __forceinline__ void ph_cmp2(const Params& p, int l, const float* hid, float* kc) {
    GT_DECL
    const int total = 2 * NB * NBC * 2 * 64;
    for (int i = gt; i < total; i += NT) {
        const int c = i & 63, j = (i >> 6) / (NB * NBC * 2);
        const float* w2 = p.in[IN_NW2] + (size_t)(l * 2 + j) * 64 * 64;
        const float* h = hid + (size_t)(i >> 6) * 64;
        float acc = 0.f;
        for (int k = 0; k < 64; ++k) acc += h[k] * w2[k * 64 + c];
        kc[i] = acc;
    }
}

__device__ __forceinline__ void ph_mla_attn(const float* qmla, const float* kvmla, const float* krope, const float* rope, float* ycat) {
    GT_DECL
    const float scale = 0.10206207261596575f;
    for (int w = gw; w < 6 * (T / 64); w += NW) {
        const int h = __builtin_amdgcn_readfirstlane(w % 6), tb = __builtin_amdgcn_readfirstlane(w / 6);
        const int t = tb * 64 + lane, s = t & (SEQ - 1), b = __builtin_amdgcn_readfirstlane(t >> 11);
        float q[96];
        const float* qp = qmla + (size_t)t * 768 + h * 96;
#pragma unroll
        for (int d = 0; d < 64; ++d) q[d] = qp[d] * scale;
#pragma unroll
        for (int d = 0; d < 16; ++d) {
            const float c = rope[s * 16 + d], sn = rope[SEQ * 16 + s * 16 + d];
            const float x1 = qp[64 + d], x2 = qp[80 + d];
            q[64 + d] = (x1 * c - x2 * sn) * scale; q[80 + d] = (x2 * c + x1 * sn) * scale;
        }
        const int jmax = __builtin_amdgcn_readfirstlane((tb * 64 + 63) & (SEQ - 1));
        for (int half = 0; half < 2; ++half) {
            float acc[32];
#pragma unroll
            for (int d = 0; d < 32; ++d) acc[d] = 0.f;
            float m = -1e30f, lsum = 0.f;
            for (int j = 0; j <= jmax; ++j) {
                const float* kp = kvmla + (size_t)(b * SEQ + j) * 768 + h * 128;
                const float* rp = krope + (size_t)(b * SEQ + j) * 32;
                float sc = 0.f;
#pragma unroll
                for (int d = 0; d < 64; ++d) sc += q[d] * kp[d];
#pragma unroll
                for (int d = 0; d < 32; ++d) sc += q[64 + d] * rp[d];
                const bool ok = j <= s;
                const float mn = ok ? fmaxf(m, sc) : m;
                const float corr = __expf(m - mn), pj = ok ? __expf(sc - mn) : 0.f;
                lsum = lsum * corr + pj; m = mn;
#pragma unroll
                for (int d = 0; d < 32; ++d) acc[d] = acc[d] * corr + pj * kp[64 + half * 32 + d];
            }
            const float inv = 1.f / lsum;
            float* o = ycat + (size_t)t * D + 256 + h * 64 + half * 32;
#pragma unroll
            for (int d = 0; d < 32; ++d) o[d] = acc[d] * inv;
        }
    }
}

__device__ __forceinline__ void ph_nsa_cmp(const Params& p, const float* proj, const float* kc, float* impp, float* ycat) {
    GT_DECL
    const float* relb = p.in[IN_RELB];
    for (int w = gw; w < 6 * (T / 64); w += NW) {
        const int hh = __builtin_amdgcn_readfirstlane(w % 6), tb = __builtin_amdgcn_readfirstlane(w / 6);
        const int g = hh / 3;
        const int t = tb * 64 + lane, s = t & (SEQ - 1), b = __builtin_amdgcn_readfirstlane(t >> 11);
        float q[64];
        const float* qp = proj + (size_t)t * INLD + O_NQ + hh * 64;
#pragma unroll
        for (int d = 0; d < 64; ++d) q[d] = qp[d] * 0.125f;
        const int nvis = s >= 31 ? ((s - 31) >> 4) + 1 : 0;
        const int smax = (tb * 64 + 63) & (SEQ - 1);
        const int nmax = __builtin_amdgcn_readfirstlane(smax >= 31 ? ((smax - 31) >> 4) + 1 : 0);
        const float* kcb = kc + (size_t)b * NBC * 128 + g * 64;
        const float* vcb = kc + (size_t)NB * NBC * 128 + (size_t)b * NBC * 128 + g * 64;
        float m = -1e30f, lsum = 0.f;
        for (int n = 0; n < nmax; ++n) {
            const float* kp = kcb + n * 128;
            float sc = 0.f;
#pragma unroll
            for (int d = 0; d < 64; ++d) sc += q[d] * kp[d];
            const bool ok = n < nvis;
            sc += relb[t5_bucket(s - (n * 16 + 31)) * 6 + hh];
            const float mn = ok ? fmaxf(m, sc) : m;
            lsum = lsum * __expf(m - mn) + (ok ? __expf(sc - mn) : 0.f); m = mn;
        }
        const float inv = nvis > 0 ? 1.f / lsum : 0.f;
        float acc[64];
#pragma unroll
        for (int d = 0; d < 64; ++d) acc[d] = 0.f;
        const int mmax = (nmax + 4) >> 2;
        for (int mb = 0; mb < 32; ++mb) {
            float im = 0.f;
            if (mb < mmax) {
                for (int dn = -1; dn < 4; ++dn) {
                    const int n = 4 * mb + dn;
                    if (n < 0 || n >= nmax) continue;
                    const float* kp = kcb + n * 128;
                    float sc = 0.f;
#pragma unroll
                    for (int d = 0; d < 64; ++d) sc += q[d] * kp[d];
                    sc += relb[t5_bucket(s - (n * 16 + 31)) * 6 + hh];
                    const float pn = (n < nvis) ? __expf(sc - m) * inv : 0.f;
                    im += pn;
                    if (dn >= 0) { const float* vp = vcb + n * 128;
#pragma unroll
                        for (int d = 0; d < 64; ++d) acc[d] += pn * vp[d]; }
                }
            }
            impp[((size_t)t * 6 + hh) * 32 + mb] = im;
        }
        const float gate = sigmoidf_(proj[(size_t)t * INLD + O_NG + 0 * 6 + hh]);
        float* o = ycat + (size_t)t * D + 640 + hh * 64;
#pragma unroll
        for (int d = 0; d < 64; ++d) o[d] = gate * acc[d];
    }
}
__device__ __forceinline__ unsigned nsa_topk_mask(const float* ip  , int cur) {
    float imp[32];
#pragma unroll
    for (int m = 0; m < 32; ++m) imp[m] = (ip[(size_t)m * SEQ] + ip[(size_t)(32 + m) * SEQ]) + ip[(size_t)(64 + m) * SEQ];
#pragma unroll
    for (int m = 0; m < 32; ++m) {
        const bool forced = (m == 0) || (m == cur) || (m == cur - 1);
        const bool future = m > cur;
        imp[m] = forced ? 1e9f : (future ? -1e9f : imp[m]);
    }
    unsigned mask = 0u;
#pragma unroll
    for (int k = 0; k < 8; ++k) {
        float best = -3e38f; int bi = 0;
#pragma unroll
        for (int m = 0; m < 32; ++m) { const bool free_ = !((mask >> m) & 1u); if (free_ && imp[m] > best) { best = imp[m]; bi = m; } }
        mask |= 1u << bi;
    }
    return mask;
}
__device__ __forceinline__ void ph_nsa_selwin(const Params& p, const float* proj, const unsigned* sel, float* ycat) {
    GT_DECL
    const float* relb = p.in[IN_RELB];
    for (int w = gw; w < 6 * (T / 64); w += NW) {
        const int hh = w % 6, tb = w / 6, g = hh / 3;
        const int t = tb * 64 + lane, s = t & (SEQ - 1), b = t >> 11, cur = s >> 6;
        float q[64];
        const float* qp = proj + (size_t)t * INLD + O_NQ + hh * 64;
#pragma unroll
        for (int d = 0; d < 64; ++d) q[d] = qp[d] * 0.125f;
        const unsigned mask = sel[t * 2 + g];
        float* o = ycat + (size_t)t * D + 640 + hh * 64;
        const float gs = sigmoidf_(proj[(size_t)t * INLD + O_NG + 1 * 6 + hh]), gwn = sigmoidf_(proj[(size_t)t * INLD + O_NG + 2 * 6 + hh]);
        for (int half = 0; half < 2; ++half) {
        {
            float acc[32];
#pragma unroll
            for (int d = 0; d < 32; ++d) acc[d] = 0.f;
            float m = -1e30f, lsum = 0.f;
            for (int mb = 0; mb < 32; ++mb) {
                const bool on = ((mask >> mb) & 1u) && mb <= cur;
                if (!__any(on)) continue;
                for (int j = 0; j < 64; ++j) {
                    const int kpos = mb * 64 + j;
                    const bool ok = on && kpos <= s;
                    if (ok) {
                        const float* kp = proj + (size_t)(b * SEQ + kpos) * INLD + O_NKV + 2 * 128 + g * 64;
                        const float* vp = kp + 128 + half * 32;
                        float sc = 0.f;
#pragma unroll
                        for (int d = 0; d < 64; ++d) sc += q[d] * kp[d];
                        sc += relb[t5_bucket(s - kpos) * 6 + hh];
                        const float mn = fmaxf(m, sc), corr = __expf(m - mn), pj = __expf(sc - mn);
                        lsum = lsum * corr + pj; m = mn;
#pragma unroll
                        for (int d = 0; d < 32; ++d) acc[d] = acc[d] * corr + pj * vp[d];
                    }
                }
            }
            const float inv = gs / lsum;
#pragma unroll
            for (int d = 0; d < 32; ++d) o[half * 32 + d] += acc[d] * inv;
        }
        {
            float acc[32];
#pragma unroll
            for (int d = 0; d < 32; ++d) acc[d] = 0.f;
            float m = -1e30f, lsum = 0.f;
            for (int j = 0; j < 256; ++j) {
                const int kpos = s - 255 + j;
                if (kpos >= 0) {
                    const float* kp = proj + (size_t)(b * SEQ + kpos) * INLD + O_NKV + 4 * 128 + g * 64;
                    const float* vp = kp + 128 + half * 32;
                    float sc = 0.f;
#pragma unroll
                    for (int d = 0; d < 64; ++d) sc += q[d] * kp[d];
                    sc += relb[t5_bucket(s - kpos) * 6 + hh];
                    const float mn = fmaxf(m, sc), corr = __expf(m - mn), pj = __expf(sc - mn);
                    lsum = lsum * corr + pj; m = mn;
#pragma unroll
                    for (int d = 0; d < 32; ++d) acc[d] = acc[d] * corr + pj * vp[d];
                }
            }
            const float inv = gwn / lsum;
#pragma unroll
            for (int d = 0; d < 32; ++d) o[half * 32 + d] += acc[d] * inv;
        }
        }
    }
}

__device__ __forceinline__ void ph_group_norm(const float* ycat, const float* gain, bf16_t* yb) {
    GT_DECL
    const f32x4 ga = *(const f32x4*)(gain + lane * 4);
    f32x2 gb[3], gc[3];
#pragma unroll
    for (int i = 0; i < 3; ++i) { gb[i] = *(const f32x2*)(gain + 256 + lane * 6 + 2 * i); gc[i] = *(const f32x2*)(gain + 640 + lane * 6 + 2 * i); }
    for (int t = gw; t < T; t += NW) {
        const float* y = ycat + (size_t)t * D; bf16_t* o = yb + (size_t)t * D;
        const f32x4 a = *(const f32x4*)(y + lane * 4);
        f32x2 b[3], c[3];
#pragma unroll
        for (int i = 0; i < 3; ++i) { b[i] = *(const f32x2*)(y + 256 + lane * 6 + 2 * i); c[i] = *(const f32x2*)(y + 640 + lane * 6 + 2 * i); }
        float sa = (a.x * a.x + a.y * a.y) + (a.z * a.z + a.w * a.w), sb = 0.f, sc = 0.f;
#pragma unroll
        for (int i = 0; i < 3; ++i) { sb += b[i].x * b[i].x + b[i].y * b[i].y; sc += c[i].x * c[i].x + c[i].y * c[i].y; }
        const float ra = rsqrtf(wave_sum(sa) * (1.f / 256.f) + EPS), rb = rsqrtf(wave_sum(sb) * (1.f / 384.f) + EPS), rc = rsqrtf(wave_sum(sc) * (1.f / 384.f) + EPS);
        *(u32x2*)(o + lane * 4) = (u32x2){pk_bf16(a.x * ra * ga.x, a.y * ra * ga.y), pk_bf16(a.z * ra * ga.z, a.w * ra * ga.w)};
#pragma unroll
        for (int i = 0; i < 3; ++i) {
            *(unsigned*)(o + 256 + lane * 6 + 2 * i) = pk_bf16(b[i].x * rb * gb[i].x, b[i].y * rb * gb[i].y);
            *(unsigned*)(o + 640 + lane * 6 + 2 * i) = pk_bf16(c[i].x * rc * gc[i].x, c[i].y * rc * gc[i].y);
        }
    }
}

__device__ __forceinline__ void ph_xattn(const float* qx, const float* kvx, bf16_t* ox) {
    GT_DECL
    for (int w = gw; w < T * 4; w += NW) {
        const int h = w & 3, t = w >> 2, b = t >> 11;
        const float* q = qx + (size_t)t * D + h * 256;
        const float* kb = kvx + (size_t)(b * 256) * 2048 + h * 256;
        float sc[4] = {0.f, 0.f, 0.f, 0.f};
        for (int d = 0; d < 256; d += 4) {
            const f32x4 qv = *(const f32x4*)(q + d);
#pragma unroll
            for (int i = 0; i < 4; ++i) { const f32x4 kv = *(const f32x4*)(kb + (size_t)(i * 64 + lane) * 2048 + d); sc[i] += qv.x * kv.x + qv.y * kv.y + qv.z * kv.z + qv.w * kv.w; }
        }
        float mx = -1e30f;
#pragma unroll
        for (int i = 0; i < 4; ++i) { sc[i] *= 0.0625f; mx = fmaxf(mx, sc[i]); }
        mx = wave_max(mx);
        float ls = 0.f;
#pragma unroll
        for (int i = 0; i < 4; ++i) { sc[i] = __expf(sc[i] - mx); ls += sc[i]; }
        ls = wave_sum(ls);
        const float inv = 1.f / ls;
        f32x4 o = {0.f, 0.f, 0.f, 0.f};
        const float* vb = kb + 1024 + lane * 4;
#pragma unroll
        for (int i = 0; i < 4; ++i)
            for (int j = 0; j < 64; ++j) {
                const float pj = __shfl(sc[i], j);
                const f32x4 vv = *(const f32x4*)(vb + (size_t)(i * 64 + j) * 2048);
                o.x += pj * vv.x; o.y += pj * vv.y; o.z += pj * vv.z; o.w += pj * vv.w;
            }
        *(u32x2*)(ox + (size_t)t * D + h * 256 + lane * 4) = (u32x2){pk_bf16(o.x * inv, o.y * inv), pk_bf16(o.z * inv, o.w * inv)};
    }
}

__device__ __forceinline__ void ph_moe_route(const bf16_t* h, const float* gain, const float* router, bf16_t* hn, int* topi, float* topw) {
    GT_DECL
    f32x4 ra[16], rb[16], gg4[4];
#pragma unroll
    for (int j = 0; j < 4; ++j) {
        gg4[j] = *((const f32x4*)gain + lane + 64 * j);
#pragma unroll
        for (int c = 0; c < 4; ++c) { const float* r = router + (size_t)(j * 256 + lane * 4 + c) * 8; ra[4 * j + c] = *(const f32x4*)r; rb[4 * j + c] = *(const f32x4*)(r + 4); }
    }
    for (int t = gw; t < T; t += NW) {
        const u32x2* x = (const u32x2*)(h + (size_t)t * D) + lane;
        f32x4 v[4]; float s = 0.f;
#pragma unroll
        for (int j = 0; j < 4; ++j) { const u32x2 xb = x[64 * j]; v[j] = (f32x4){bflo(xb.x), bfhi(xb.x), bflo(xb.y), bfhi(xb.y)}; s += v[j].x * v[j].x + v[j].y * v[j].y + v[j].z * v[j].z + v[j].w * v[j].w; }
        const float rstd = rsqrtf(wave_sum(s) * (1.f / D) + EPS);
        u32x2* o = (u32x2*)(hn + (size_t)t * D) + lane;
        float lg[8] = {0.f, 0.f, 0.f, 0.f, 0.f, 0.f, 0.f, 0.f};
#pragma unroll
        for (int j = 0; j < 4; ++j) {
            const f32x4 gg = gg4[j];
            const f32x4 y = {v[j].x * rstd * gg.x, v[j].y * rstd * gg.y, v[j].z * rstd * gg.z, v[j].w * rstd * gg.w};
            o[64 * j] = (u32x2){pk_bf16(y.x, y.y), pk_bf16(y.z, y.w)};
            const float yy[4] = {y.x, y.y, y.z, y.w};
#pragma unroll
            for (int c = 0; c < 4; ++c) {
                const f32x4 r0 = ra[4 * j + c], r1 = rb[4 * j + c];
                lg[0] += yy[c] * r0.x; lg[1] += yy[c] * r0.y; lg[2] += yy[c] * r0.z; lg[3] += yy[c] * r0.w;
                lg[4] += yy[c] * r1.x; lg[5] += yy[c] * r1.y; lg[6] += yy[c] * r1.z; lg[7] += yy[c] * r1.w;
            }
        }
#pragma unroll
        for (int e = 0; e < 8; ++e) lg[e] = wave_sum(lg[e]);
        float v0 = -3e38f; int i0 = 0;
#pragma unroll
        for (int e = 0; e < 8; ++e) if (lg[e] > v0) { v0 = lg[e]; i0 = e; }
        float v1 = -3e38f; int i1 = 0;
#pragma unroll
        for (int e = 0; e < 8; ++e) if (e != i0 && lg[e] > v1) { v1 = lg[e]; i1 = e; }
        const float e1 = __expf(v1 - v0), w0 = 1.f / (1.f + e1), w1 = e1 * w0;
        if (lane == 0) { topi[t * 2] = i0; topi[t * 2 + 1] = i1; topw[t * 2] = w0; topw[t * 2 + 1] = w1; }
    }
}
__device__ __forceinline__ void ph_moe_sort(LAS int* lds, const int* topi, int* pos, int* rsrc, int* texp) {
    if (blockIdx.x != 0) return;
    const int tid = tid_(), lane = tid & 63, wave = tid >> 6;
    LAS int* cnt = lds;
    LAS int* tot = lds + 8 * 512;
    int c[8];
#pragma unroll
    for (int k = 0; k < 8; ++k) c[k] = 0;
    for (int i = 0; i < 64; ++i) { const int e = topi[i * NTHR + tid];
#pragma unroll
        for (int k = 0; k < 8; ++k) c[k] += (e == k) ? 1 : 0; }
#pragma unroll
    for (int k = 0; k < 8; ++k) cnt[k * NTHR + tid] = c[k];
    __syncthreads();
    {
        int v[8]; int sum = 0;
#pragma unroll
        for (int j = 0; j < 8; ++j) { v[j] = cnt[wave * NTHR + lane * 8 + j]; sum += v[j]; }
        int incl = sum;
#pragma unroll
        for (int o = 1; o < 64; o <<= 1) { const int t = __shfl_up(incl, o); if (lane >= o) incl += t; }
        int run = incl - sum;
#pragma unroll
        for (int j = 0; j < 8; ++j) { cnt[wave * NTHR + lane * 8 + j] = run; run += v[j]; }
        if (lane == 63) tot[wave] = incl;
    }
    __syncthreads();
    if (tid == 0) { int off = 0; for (int e = 0; e < 8; ++e) { tot[8 + e] = off; off += (tot[e] + 255) & ~255; } tot[16] = off; texp[160] = off >> 8; }
    __syncthreads();
    if (tid < MOE_TILES) { const int r0 = tid * 256; int ex = -1;
        for (int e = 0; e < 8; ++e) { const int lo = tot[8 + e], hi = lo + ((tot[e] + 255) & ~255); if (r0 >= lo && r0 < hi) ex = e; }
        texp[tid] = ex; }
    for (int e = 0; e < 8; ++e) { const int lo = tot[8 + e] + tot[e], hi = tot[8 + e] + ((tot[e] + 255) & ~255); for (int r = lo + tid; r < hi; r += NTHR) rsrc[r] = 0; }
    int run[8];
#pragma unroll
    for (int k = 0; k < 8; ++k) run[k] = tot[8 + k] + cnt[k * NTHR + tid];
    for (int i = 0; i < 64; ++i) {
        const int idx = i * NTHR + tid, e = topi[idx];
        int r = 0;
#pragma unroll
        for (int k = 0; k < 8; ++k) { r = (e == k) ? run[k] : r; run[k] += (e == k) ? 1 : 0; }
        rsrc[r] = idx >> 1; pos[idx] = r;
    }
}
__device__ __forceinline__ f32x4 moe_row4(const bf16_t* ys, const float* ys2p, int r, int col) {
    if (r < 2 * MOE_RT * 256) { const u32x2 b2 = *(const u32x2*)(ys + (size_t)r * D + col); return (f32x4){bflo(b2.x), bfhi(b2.x), bflo(b2.y), bfhi(b2.y)}; }
    const float* q = ys2p + (size_t)(r - 2 * MOE_RT * 256) * D + col;
    return (*(const f32x4*)q + *(const f32x4*)(q + (size_t)2048 * D)) + (*(const f32x4*)(q + (size_t)2 * 2048 * D) + *(const f32x4*)(q + (size_t)3 * 2048 * D));
}
__device__ __forceinline__ void ph_moe_combine_final(const bf16_t* h, const bf16_t* ys, const float* ys2p, const int* pos, const float* topw, const float* gain, float* out) {
    GT_DECL
    for (int t = gw; t < T; t += NW) {
        const u32x2* x = (const u32x2*)(h + (size_t)t * D) + lane;
        const int r0 = pos[t * 2], r1 = pos[t * 2 + 1];
        const float w0 = topw[t * 2], w1 = topw[t * 2 + 1];
        f32x4 v[4]; float s = 0.f;
#pragma unroll
        for (int j = 0; j < 4; ++j) { const u32x2 xb = x[64 * j]; const f32x4 a = {bflo(xb.x), bfhi(xb.x), bflo(xb.y), bfhi(xb.y)};
            const f32x4 b = moe_row4(ys, ys2p, r0, 256 * j + 4 * lane), c = moe_row4(ys, ys2p, r1, 256 * j + 4 * lane);
            v[j] = (f32x4){a.x + w0 * b.x + w1 * c.x, a.y + w0 * b.y + w1 * c.y, a.z + w0 * b.z + w1 * c.z, a.w + w0 * b.w + w1 * c.w};
            s += v[j].x * v[j].x + v[j].y * v[j].y + v[j].z * v[j].z + v[j].w * v[j].w; }
        const float rstd = rsqrtf(wave_sum(s) * (1.f / D) + EPS);
        f32x4* o = (f32x4*)(out + (size_t)t * D) + lane; const f32x4* g = (const f32x4*)gain + lane;
#pragma unroll
        for (int j = 0; j < 4; ++j) { const f32x4 gg = g[64 * j]; o[64 * j] = (f32x4){v[j].x * rstd * gg.x, v[j].y * rstd * gg.y, v[j].z * rstd * gg.z, v[j].w * rstd * gg.w}; }
    }
}

namespace fa {
typedef short bf16x8 __attribute__((ext_vector_type(8)));
typedef __bf16 bfv8 __attribute__((ext_vector_type(8)));
typedef float f32x8 __attribute__((ext_vector_type(8)));
typedef float f32x16 __attribute__((ext_vector_type(16)));
typedef short s16x4 __attribute__((ext_vector_type(4)));
#define FA_MFMA(a, b, c) __builtin_amdgcn_mfma_f32_32x32x16_bf16((a), (b), (c), 0, 0, 0)
constexpr float LOG2E = 1.4426950408889634f;
constexpr float NEG_S = -1e30f, M_INIT = -1e20f;
enum { MASK_NONE = 0, MASK_CAUSAL = 1, MASK_WIN = 2, MASK_SEL = 3 };

__device__ __forceinline__ bf16x8 pack8(float a0, float a1, float a2, float a3, float a4, float a5, float a6, float a7) {
    const f32x8 v = {a0, a1, a2, a3, a4, a5, a6, a7};
    return __builtin_bit_cast(bf16x8, __builtin_convertvector(v, bfv8));
}
struct KVSrc { const bf16_t* K0; int ldk0; const bf16_t* K1; int ldk1; const bf16_t* V; int ldv; };

template <int DK, int DK0, int DVT, int KT>
struct Geo {
    static constexpr int KSTR = DK * 2 + 16, VSTR = (DVT == 64) ? 192 : (DVT * 2 + 64);
    static constexpr int KBUF = KT * KSTR, VBUF = KT * VSTR;
    static constexpr int NKC = KT * DK / 8 / 256, NVC = KT * DVT / 8 / 256;
    static constexpr int LDS_TILES = 2 * KBUF + 2 * VBUF;
    static_assert(NKC * 256 * 8 == KT * DK && NVC * 256 * 8 == KT * DVT && (VSTR / 4) % 64 % 32 == 16, "staging split / V stride");
};

template <int DK, int DK0, int DVW, int DVT, int KT, int MASK>
__device__ __forceinline__ void attn_pass(LAS unsigned char* lds, const KVSrc src, const bf16x8 (&qf)[DK / 16], f32x16 (&O)[DVW / 32], float& m, float& l,
                                          int kt_lo, int kt_hi, int qpos, int qw, int dvoff, unsigned selmask, const LAS float* biasT, float c1) {
    typedef Geo<DK, DK0, DVT, KT> G;
    const int tid = tid_(), lane = tid & 63, r = lane & 31, h = lane >> 5;
    u32x4 kreg[G::NKC]; u32x4 vreg[G::NVC];
    const int trq = (lane & 15) >> 2, trp = lane & 3, trblk = (lane >> 4) & 1;
#define FA_ISSUE(k0_) do { const int k0i_ = (k0_); \
    if (tid >= 256) { _Pragma("unroll") for (int i_ = 0; i_ < G::NKC; ++i_) { const int c_ = (tid - 256) + 256 * i_, key_ = c_ / (DK / 8), col_ = (c_ % (DK / 8)) * 8; \
        const bf16_t* p_ = (col_ < DK0) ? src.K0 + (size_t)(k0i_ + key_) * src.ldk0 + col_ : src.K1 + (size_t)(k0i_ + key_) * src.ldk1 + (col_ - DK0); \
        kreg[i_] = *(const u32x4*)p_; } } \
    else { _Pragma("unroll") for (int i_ = 0; i_ < G::NVC; ++i_) { const int c_ = tid + 256 * i_, key_ = c_ / (DVT / 8), cc_ = c_ % (DVT / 8); \
        vreg[i_] = *(const u32x4*)(src.V + (size_t)(k0i_ + key_) * src.ldv + cc_ * 8); } } } while (0)
#define FA_COMMIT(buf_) do { LAS unsigned char* kb_ = lds + (buf_) * G::KBUF; LAS unsigned char* vb_ = lds + 2 * G::KBUF + (buf_) * G::VBUF; \
    if (tid >= 256) { _Pragma("unroll") for (int i_ = 0; i_ < G::NKC; ++i_) { const int c_ = (tid - 256) + 256 * i_, key_ = c_ / (DK / 8), cc_ = c_ % (DK / 8); \
        *(LAS u32x4*)(kb_ + key_ * G::KSTR + cc_ * 16) = kreg[i_]; } } \
    else { _Pragma("unroll") for (int i_ = 0; i_ < G::NVC; ++i_) { const int c_ = tid + 256 * i_, key_ = c_ / (DVT / 8), cc_ = c_ % (DVT / 8); \
        *(LAS u32x4*)(vb_ + key_ * G::VSTR + cc_ * 16) = vreg[i_]; } } } while (0)
    if (kt_lo < kt_hi) { FA_ISSUE(kt_lo * KT); FA_COMMIT(0); }
    __syncthreads();
    for (int kt = kt_lo; kt < kt_hi; ++kt) {
        const int buf = (kt - kt_lo) & 1, k0 = kt * KT;
        if (kt + 1 < kt_hi) FA_ISSUE(k0 + KT);
        bool need = true, full = true;
        if (MASK == MASK_CAUSAL || MASK == MASK_SEL) { need = k0 <= qw + 31; full = (k0 + KT - 1 <= qw); }
        if (MASK == MASK_WIN) { need = (k0 <= qw + 31) && (k0 + KT - 1 >= qw - 255); full = (k0 + KT - 1 <= qw) && (k0 >= qw + 31 - 255); }
        if (need) {
            const LAS unsigned char* kb = lds + buf * G::KBUF; const LAS unsigned char* vb = lds + 2 * G::KBUF + buf * G::VBUF;
            f32x16 S[KT / 32];
#pragma unroll
            for (int mt = 0; mt < KT / 32; ++mt) {
#pragma unroll
                for (int i = 0; i < 16; ++i) S[mt][i] = 0.f;
#pragma unroll
                for (int s = 0; s < DK / 16; ++s) {
                    const bf16x8 a = *(const LAS bf16x8*)(kb + (32 * mt + r) * G::KSTR + (2 * s + h) * 16);
                    __builtin_amdgcn_s_setprio(1); S[mt] = FA_MFMA(a, qf[s], S[mt]); __builtin_amdgcn_s_setprio(0);
                }
            }
            const bool hasbias = (MASK == MASK_WIN || MASK == MASK_SEL);
            const bool near = hasbias && (qw - (k0 + KT - 1) < 127);
            const bool selok = (MASK == MASK_SEL) ? (((selmask >> (k0 >> 6)) & 1u) != 0u) : true;
            const float bfar = hasbias ? biasT[256] : 0.f;
            float tmax = NEG_S;
            bool raw = false;
            if (full && !near) {
                if (!hasbias && MASK != MASK_SEL) {
                    raw = true;
#pragma unroll
                    for (int mt = 0; mt < KT / 32; ++mt)
#pragma unroll
                        for (int i = 0; i < 16; ++i) tmax = fmaxf(tmax, S[mt][i]);
                    tmax *= c1;
                } else {
#pragma unroll
                    for (int mt = 0; mt < KT / 32; ++mt)
#pragma unroll
                        for (int i = 0; i < 16; ++i) { float v = S[mt][i] * c1 + bfar; if (MASK == MASK_SEL) v = selok ? v : NEG_S; S[mt][i] = v; tmax = fmaxf(tmax, v); }
                }
            } else if (hasbias) {
                const LAS float* tb = biasT + (383 - (qpos - k0 - 4 * h));
#pragma unroll
                for (int mt = 0; mt < KT / 32; ++mt)
#pragma unroll
                    for (int i = 0; i < 16; ++i) {
                        float v = S[mt][i] * c1 + tb[32 * mt + (i & 3) + 8 * (i >> 2)];
                        if (MASK == MASK_SEL) v = selok ? v : NEG_S;
                        v = fmaxf(v, NEG_S);
                        S[mt][i] = v; tmax = fmaxf(tmax, v);
                    }
            } else {
                const int qrel = qpos - k0 - 4 * h;
#pragma unroll
                for (int mt = 0; mt < KT / 32; ++mt)
#pragma unroll
                    for (int i = 0; i < 16; ++i) {
                        const int dist = qrel - (32 * mt + (i & 3) + 8 * (i >> 2));
                        bool ok = selok;
                        if (MASK != MASK_NONE) ok = ok && (dist >= 0);
                        if (MASK == MASK_WIN) ok = ok && (dist < 256);
                        float b = 0.f;
                        if (hasbias) { const int di = dist < 0 ? 0 : (dist > 127 ? 127 : dist); b = biasT[di]; }
                        const float v = ok ? S[mt][i] * c1 + b : NEG_S;
                        S[mt][i] = v; tmax = fmaxf(tmax, v);
                    }
            }
            tmax = xhalf_max(tmax);
            const float mn = fmaxf(m, tmax);
            const bool moved = mn > m;
            float ps = 0.f;
            if (raw) {
#pragma unroll
                for (int mt = 0; mt < KT / 32; ++mt)
#pragma unroll
                    for (int i = 0; i < 16; ++i) { const float pv = __builtin_amdgcn_exp2f(S[mt][i] * c1 - mn); S[mt][i] = pv; ps += pv; }
            } else {
#pragma unroll
                for (int mt = 0; mt < KT / 32; ++mt)
#pragma unroll
                    for (int i = 0; i < 16; ++i) { const float pv = __builtin_amdgcn_exp2f(S[mt][i] - mn); S[mt][i] = pv; ps += pv; }
            }
            if (__any(moved)) {
                const float alpha = __builtin_amdgcn_exp2f(m - mn);
                l *= alpha;
#pragma unroll
                for (int dt = 0; dt < DVW / 32; ++dt)
#pragma unroll
                    for (int i = 0; i < 16; ++i) O[dt][i] *= alpha;
            }
            m = mn;
            l += ps;
#pragma unroll
            for (int mt = 0; mt < KT / 32; ++mt)
#pragma unroll
                for (int s = 0; s < 2; ++s) {
                    const bf16x8 pb = pack8(S[mt][8 * s + 0], S[mt][8 * s + 1], S[mt][8 * s + 2], S[mt][8 * s + 3], S[mt][8 * s + 4], S[mt][8 * s + 5], S[mt][8 * s + 6], S[mt][8 * s + 7]);
#pragma unroll
                    for (int dt = 0; dt < DVW / 32; ++dt) {
                        const LAS unsigned char* vp = vb + (32 * mt + 16 * s + 4 * h + trq) * G::VSTR + (dvoff + 32 * dt + 16 * trblk + 4 * trp) * 2;
                        const s16x4 lo = __builtin_amdgcn_ds_read_tr16_b64_v4i16((LAS s16x4*)vp);
                        const s16x4 hi = __builtin_amdgcn_ds_read_tr16_b64_v4i16((LAS s16x4*)(vp + 8 * G::VSTR));
                        const bf16x8 av = __builtin_shufflevector(lo, hi, 0, 1, 2, 3, 4, 5, 6, 7);
                        O[dt] = FA_MFMA(av, pb, O[dt]);
                    }
                }
        }
        if (kt + 1 < kt_hi) FA_COMMIT(buf ^ 1);
        __syncthreads();
    }
#undef FA_ISSUE
#undef FA_COMMIT
}

__device__ __forceinline__ bf16x8 ld8f(const float* p) { const f32x4 a = *(const f32x4*)p, b = *(const f32x4*)(p + 4); return pack8(a.x, a.y, a.z, a.w, b.x, b.y, b.z, b.w); }

__device__ __forceinline__ int next_unit(unsigned* ctr, volatile LAS unsigned* uw) {
    __syncthreads();
    if (threadIdx.x == 0) *uw = atomicAdd(ctr, 1u);
    __syncthreads();
    return (int)*uw;
}
constexpr int LDS_BIAS = 98304, LDS_UW = 98304 + 1024;

__device__ __forceinline__ void mla_unit(LAS unsigned char* lds, int qb, int bh, const bf16_t* qmla, const bf16_t* kvmb, const bf16_t* krb, const float* rope, float* ycat) {
    const int tid = tid_(), lane = tid & 63, wave = tid >> 6, r = lane & 31, h = lane >> 5;
    {
        const int b = bh / 6, hd = bh % 6;
        const int qw = qb * 256 + wave * 32, qpos = qw + r;
        const bf16_t* qp = qmla + (size_t)(b * SEQ + qpos) * 768 + hd * 96;
        bf16x8 qf[6];
#pragma unroll
        for (int s = 0; s < 4; ++s) qf[s] = *(const bf16x8*)(qp + 16 * s + 8 * h);
        {
            const u32x4 r1 = *(const u32x4*)(qp + 64 + 8 * h), r2 = *(const u32x4*)(qp + 80 + 8 * h);
            const f32x4 x1a = {bflo(r1.x), bfhi(r1.x), bflo(r1.y), bfhi(r1.y)}, x1b = {bflo(r1.z), bfhi(r1.z), bflo(r1.w), bfhi(r1.w)};
            const f32x4 x2a = {bflo(r2.x), bfhi(r2.x), bflo(r2.y), bfhi(r2.y)}, x2b = {bflo(r2.z), bfhi(r2.z), bflo(r2.w), bfhi(r2.w)};
            const float* cs = rope + qpos * 16 + 8 * h; const float* sn = rope + SEQ * 16 + qpos * 16 + 8 * h;
            const f32x4 ca = *(const f32x4*)cs, cb = *(const f32x4*)(cs + 4), sa = *(const f32x4*)sn, sb = *(const f32x4*)(sn + 4);
            qf[4] = pack8(x1a.x * ca.x - x2a.x * sa.x, x1a.y * ca.y - x2a.y * sa.y, x1a.z * ca.z - x2a.z * sa.z, x1a.w * ca.w - x2a.w * sa.w,
                          x1b.x * cb.x - x2b.x * sb.x, x1b.y * cb.y - x2b.y * sb.y, x1b.z * cb.z - x2b.z * sb.z, x1b.w * cb.w - x2b.w * sb.w);
            qf[5] = pack8(x2a.x * ca.x + x1a.x * sa.x, x2a.y * ca.y + x1a.y * sa.y, x2a.z * ca.z + x1a.z * sa.z, x2a.w * ca.w + x1a.w * sa.w,
                          x2b.x * cb.x + x1b.x * sb.x, x2b.y * cb.y + x1b.y * sb.y, x2b.z * cb.z + x1b.z * sb.z, x2b.w * cb.w + x1b.w * sb.w);
        }
        KVSrc src; src.K0 = kvmb + (size_t)b * SEQ * 768 + hd * 128; src.ldk0 = 768; src.K1 = krb + (size_t)b * SEQ * 32; src.ldk1 = 32; src.V = kvmb + (size_t)b * SEQ * 768 + hd * 128 + 64; src.ldv = 768;
        f32x16 O[2];
#pragma unroll
        for (int dt = 0; dt < 2; ++dt)
#pragma unroll
            for (int i = 0; i < 16; ++i) O[dt][i] = 0.f;
        float m = M_INIT, l = 0.f;
        attn_pass<96, 64, 64, 64, 64, MASK_CAUSAL>(lds, src, qf, O, m, l, 0, (qb + 1) * 4, qpos, qw, 0, 0u, nullptr, 0.10206207261596575f * LOG2E);
        const float inv = 1.f / xhalf_sum(l);
        float* op = ycat + (size_t)(b * SEQ + qpos) * D + 256 + hd * 64;
#pragma unroll
        for (int dt = 0; dt < 2; ++dt)
#pragma unroll
            for (int g = 0; g < 4; ++g)
                *(f32x4*)(op + 32 * dt + 8 * g + 4 * h) = (f32x4){O[dt][4 * g] * inv, O[dt][4 * g + 1] * inv, O[dt][4 * g + 2] * inv, O[dt][4 * g + 3] * inv};
    }
}

__device__ __forceinline__ void selwin_unit(LAS unsigned char* lds, int qb, int bh, const float* proj, const bf16_t* nqb, const bf16_t* nkvb, const float* impp, const float* relb, float* ycat) {
    const int tid = tid_(), lane = tid & 63, wave = tid >> 6, r = lane & 31, h = lane >> 5;
    LAS float* biasT = (LAS float*)(lds + LDS_BIAS);
    {
        const int b = bh / 6, hh = bh % 6, g = hh / 3;
        { const int dist = 383 - tid; biasT[tid] = (dist < 0 || dist >= 256) ? NEG_S : relb[t5_bucket(dist > 127 ? 127 : dist) * 6 + hh] * LOG2E; }
        const int qw = qb * 256 + wave * 32, qpos = qw + r;
        const size_t trow = (size_t)(b * SEQ + qpos);
        const bf16_t* qp = nqb + trow * 384 + hh * 64;
        bf16x8 qf[4];
#pragma unroll
        for (int s = 0; s < 4; ++s) qf[s] = *(const bf16x8*)(qp + 16 * s + 8 * h);
        const unsigned selmask = nsa_topk_mask(impp + ((size_t)(b * 6 + g * 3) * 32) * SEQ + qpos, qpos >> 6);
        const bf16_t* kvb = nkvb + (size_t)b * SEQ * 768 + g * 64;
        f32x16 O[2], Os[2];
        float m, l;
        KVSrc src; src.K1 = nullptr; src.ldk1 = 0; src.ldk0 = 768; src.ldv = 768;
#pragma unroll
        for (int dt = 0; dt < 2; ++dt)
#pragma unroll
            for (int i = 0; i < 16; ++i) O[dt][i] = 0.f;
        m = M_INIT; l = 0.f;
        src.K0 = kvb + 2 * 128; src.V = kvb + 3 * 128;
        attn_pass<64, 64, 64, 64, 64, MASK_SEL>(lds, src, qf, O, m, l, 0, (qb + 1) * 4, qpos, qw, 0, selmask, biasT, 0.125f * LOG2E);
        {
            const float gs = sigmoidf_(proj[trow * INLD + O_NG + 6 + hh]) / xhalf_sum(l);
#pragma unroll
            for (int dt = 0; dt < 2; ++dt)
#pragma unroll
                for (int i = 0; i < 16; ++i) { Os[dt][i] = O[dt][i] * gs; O[dt][i] = 0.f; }
        }
        m = M_INIT; l = 0.f;
        src.K0 = kvb + 4 * 128; src.V = kvb + 5 * 128;
        attn_pass<64, 64, 64, 64, 64, MASK_WIN>(lds, src, qf, O, m, l, qb > 0 ? qb * 4 - 4 : 0, (qb + 1) * 4, qpos, qw, 0, 0u, biasT, 0.125f * LOG2E);
        const float gwn = sigmoidf_(proj[trow * INLD + O_NG + 12 + hh]) / xhalf_sum(l);
        float* op = ycat + trow * D + 640 + hh * 64;
#pragma unroll
        for (int dt = 0; dt < 2; ++dt)
#pragma unroll
            for (int gq = 0; gq < 4; ++gq) {
                float* o4 = op + 32 * dt + 8 * gq + 4 * h;
                const f32x4 old = *(const f32x4*)o4;
                *(f32x4*)o4 = (f32x4){old.x + Os[dt][4 * gq] + O[dt][4 * gq] * gwn, old.y + Os[dt][4 * gq + 1] + O[dt][4 * gq + 1] * gwn,
                                      old.z + Os[dt][4 * gq + 2] + O[dt][4 * gq + 2] * gwn, old.w + Os[dt][4 * gq + 3] + O[dt][4 * gq + 3] * gwn};
            }
    }
}

__device__ __forceinline__ void ph_attn_merged(LAS unsigned char* lds, unsigned* ctr, const bf16_t* qmla, const bf16_t* kvmb, const bf16_t* krb, const float* rope,
                                               const float* proj, const bf16_t* nqb, const bf16_t* nkvb, const float* impp, const float* relb, float* ycat) {
    volatile LAS unsigned* uw = (volatile LAS unsigned*)(lds + LDS_UW);
    for (;;) {
        const int u = next_unit(ctr, uw);
        if (u >= 16 * 48) break;
        const int grp = u / 48, bh = u % 48;
        const unsigned code = (unsigned)((0x7654736251430210ull >> (4 * (15 - grp))) & 0xfull);
        const bool is_mla = ((0x0ab7u >> (15 - grp)) & 1u) != 0u;
        if (is_mla) mla_unit(lds, (int)code, bh, qmla, kvmb, krb, rope, ycat);
        else selwin_unit(lds, (int)code, bh, proj, nqb, nkvb, impp, relb, ycat);
    }
}

__device__ __forceinline__ void ph_xattn_mfma(LAS unsigned char* lds, unsigned* ctr, const bf16_t* qx, const bf16_t* kvxb, bf16_t* oxb) {
    const int tid = tid_(), lane = tid & 63, wave = tid >> 6, r = lane & 31, h = lane >> 5;
    volatile LAS unsigned* uw = (volatile LAS unsigned*)(lds + LDS_UW);
    for (;;) {
        const int u = next_unit(ctr, uw);
        if (u >= (T / 128) * 4) break;
        const int hd = u & 3, tt = u >> 2, t0 = tt * 128, b = t0 >> 11;
        const int qw = t0 + (wave & 3) * 32, qrow = qw + r, dvoff = (wave >> 2) * 128;
        const bf16_t* qp = qx + (size_t)qrow * D + hd * 256;
        bf16x8 qf[16];
#pragma unroll
        for (int s = 0; s < 16; ++s) qf[s] = *(const bf16x8*)(qp + 16 * s + 8 * h);
        KVSrc src; src.K0 = kvxb + (size_t)(b * 256) * 2048 + hd * 256; src.ldk0 = 2048; src.K1 = nullptr; src.ldk1 = 0; src.V = src.K0 + 1024; src.ldv = 2048;
        f32x16 O[4];
#pragma unroll
        for (int dt = 0; dt < 4; ++dt)
#pragma unroll
            for (int i = 0; i < 16; ++i) O[dt][i] = 0.f;
        float m = M_INIT, l = 0.f;
        attn_pass<256, 256, 128, 256, 32, MASK_NONE>(lds, src, qf, O, m, l, 0, 8, 0, 0, dvoff, 0u, nullptr, 0.0625f * LOG2E);
        const float inv = 1.f / xhalf_sum(l);
        bf16_t* op = oxb + (size_t)qrow * D + hd * 256 + dvoff;
#pragma unroll
        for (int dt = 0; dt < 4; ++dt)
#pragma unroll
            for (int g = 0; g < 4; ++g)
                *(u32x2*)(op + 32 * dt + 8 * g + 4 * h) = (u32x2){pk_bf16(O[dt][4 * g] * inv, O[dt][4 * g + 1] * inv), pk_bf16(O[dt][4 * g + 2] * inv, O[dt][4 * g + 3] * inv)};
    }
}
}

__device__ __forceinline__ void ph_pe_bias(const Params& p, float* peb) {
    GT_DECL
    const int gwv = (tid >> 6) * (int)gridDim.x + (int)blockIdx.x;
    for (int w = gwv; w < 2 * 2 * 64; w += NW) {
        const int c = w & 63, lj = w >> 6;
        const float* pe = p.in[IN_NPE] + (size_t)lj * 2048; const float* w1 = p.in[IN_NW1] + (size_t)lj * 2048 * 64 + c;
        float acc = 0.f;
        for (int i = 0; i < 32; ++i) { const int k = lane + 64 * i; acc += pe[k] * w1[(size_t)k * 64]; }
        acc = wave_sum(acc);
        if (lane == 0) peb[w] = acc;
    }
}
__device__ __forceinline__ void ph_cmp_mfma(const Params& p, int l, const bf16_t* nkvb, const bf16_t* w1t, const float* peb, bf16_t* kcb, bf16_t* vct, LAS unsigned char* lds) {
    const int tid = tid_(), lane = tid & 63, r = lane & 31, h = lane >> 5, wave = tid >> 6;
    LAS float* red = (LAS float*)lds;
    for (int u = (int)blockIdx.x; u < 128; u += (int)gridDim.x) {
        const int rt = u & 3, g = (u >> 2) & 1, b = (u >> 3) & 7, j = u >> 6;
        const int n = rt * 32 + r, nc = n < NBC ? n : NBC - 1;
        const bf16_t* xrow = nkvb + (size_t)(b * SEQ + nc * 16) * 768 + j * 128 + g * 64;
        const bf16_t* w1 = w1t + (size_t)j * 64 * 2048;
        fa::f32x16 acc[2];
#pragma unroll
        for (int ct = 0; ct < 2; ++ct)
#pragma unroll
            for (int i = 0; i < 16; ++i) acc[ct][i] = 0.f;
#pragma unroll 2
        for (int pp = 0; pp < 4; ++pp) {
            const int pos = wave * 4 + pp;
#pragma unroll
            for (int s4 = 0; s4 < 4; ++s4) {
                const bf16x8_t bfr = *(const bf16x8_t*)(xrow + (size_t)pos * 768 + s4 * 16 + 8 * h);
                const int kk = pos * 64 + s4 * 16 + 8 * h;
#pragma unroll
                for (int ct = 0; ct < 2; ++ct) {
                    const bf16x8_t afr = *(const bf16x8_t*)(w1 + (size_t)(32 * ct + r) * 2048 + kk);
                    acc[ct] = FA_MFMA(afr, bfr, acc[ct]);
                }
            }
        }
        __syncthreads();
#pragma unroll
        for (int ct = 0; ct < 2; ++ct)
#pragma unroll
            for (int i = 0; i < 16; ++i) red[((wave * 2 + ct) * 16 + i) * 64 + lane] = acc[ct][i];
        __syncthreads();
        if (wave != 0) continue;
#pragma unroll 1
        for (int w8 = 1; w8 < 8; ++w8) {
#pragma unroll
            for (int ct = 0; ct < 2; ++ct)
#pragma unroll
                for (int i = 0; i < 16; ++i) acc[ct][i] += red[((w8 * 2 + ct) * 16 + i) * 64 + lane];
        }
        const float* pb = peb + (l * 2 + j) * 64;
#pragma unroll
        for (int ct = 0; ct < 2; ++ct)
#pragma unroll
            for (int g4 = 0; g4 < 4; ++g4) {
                const f32x4 bv = *(const f32x4*)(pb + 32 * ct + 8 * g4 + 4 * h);
                acc[ct][4 * g4 + 0] = gelu_tanh(acc[ct][4 * g4 + 0] + bv.x); acc[ct][4 * g4 + 1] = gelu_tanh(acc[ct][4 * g4 + 1] + bv.y);
                acc[ct][4 * g4 + 2] = gelu_tanh(acc[ct][4 * g4 + 2] + bv.z); acc[ct][4 * g4 + 3] = gelu_tanh(acc[ct][4 * g4 + 3] + bv.w);
            }
        const float* w2 = p.in[IN_NW2] + (size_t)(l * 2 + j) * 64 * 64;
        fa::f32x16 o[2];
#pragma unroll
        for (int ct = 0; ct < 2; ++ct)
#pragma unroll
            for (int i = 0; i < 16; ++i) o[ct][i] = 0.f;
#pragma unroll
        for (int ct = 0; ct < 2; ++ct)
#pragma unroll
            for (int s = 0; s < 2; ++s) {
                const bf16x8_t pbk = pack8f(acc[ct][8 * s + 0], acc[ct][8 * s + 1], acc[ct][8 * s + 2], acc[ct][8 * s + 3], acc[ct][8 * s + 4], acc[ct][8 * s + 5], acc[ct][8 * s + 6], acc[ct][8 * s + 7]);
#pragma unroll
                for (int ct2 = 0; ct2 < 2; ++ct2) {
                    const float* wp = w2 + (size_t)(32 * ct + 16 * s + 4 * h) * 64 + 32 * ct2 + r;
                    const bf16x8_t afr = pack8f(wp[0], wp[64], wp[128], wp[192], wp[512], wp[576], wp[640], wp[704]);
                    o[ct2] = FA_MFMA(afr, pbk, o[ct2]);
                }
            }
        const bool valid = n < NBC;
        if (j == 0) {
            bf16_t* kr = kcb + ((size_t)(b * 2 + g) * 128 + n) * 64;
#pragma unroll
            for (int ct2 = 0; ct2 < 2; ++ct2)
#pragma unroll
                for (int g4 = 0; g4 < 4; ++g4)
                    *(u32x2*)(kr + 32 * ct2 + 8 * g4 + 4 * h) = valid ? (u32x2){pk_bf16(o[ct2][4 * g4], o[ct2][4 * g4 + 1]), pk_bf16(o[ct2][4 * g4 + 2], o[ct2][4 * g4 + 3])} : (u32x2){0u, 0u};
        } else {
            bf16_t* vc = vct + (size_t)(b * 2 + g) * 64 * 128 + n;
#pragma unroll
            for (int ct2 = 0; ct2 < 2; ++ct2)
#pragma unroll
                for (int i = 0; i < 16; ++i) vc[(size_t)(32 * ct2 + (i & 3) + 8 * (i >> 2) + 4 * h) * 128] = valid ? f2bf(o[ct2][i]) : (bf16_t)0;
        }
    }
}
constexpr int LDS_CBIAS = 135168;
__device__ __forceinline__ void ph_nsa_cmp_mfma(const Params& p, const float* proj, const bf16_t* nqb, const bf16_t* kcb, const bf16_t* vct, float* impp, float* ycat, LAS unsigned char* lds) {
    const int tid = tid_(), lane = tid & 63, wave = tid >> 6;
    const int r = lane & 31, h = lane >> 5;
    LAS float* bt = (LAS float*)(lds + LDS_CBIAS);
    constexpr int KS = 144, VS = 264;
    LAS unsigned char* kl = lds;
    LAS unsigned char* vl = lds + 18432;
    for (int i = tid; i < 768; i += NTHR) bt[i] = p.in[IN_RELB][t5_bucket(i & 127) * 6 + (i >> 7)] * fa::LOG2E;
    for (int bu = (int)((blockIdx.x + 64u) % gridDim.x); bu < NB * 6 * 8; bu += (int)gridDim.x) {
        const int q8 = bu & 7, bh = bu >> 3, hh = bh % 6, b = bh / 6, g = hh / 3;
        __syncthreads();
        {
            const bf16_t* ksrc = kcb + (size_t)(b * 2 + g) * 128 * 64; const bf16_t* vsrc = vct + (size_t)(b * 2 + g) * 64 * 128;
#pragma unroll
            for (int i = 0; i < 2; ++i) { const int c = tid + 512 * i, row = c >> 3, cc = c & 7;
                *(LAS u32x4*)(kl + row * KS + cc * 16) = *(const u32x4*)(ksrc + (size_t)row * 64 + cc * 8); }
#pragma unroll
            for (int i = 0; i < 2; ++i) { const int c = tid + 512 * i, row = c >> 4, cc = c & 15;
                *(LAS u32x4*)(vl + row * VS + cc * 16) = *(const u32x4*)(vsrc + (size_t)row * 128 + cc * 8); }
        }
        const int qg = q8 * 8 + wave;
        const int s = qg * 32 + r; const size_t t = (size_t)b * SEQ + s;
        const bf16_t* qp = nqb + t * 384 + hh * 64;
        bf16x8_t qf[4];
#pragma unroll
        for (int ks = 0; ks < 4; ++ks) qf[ks] = *(const bf16x8_t*)(qp + 16 * ks + 8 * h);
        const float gate_logit = proj[t * INLD + O_NG + hh];
        __syncthreads();
        fa::f32x16 S[4];
#pragma unroll
        for (int mt = 0; mt < 4; ++mt) {
#pragma unroll
            for (int i = 0; i < 16; ++i) S[mt][i] = 0.f;
#pragma unroll
            for (int ks = 0; ks < 4; ++ks) {
                const bf16x8_t a = *(const LAS bf16x8_t*)(kl + (32 * mt + r) * KS + (2 * ks + h) * 16);
                S[mt] = FA_MFMA(a, qf[ks], S[mt]);
            }
        }
        const LAS float* bth = bt + hh * 128;
        const int qrel = s - 31 - 64 * h;
        float tmax = fa::NEG_S;
#pragma unroll
        for (int mt = 0; mt < 4; ++mt)
#pragma unroll
            for (int i = 0; i < 16; ++i) {
                const int dist = qrel - 16 * (32 * mt + (i & 3) + 8 * (i >> 2));
                const int di = dist < 0 ? 0 : (dist > 127 ? 127 : dist);
                const float v = dist >= 0 ? S[mt][i] * (0.125f * fa::LOG2E) + bth[di] : fa::NEG_S;
                S[mt][i] = v; tmax = fmaxf(tmax, v);
            }
        tmax = xhalf_max(tmax);
        const float mx = fmaxf(tmax, fa::M_INIT);
        float ps = 0.f;
#pragma unroll
        for (int mt = 0; mt < 4; ++mt)
#pragma unroll
            for (int i = 0; i < 16; ++i) { const float pv = __builtin_amdgcn_exp2f(S[mt][i] - mx); S[mt][i] = pv; ps += pv; }
        ps = xhalf_sum(ps);
        const float inv = ps > 0.f ? 1.f / ps : 0.f;
        {
            float own[16]; float prev = 0.f;
#pragma unroll
            for (int mt = 0; mt < 4; ++mt)
#pragma unroll
                for (int g4 = 0; g4 < 4; ++g4) {
                    const float qs = (S[mt][4 * g4] + S[mt][4 * g4 + 1]) + (S[mt][4 * g4 + 2] + S[mt][4 * g4 + 3]);
                    const auto sw = __builtin_amdgcn_permlane32_swap(__float_as_uint(S[mt][4 * g4 + 3]), __float_as_uint(S[mt][4 * g4 + 3]), false, false);
                    const float rl = __uint_as_float(h ? sw[0] : sw[1]);
                    const float extra = h ? rl : prev;
                    prev = rl;
                    own[4 * mt + g4] = (qs + extra) * inv;
                }
            float* ip = impp + ((size_t)(b * 6 + hh) * 32) * SEQ + s;
#pragma unroll
            for (int j = 0; j < 16; ++j) ip[(size_t)(2 * j + h) * SEQ] = own[j];
        }
        fa::f32x16 O[2];
#pragma unroll
        for (int dt = 0; dt < 2; ++dt)
#pragma unroll
            for (int i = 0; i < 16; ++i) O[dt][i] = 0.f;
#pragma unroll
        for (int mt = 0; mt < 4; ++mt)
#pragma unroll
            for (int s2 = 0; s2 < 2; ++s2) {
                const bf16x8_t pbk = pack8f(S[mt][8 * s2 + 0], S[mt][8 * s2 + 1], S[mt][8 * s2 + 2], S[mt][8 * s2 + 3], S[mt][8 * s2 + 4], S[mt][8 * s2 + 5], S[mt][8 * s2 + 6], S[mt][8 * s2 + 7]);
#pragma unroll
                for (int dt = 0; dt < 2; ++dt) {
                    const LAS unsigned char* vp = vl + (32 * dt + r) * VS + (32 * mt + 16 * s2 + 4 * h) * 2;
                    const u32x2 lo = *(const LAS u32x2*)vp, hi = *(const LAS u32x2*)(vp + 16);
                    const u32x4 av = {lo.x, lo.y, hi.x, hi.y};
                    O[dt] = FA_MFMA(__builtin_bit_cast(bf16x8_t, av), pbk, O[dt]);
                }
            }
        const float gate = sigmoidf_(gate_logit) * inv;
        float* op = ycat + t * D + 640 + hh * 64;
#pragma unroll
        for (int dt = 0; dt < 2; ++dt)
#pragma unroll
            for (int g4 = 0; g4 < 4; ++g4)
                *(f32x4*)(op + 32 * dt + 8 * g4 + 4 * h) = (f32x4){O[dt][4 * g4] * gate, O[dt][4 * g4 + 1] * gate, O[dt][4 * g4 + 2] * gate, O[dt][4 * g4 + 3] * gate};
    }
    __syncthreads();
}

__device__ __forceinline__ void cvt_layer(const Params& p, int l, int which, CvtCursor& cur, bf16_t* WB, LAS float* scr, int gwv, int nwv, int lane) {
    bf16_t* wl = WB + (size_t)l * WL_SIZE;
    if (which != 2) cvt_matrix<true>(cur, p.in[IN_XWKV] + (size_t)l * D * 2048, D, 2048, wl + WL_XWKV, D, 2048, 0, scr, gwv, nwv, lane);
    if (which == 1) return;
    cvt_matrix<false>(cur, p.in[IN_WIN] + (size_t)l * D * INC, D, INC, wl + WL_WIN, D, 1792, 0, scr, gwv, nwv, lane, l ? p.in[IN_MIXN] + D : nullptr);
    cvt_matrix<true>(cur, p.in[IN_MWUQ] + (size_t)l * 192 * 576, 192, 576, wl + WL_WUQ, 256, 768, 0, scr, gwv, nwv, lane);
    cvt_matrix<true>(cur, p.in[IN_MWUKV] + (size_t)l * 128 * 768, 128, 768, wl + WL_WUKV, 256, 768, 0, scr, gwv, nwv, lane);
    cvt_matrix<true>(cur, p.in[IN_SGLU] + (size_t)l * 256 * 256, 256, 256, wl + WL_WGLU, 256, 256, 0, scr, gwv, nwv, lane);
    cvt_matrix<true>(cur, p.in[IN_WOUT] + (size_t)l * D * D, D, D, wl + WL_WOUT, D, D, 0, scr, gwv, nwv, lane);
    cvt_matrix<true>(cur, p.in[IN_XWQ] + (size_t)l * D * D, D, D, wl + WL_XWQ, D, D, 0, scr, gwv, nwv, lane, p.in[IN_XN] + (size_t)l * D);
    cvt_matrix<true>(cur, p.in[IN_XWO] + (size_t)l * D * D, D, D, wl + WL_XWO, D, D, 0, scr, gwv, nwv, lane);
    cvt_matrix<true>(cur, p.in[IN_NW1] + (size_t)(l * 2) * 2048 * 64, 2048, 64, wl + WL_CW1, 2048, 64, 0, scr, gwv, nwv, lane);
    cvt_matrix<true>(cur, p.in[IN_NW1] + (size_t)(l * 2 + 1) * 2048 * 64, 2048, 64, wl + WL_CW1 + 64 * 2048, 2048, 64, 0, scr, gwv, nwv, lane);
}
__device__ __forceinline__ void ph_convert_small(const Params& p, bf16_t* WB, LAS unsigned char* lds) {
    GT_DECL
    LAS float* scr = (LAS float*)(lds + (tid >> 6) * 16384);
    CvtCursor cur{0};
    cvt_layer(p, 0, 0, cur, WB, scr, gw, NW, lane);
    cvt_layer(p, 1, 1, cur, WB, scr, gw, NW, lane);
    cvt_matrix<true>(cur, p.in[IN_DWG], D, FFD, WB + WD_GU, D, FFD, 1, scr, gw, NW, lane, p.in[IN_FFN]);
    cvt_matrix<true>(cur, p.in[IN_DWU], D, FFD, WB + WD_GU, D, FFD, 2, scr, gw, NW, lane, p.in[IN_FFN]);
    cvt_matrix<true>(cur, p.in[IN_DWD], FFD, D, WB + WD_DN, FFD, D, 0, scr, gw, NW, lane);
}
__device__ __forceinline__ void ph_convert_l1(const Params& p, bf16_t* WB, LAS unsigned char* lds) {
    const int half = (int)gridDim.x / 2;
    if ((int)blockIdx.x < half) return;
    const int tid = tid_(), lane = tid & 63;
    LAS float* scr = (LAS float*)(lds + (tid >> 6) * 16384);
    CvtCursor cur{0};
    cvt_layer(p, 1, 2, cur, WB, scr, ((int)blockIdx.x - half) * (NTHR / 64) + (tid >> 6), ((int)gridDim.x - half) * (NTHR / 64), lane);
}
__device__ __forceinline__ void ph_convert_moe(const Params& p, bf16_t* MW, LAS unsigned char* lds, int e_lo, int e_hi, bool skip0) {
    const int tid = tid_(), lane = tid & 63;
    if (skip0 && blockIdx.x == 0) return;
    const int gwv = ((int)blockIdx.x - (skip0 ? 1 : 0)) * (NTHR / 64) + (tid >> 6), nwv = ((int)gridDim.x - (skip0 ? 1 : 0)) * (NTHR / 64);
    LAS float* scr = (LAS float*)(lds + (tid >> 6) * 16384);
    CvtCursor cur{0};
    for (int e = e_lo; e < e_hi; ++e) {
        bf16_t* we = MW + (size_t)e * ME_SIZE;
        cvt_matrix<true>(cur, p.in[IN_MWG] + (size_t)e * D * FFE, D, FFE, we + ME_GU, D, FFE, 1, scr, gwv, nwv, lane);
        cvt_matrix<true>(cur, p.in[IN_MWU] + (size_t)e * D * FFE, D, FFE, we + ME_GU, D, FFE, 2, scr, gwv, nwv, lane);
        cvt_matrix<true>(cur, p.in[IN_MWD] + (size_t)e * FFE * D, FFE, D, we + ME_DN, FFE, D, 0, scr, gwv, nwv, lane);
    }
}

constexpr int LDS_BYTES = 147456;
constexpr int LDS_MISC = 131072;
enum { P_PRO = 0, P_PROJ0, L0_BASE, L0_GU = L0_BASE + 8, L0_DN, L1_PROJ, L1_BASE, L1_ROUTE = L1_BASE + 8, L1_SORT, M_BASE, P_FINAL = M_BASE + 2 * MOE_NR, NPHASE };

__global__ void __launch_bounds__(NTHR, 2) fwd_kernel(Params p) {
    extern __shared__ __attribute__((aligned(16))) unsigned char lds_raw[];
    LAS unsigned char* lds = (LAS unsigned char*)lds_raw;
    volatile LAS unsigned* misc = (volatile LAS unsigned*)(lds + LDS_MISC);
    if (threadIdx.x < 64) misc[threadIdx.x] = 0u;
    __syncthreads();
    unsigned char* ws = p.ws;
    unsigned* ctl = (unsigned*)(ws + WS_CTL);
    XcdBarrier bar; bar.bar = ctl + 4096; bar.x = 0; bar.st = nullptr;
    const int lo = p.ph_lo, hi = p.ph_hi;
    if (hi - lo > 1) bar = xcd_barrier_post(ctl + 4096, misc + 8);
#define PH(k) if (lo <= (k) && (k) < hi)
#define ENDPH(k) if ((k) + 1 < hi) xcd_barrier(bar);

    bf16_t* HB = (bf16_t*)(ws + WS_H);
    bf16_t* XNB = (bf16_t*)(ws + WS_XNB);
    bf16_t* CQNB = (bf16_t*)(ws + XB_CQN);
    bf16_t* CKVNB = (bf16_t*)(ws + XB_CKVN);
    bf16_t* YPREB = (bf16_t*)(ws + XB_YPRE);
    bf16_t* YCATB = (bf16_t*)(ws + WS_XNB);
    bf16_t* KVXB = (bf16_t*)(ws + WS_KVX);
    float* PROJ = (float*)(ws + BG_PROJ);
    bf16_t* NKVB = (bf16_t*)(ws + BG_NKVB);
    bf16_t* QMB = (bf16_t*)(ws + BG_QMLA);
    bf16_t* NQB = (bf16_t*)(ws + BG_NQB);
    bf16_t* KVMB = (bf16_t*)(ws + BG_KVMB);
    bf16_t* KRB = (bf16_t*)(ws + BG_KRB);
    float* YCAT = (float*)(ws + BG_YCAT);
    bf16_t* MEMNB = (bf16_t*)(ws + BG_MEMN);
    bf16_t* QXB = (bf16_t*)(ws + BG_QX);
    bf16_t* OXB = (bf16_t*)(ws + BG_OX);
    bf16_t* ACTB = (bf16_t*)(ws + BG_ACT);
    bf16_t* MACTB = (bf16_t*)(ws + MOE_ACT);
    bf16_t* YSB = (bf16_t*)(ws + MOE_YS);
    float* YS2P = (float*)(ws + MOE_YS2P);
    float* IMPP = (float*)(ws + SM_IMPP);
    float* ROPE = (float*)(ws + SM_ROPE);
    f32x2* SSME = (f32x2*)(ws + SM_SSME);
    bf16_t* KCB = (bf16_t*)(ws + SM_KC);
    bf16_t* VCT = (bf16_t*)(ws + SM_KC + 512 * 1024);
    float* PEB = (float*)(ws + SM_HID);
    unsigned* SEL = (unsigned*)(ws + SM_SEL);
    int* TOPI = (int*)(ws + SM_TOPI);
    float* TOPW = (float*)(ws + SM_TOPW);
    int* POS = (int*)(ws + SM_POS);
    int* RSRC = (int*)(ws + SM_RSRC);
    int* TEXP = (int*)(ws + SM_TEXP);
    bf16_t* WB = (bf16_t*)(ws + WS_WBS);
    bf16_t* MW = (bf16_t*)(ws + MOE_W);
#define QCTR(k) (ctl + 8192 + 64 * (k))
#define PG8_RUN_ROT(ROT, EPI_T, GATH, Aptr, Btptr, Kval, ridx, texp_, estr, nM_, nN_, pm0_, ...) do { \
    pg8::Gemm g_{Aptr, Btptr, Kval, ridx, texp_, estr}; pg8::StaticOrder S_; S_.init(nM_, nN_, (int)gridDim.x, (int)((blockIdx.x + gridDim.x - (ROT)) % gridDim.x), pm0_); \
    EPI_T E_{__VA_ARGS__}; pg8::gemm_phase<EPI_T, GATH>(lds, g_, S_, E_); } while (0)
#define PG8_RUN(...) PG8_RUN_ROT(0, __VA_ARGS__)
#define PG8_RUN_SPLITK(EPI_T, Aptr, Btptr, Kslice, ld_, nks_, texp_, estr, nM_, nNr_, pm0_, ...) do { \
    pg8::Gemm g_{Aptr, Btptr, Kslice, nullptr, texp_, estr, ld_, nks_, nNr_}; pg8::StaticOrder S_; S_.init(nM_, (nNr_) * (nks_), (int)gridDim.x, (int)blockIdx.x, pm0_); \
    EPI_T E_{__VA_ARGS__}; pg8::gemm_phase<EPI_T, false>(lds, g_, S_, E_); } while (0)

    float* SSQ = (float*)(ws + SM_KROPE);
    PH(P_PRO) {
        ph_rope_table(ROPE);
        ph_pe_bias(p, PEB);
        ph_rms(p.in[IN_MEM], p.in[IN_MEMN], MEMNB, NB * 256);
        ph_rms(p.in[IN_MEM], p.in[IN_MEMN] + D, MEMNB + (size_t)NB * 256 * D, NB * 256);
        ph_rms(p.in[IN_X], p.in[IN_MIXN], XNB, T);
        ph_convert_small(p, WB, lds);
        ENDPH(P_PRO)
    }
    PH(P_PROJ0) {
        PG8_RUN(pg8::EpiProj, false, XNB, WB + WL_WIN, D, nullptr, nullptr, 0, 64, 7, 0, PROJ, INLD, NKVB, nullptr, NQB);
        PG8_RUN_ROT(192, pg8::EpiBf16, false, MEMNB, WB + WL_XWKV, D, nullptr, nullptr, 0, 8, 8, 0, KVXB, 2048);
        ENDPH(P_PROJ0)
    }
#define LAYER_BODY(l, B0, HIN, XO_EPI, EXTRA_XQ) \
    PH(B0 + 0) { ph_mla_prep(PROJ, p.in[IN_MQN] + (l) * 192, p.in[IN_MKVN] + (l) * 128, ROPE, CQNB, CKVNB, KRB); ph_ssm1(p, l, PROJ, SSME, lds); ph_cmp_mfma(p, l, NKVB, WB + (size_t)(l) * WL_SIZE + WL_CW1, PEB, KCB, VCT, lds); ENDPH(B0 + 0) } \
    PH(B0 + 1) { PG8_RUN(pg8::EpiBf16, false, CQNB, WB + (size_t)(l) * WL_SIZE + WL_WUQ, 256, nullptr, nullptr, 0, 64, 3, 0, QMB, 768); \
                 PG8_RUN_ROT(64, pg8::EpiBf16, false, CKVNB, WB + (size_t)(l) * WL_SIZE + WL_WUKV, 256, nullptr, nullptr, 0, 64, 3, 0, KVMB, 768); \
                 ph_nsa_cmp_mfma(p, PROJ, NQB, KCB, VCT, IMPP, YCAT, lds); ph_ssm2(p, l, PROJ, SSME, YPREB, lds); ENDPH(B0 + 1) } \
    PH(B0 + 2) { PG8_RUN(pg8::EpiGlu, false, YPREB, WB + (size_t)(l) * WL_SIZE + WL_WGLU, 256, nullptr, nullptr, 0, 64, 1, 0, YCAT, D, YPREB); KVX1_HERE \
                 fa::ph_attn_merged(lds, QCTR(3 * (l)), QMB, KVMB, KRB, ROPE, PROJ, NQB, NKVB, IMPP, p.in[IN_RELB], YCAT); ENDPH(B0 + 2) } \
    PH(B0 + 3) { ph_group_norm(YCAT, p.in[IN_OUTN] + (l) * D, YCATB); ENDPH(B0 + 3) } \
    PH(B0 + 4) { PG8_RUN(pg8::EpiResNorm, false, YCATB, WB + (size_t)(l) * WL_SIZE + WL_WOUT, D, nullptr, nullptr, 0, 64, 4, 0, HB, HIN, D, SSQ); ENDPH(B0 + 4) } \
    PH(B0 + 5) { PG8_RUN(pg8::EpiBf16, false, HB, WB + (size_t)(l) * WL_SIZE + WL_XWQ, D, nullptr, nullptr, 0, 64, 4, 0, QXB, D, SSQ); EXTRA_XQ ENDPH(B0 + 5) } \
    PH(B0 + 6) { fa::ph_xattn_mfma(lds, QCTR(3 * (l) + 2), QXB, KVXB + (size_t)(l) * 2048 * 2048, OXB); ENDPH(B0 + 6) } \
    PH(B0 + 7) { XO_EPI ENDPH(B0 + 7) }

#define KVX1_HERE PG8_RUN_ROT(64, pg8::EpiBf16, false, MEMNB + (size_t)NB * 256 * D, WB + WL_SIZE + WL_XWKV, D, nullptr, nullptr, 0, 8, 8, 0, KVXB + (size_t)2048 * 2048, 2048);
    LAYER_BODY(0, L0_BASE, p.in[IN_X], PG8_RUN(pg8::EpiResNorm, false, OXB, WB + WL_XWO, D, nullptr, nullptr, 0, 64, 4, 0, HB, nullptr, D, SSQ);, )
    PH(L0_GU) { PG8_RUN(pg8::EpiSwiglu, false, HB, WB + WD_GU, D, nullptr, nullptr, 0, 64, 22, 0, ACTB, FFD, 0, SSQ); ph_convert_l1(p, WB, lds); ENDPH(L0_GU) }
    PH(L0_DN) { PG8_RUN(pg8::EpiResNorm, false, ACTB, WB + WD_DN, FFD, nullptr, nullptr, 0, 64, 4, 0, HB, nullptr, D, SSQ); ENDPH(L0_DN) }
    PH(L1_PROJ) { PG8_RUN(pg8::EpiProj, false, HB, WB + WL_SIZE + WL_WIN, D, nullptr, nullptr, 0, 64, 7, 0, PROJ, INLD, NKVB, SSQ, NQB); ENDPH(L1_PROJ) }
#undef KVX1_HERE
#define KVX1_HERE
    LAYER_BODY(1, L1_BASE, nullptr, PG8_RUN(pg8::EpiResNorm, false, OXB, WB + WL_SIZE + WL_XWO, D, nullptr, nullptr, 0, 64, 4, 0, HB, nullptr, D, nullptr);, ph_convert_moe(p, MW, lds, 0, 6, false);)
    PH(L1_ROUTE) { ph_moe_route(HB, p.in[IN_FFN] + D, p.in[IN_ROUTER], XNB, TOPI, TOPW); ENDPH(L1_ROUTE) }
    PH(L1_SORT) { ph_moe_sort((LAS int*)lds, TOPI, POS, RSRC, TEXP); ph_convert_moe(p, MW, lds, 6, NE, true); ENDPH(L1_SORT) }
#define MOE_ROUND(r) \
    PH(M_BASE + 2 * (r)) { const int ntl_ = TEXP[160] - (r) * MOE_RT; const int nm_ = ntl_ < 0 ? 0 : (ntl_ > MOE_RT ? MOE_RT : ntl_); \
        PG8_RUN(pg8::EpiSwiglu, true, XNB, MW + ME_GU, D, RSRC, TEXP, ME_SIZE, nm_, 28, (r) * MOE_RT, MACTB, FFE, (r) * MOE_RT * 256, nullptr); ENDPH(M_BASE + 2 * (r)) } \
    PH(M_BASE + 1 + 2 * (r)) { const int ntl_ = TEXP[160] - (r) * MOE_RT; const int nm_ = ntl_ < 0 ? 0 : (ntl_ > MOE_RT ? MOE_RT : ntl_); \
        PG8_RUN(pg8::EpiBf16, false, MACTB - (size_t)(r) * MOE_RT * 256 * FFE, MW + ME_DN, FFE, nullptr, TEXP, ME_SIZE, nm_, 4, (r) * MOE_RT, YSB, D); ENDPH(M_BASE + 1 + 2 * (r)) }
    MOE_ROUND(0) MOE_ROUND(1)
    PH(M_BASE + 4) { const int ntl_ = TEXP[160] - 2 * MOE_RT; const int nm_ = ntl_ < 0 ? 0 : (ntl_ > MOE_RT ? MOE_RT : ntl_);
        PG8_RUN(pg8::EpiSwiglu, true, XNB, MW + ME_GU, D, RSRC, TEXP, ME_SIZE, nm_, 28, 2 * MOE_RT, MACTB, FFE, 2 * MOE_RT * 256, nullptr); ENDPH(M_BASE + 4) }
    PH(M_BASE + 5) { const int ntl_ = TEXP[160] - 2 * MOE_RT; const int nm_ = ntl_ < 0 ? 0 : (ntl_ > MOE_RT ? MOE_RT : ntl_);
        PG8_RUN_SPLITK(pg8::EpiF32Slab, MACTB - (size_t)2 * MOE_RT * 256 * FFE, MW + ME_DN, FFE / 4, FFE, 4, TEXP, ME_SIZE, nm_, 4, 2 * MOE_RT, YS2P, D, (size_t)2048 * D, 2 * MOE_RT * 256); ENDPH(M_BASE + 5) }
    PH(P_FINAL) { ph_moe_combine_final(HB, YSB, YS2P, POS, TOPW, p.in[IN_FINAL], p.out); }
}

extern "C" void kernel_launch(void* const* d_in, const int* in_sizes, int n_in, void* d_out, int out_size, void* d_ws, size_t ws_size, hipStream_t stream) {
    static int grid = 0;
    if (grid == 0) {
        if (n_in != 37 || out_size != T * D || ws_size < WS_END) { fprintf(stderr, "kernel_launch: unexpected shapes: n_in %d out %d ws %zu (need %zu)\n", n_in, out_size, ws_size, (size_t)WS_END); grid = -1; return; }
        int dev = 0, cus = 0;
        if (hipGetDevice(&dev) != hipSuccess || hipDeviceGetAttribute(&cus, hipDeviceAttributeMultiprocessorCount, dev) != hipSuccess) { grid = -1; return; }
        if (hipFuncSetAttribute((const void*)fwd_kernel, hipFuncAttributeMaxDynamicSharedMemorySize, LDS_BYTES) != hipSuccess) { fprintf(stderr, "kernel_launch: hipFuncSetAttribute failed\n"); grid = -1; return; }
        int per_cu = 0;
        if (hipOccupancyMaxActiveBlocksPerMultiprocessor(&per_cu, (const void*)fwd_kernel, NTHR, LDS_BYTES) != hipSuccess || per_cu < 1) fprintf(stderr, "kernel_launch: occupancy query says %d\n", per_cu);
        (void)hipGetLastError();
        grid = cus;
    }
    if (grid < 0) return;
    (void)hipMemsetAsync((char*)d_ws + WS_CTL, 0, CTL_BYTES, stream);
    Params p{};
    for (int i = 0; i < 37; ++i) p.in[i] = (const float*)d_in[i];
    p.out = (float*)d_out; p.ws = (unsigned char*)d_ws;
#if MK_ONE_LAUNCH
    p.ph_lo = 0; p.ph_hi = NPHASE;
    hipLaunchKernelGGL(fwd_kernel, dim3(grid), dim3(NTHR), LDS_BYTES, stream, p);
#else
    for (int k = 0; k < NPHASE; ++k) { p.ph_lo = k; p.ph_hi = k + 1; hipLaunchKernelGGL(fwd_kernel, dim3(grid), dim3(NTHR), LDS_BYTES, stream, p); }
#endif
}
```

```cpp
#include <hip/hip_runtime.h>
#include <cstdio>
#include <cstdint>

#ifndef MK_ONE_LAUNCH
#define MK_ONE_LAUNCH 1
#endif

#define LAS __attribute__((address_space(3)))
typedef float f32x4 __attribute__((ext_vector_type(4)));
typedef float f32x2 __attribute__((ext_vector_type(2)));
typedef unsigned short bf16_t;
typedef unsigned u32x2 __attribute__((ext_vector_type(2)));
typedef unsigned u32x4 __attribute__((ext_vector_type(4)));
typedef __bf16 bf16v2_t __attribute__((ext_vector_type(2)));
__device__ __forceinline__ unsigned pk_bf16(float lo, float hi) { const f32x2 v = {lo, hi}; return __builtin_bit_cast(unsigned, __builtin_convertvector(v, bf16v2_t)); }
__device__ __forceinline__ bf16_t f2bf(float f) { return (bf16_t)(pk_bf16(f, 0.f) & 0xffffu); }
__device__ __forceinline__ float bf2f(bf16_t b) { return __uint_as_float(((unsigned)b) << 16); }
__device__ __forceinline__ float bflo(unsigned u) { return __uint_as_float(u << 16); }
__device__ __forceinline__ float bfhi(unsigned u) { return __uint_as_float(u & 0xffff0000u); }
typedef short bf16x8_t __attribute__((ext_vector_type(8)));
typedef __bf16 bfv8_t __attribute__((ext_vector_type(8)));
typedef float f32x8_t __attribute__((ext_vector_type(8)));
__device__ __forceinline__ bf16x8_t pack8f(float a0, float a1, float a2, float a3, float a4, float a5, float a6, float a7) {
    const f32x8_t v = {a0, a1, a2, a3, a4, a5, a6, a7};
    return __builtin_bit_cast(bf16x8_t, __builtin_convertvector(v, bfv8_t));
}
__device__ __forceinline__ float xhalf_max(float x) { const auto r = __builtin_amdgcn_permlane32_swap(__float_as_uint(x), __float_as_uint(x), false, false); return fmaxf(__uint_as_float(r[0]), __uint_as_float(r[1])); }
__device__ __forceinline__ float xhalf_sum(float x) { const auto r = __builtin_amdgcn_permlane32_swap(__float_as_uint(x), __float_as_uint(x), false, false); return __uint_as_float(r[0]) + __uint_as_float(r[1]); }
__device__ __forceinline__ int tid_() { int t = threadIdx.x; asm volatile("" : "+v"(t)); return t; }

constexpr int NB = 8, SEQ = 2048, T = NB * SEQ, D = 1024;
constexpr int INC = 1778, INLD = 1792;
constexpr int O_U = 0, O_CQ = 256, O_CKV = 448, O_KR = 576, O_NQ = 608, O_NKV = 992, O_NG = 1760;
constexpr int NBC = 127;
constexpr int FFD = 2816, FFE = 3584, NE = 8;
constexpr int MOE_ROWS = 2 * T + NE * 256;
constexpr int MOE_TILES = MOE_ROWS / 256;
constexpr int MOE_NR = 3, MOE_RT = 64;
constexpr float EPS = 1e-6f;
constexpr int NTHR = 512;

constexpr size_t MiB = 1u << 20;
constexpr size_t WS_CTL = 0, CTL_BYTES = 1 * MiB;
constexpr size_t WS_SMALL = 1 * MiB;
constexpr size_t SM_ROPE = WS_SMALL;
constexpr size_t SM_SSME = SM_ROPE + 256 * 1024;
constexpr size_t SM_KC = SM_SSME + 2 * MiB;
constexpr size_t SM_HID = SM_KC + 2 * MiB;
constexpr size_t SM_SEL = SM_HID + 2 * MiB;
constexpr size_t SM_TOPI = SM_SEL + 256 * 1024;
constexpr size_t SM_TOPW = SM_TOPI + 256 * 1024;
constexpr size_t SM_POS = SM_TOPW + 256 * 1024;
constexpr size_t SM_RSRC = SM_POS + 256 * 1024;
constexpr size_t SM_TEXP = SM_RSRC + 256 * 1024;
constexpr size_t SM_KROPE = SM_TEXP + 256 * 1024;
constexpr size_t SM_IMPP = SM_KROPE + 2 * MiB;
static_assert(SM_IMPP + 12 * MiB <= 25 * MiB, "small region");
constexpr size_t WS_H = 25 * MiB;
constexpr size_t WS_XNB = 89 * MiB;
constexpr size_t XB_CQN = WS_XNB, XB_CKVN = WS_XNB + 8 * MiB, XB_YPRE = WS_XNB + 16 * MiB;
constexpr size_t WS_WBS = 121 * MiB;
constexpr size_t WS_KVX = 169 * MiB;
constexpr size_t WS_R = 201 * MiB;
constexpr size_t BG_PROJ = WS_R, BG_NKVB = WS_R + 112 * MiB, BG_QMLA = WS_R + 136 * MiB, BG_NQB = WS_R + 160 * MiB, BG_KVMB = WS_R + 184 * MiB, BG_YCAT = WS_R + 208 * MiB, BG_KRB = WS_R + 272 * MiB;
constexpr size_t BG_MEMN = WS_R + 275 * MiB;
constexpr size_t BG_QX = WS_R, BG_OX = WS_R + 64 * MiB;
constexpr size_t BG_ACT = WS_R;
constexpr size_t MOE_ACT = 121 * MiB;
constexpr size_t MOE_YS = 233 * MiB;
constexpr size_t MOE_YS2P = 297 * MiB;
constexpr size_t MOE_W = 331 * MiB;
constexpr size_t WS_END = 499 * MiB;

constexpr size_t WL_WIN = 0, WL_WUQ = WL_WIN + (size_t)1792 * 1024, WL_WUKV = WL_WUQ + 768 * 256, WL_WGLU = WL_WUKV + 768 * 256, WL_WOUT = WL_WGLU + 256 * 256,
                 WL_XWQ = WL_WOUT + 1024 * 1024, WL_XWKV = WL_XWQ + 1024 * 1024, WL_XWO = WL_XWKV + 2048 * 1024, WL_CW1 = WL_XWO + 1024 * 1024, WL_SIZE = WL_CW1 + 2 * 64 * 2048;
constexpr size_t WD_GU = 2 * WL_SIZE, WD_DN = WD_GU + (size_t)5632 * 1024, W_SMALL_END = WD_DN + (size_t)1024 * 2816;
static_assert(W_SMALL_END * 2 <= 48 * MiB, "small weights fit");
constexpr size_t ME_GU = 0, ME_DN = (size_t)7168 * 1024, ME_SIZE = ME_DN + (size_t)1024 * 3584;
static_assert(MOE_W + ME_SIZE * 8 * 2 <= WS_END, "moe weights fit");
#ifndef USE_PG8
#define USE_PG8 2
#endif

#define XB_TMO      128
#define XB_XCNT(j)  (256  + 64 * (j))
#define XB_XSUB(j)  (1280 + 64 * (j))
#define XB_XGEN(j)  (2304 + 64 * (j))
#define XB_TOP      3328
#define XB_TOPGEN   3392
#define XCD_BAR_WORDS 3456
#define XB_SPIN_CAP (1u << 22)
__device__ __forceinline__ unsigned xb_ld(unsigned* p)              { return __hip_atomic_load(p, __ATOMIC_RELAXED, __HIP_MEMORY_SCOPE_AGENT); }
__device__ __forceinline__ unsigned xb_add(unsigned* p, unsigned v) { return __hip_atomic_fetch_add(p, v, __ATOMIC_RELAXED, __HIP_MEMORY_SCOPE_AGENT); }
__device__ __forceinline__ unsigned xb_xcc_id() { return (unsigned)__builtin_amdgcn_s_getreg((3 << 11) | 20) & 0xFu; }
#define XB_SPIN(cond, bar) do { unsigned _sp = 0; while (cond) { __builtin_amdgcn_s_sleep(1); \
    if ((++_sp & 255u) == 0u) { if (xb_ld(&(bar)[XB_TMO])) break; if (_sp > XB_SPIN_CAP) { atomicAdd(&(bar)[XB_TMO], 1u); break; } } } } while (0)
struct XcdBarrier { unsigned* bar; unsigned x; volatile LAS unsigned* st; };
__device__ __forceinline__ XcdBarrier xcd_barrier_post(unsigned* bar, volatile LAS unsigned* st) {
    XcdBarrier b; b.bar = bar; b.x = xb_xcc_id(); b.st = st;
    if (threadIdx.x == 0) (void)xb_add(&bar[XB_XCNT(b.x)], 1u);
    return b;
}
__device__ __forceinline__ void xcd_barrier_complete(unsigned* bar, unsigned x, unsigned& nloc, unsigned& nx) {
    const unsigned G = gridDim.x * gridDim.y * gridDim.z;
    unsigned sum, cnt, mine, sp = 0u;
    for (;;) {
        sum = 0u; cnt = 0u; mine = 0u;
#pragma unroll
        for (unsigned j = 0; j < 16; ++j) { const unsigned c = xb_ld(&bar[XB_XCNT(j)]); sum += c; cnt += (c > 0u) ? 1u : 0u; mine = (j == x) ? c : mine; }
        if (sum == G) break;
        __builtin_amdgcn_s_sleep(1);
        if ((++sp & 255u) == 0u) { if (xb_ld(&bar[XB_TMO])) break; if (sp > XB_SPIN_CAP) { atomicAdd(&bar[XB_TMO], 1u); break; } }
    }
    nloc = mine > 0u ? mine : 1u; nx = cnt > 0u ? cnt : 1u;
}
__device__ __forceinline__ void xcd_barrier(const XcdBarrier& b) {
    asm volatile("s_waitcnt vmcnt(0)" ::: "memory");
    __syncthreads();
    if (threadIdx.x == 0) {
        unsigned* bar = b.bar;
        __builtin_amdgcn_s_waitcnt(0);
        unsigned nloc = b.st[0], nx = b.st[1];
        if (nloc == 0u) { xcd_barrier_complete(bar, b.x, nloc, nx); b.st[0] = nloc; b.st[1] = nx; }
        const unsigned old = xb_add(&bar[XB_XSUB(b.x)], 1u);
        const unsigned gen = old / nloc;
        if (old + 1u == (gen + 1u) * nloc) {
            __builtin_amdgcn_fence(__ATOMIC_RELEASE, "agent");
            asm volatile("s_waitcnt vmcnt(0)" ::: "memory");
            const unsigned og = xb_add(&bar[XB_TOP], 1u);
            const unsigned tg = og / nx;
            if (og + 1u == (tg + 1u) * nx) xb_add(&bar[XB_TOPGEN], 1u);
            else XB_SPIN(xb_ld(&bar[XB_TOPGEN]) == tg, bar);
            __builtin_amdgcn_fence(__ATOMIC_ACQUIRE, "agent");
            xb_add(&bar[XB_XGEN(b.x)], 1u);
            asm volatile("s_waitcnt vmcnt(0)" ::: "memory");
        } else {
            XB_SPIN(xb_ld(&bar[XB_XGEN(b.x)]) == gen, bar);
            __builtin_amdgcn_fence(__ATOMIC_ACQUIRE, "agent");
            asm volatile("s_waitcnt vmcnt(0)" ::: "memory");
        }
    }
    __syncthreads();
}

template <int CTRL> __device__ __forceinline__ float dpp_mov(float v) { return __uint_as_float(__builtin_amdgcn_update_dpp(0u, __float_as_uint(v), CTRL, 0xf, 0xf, true)); }
__device__ __forceinline__ float wave_sum(float v) {
    v += dpp_mov<0xB1>(v); v += dpp_mov<0x4E>(v); v += dpp_mov<0x124>(v); v += dpp_mov<0x128>(v);
    v += __shfl_xor(v, 16);
    const auto r = __builtin_amdgcn_permlane32_swap(__float_as_uint(v), __float_as_uint(v), false, false);
    return __uint_as_float(r[0]) + __uint_as_float(r[1]);
}
__device__ __forceinline__ float wave_max(float v) {
    v = fmaxf(v, dpp_mov<0xB1>(v)); v = fmaxf(v, dpp_mov<0x4E>(v)); v = fmaxf(v, dpp_mov<0x124>(v)); v = fmaxf(v, dpp_mov<0x128>(v));
    v = fmaxf(v, __shfl_xor(v, 16));
    const auto r = __builtin_amdgcn_permlane32_swap(__float_as_uint(v), __float_as_uint(v), false, false);
    return fmaxf(__uint_as_float(r[0]), __uint_as_float(r[1]));
}
__device__ __forceinline__ float sigmoidf_(float x) { return __builtin_amdgcn_rcpf(1.f + __expf(-x)); }
__device__ __forceinline__ float gelu_tanh(float x) {
    const float u = 0.7978845608028654f * (x + 0.044715f * x * x * x);
    const float th = 1.f - 2.f * __builtin_amdgcn_rcpf(__expf(2.f * u) + 1.f);
    return 0.5f * x * (1.f + th);
}
__device__ __forceinline__ void sincos_d(double ang, float& s, float& c) {
    double rev = ang * 0.15915494309189535;
    rev -= floor(rev);
    const float r = (float)rev;
    s = __builtin_amdgcn_sinf(r); c = __builtin_amdgcn_cosf(r);
}
__device__ __forceinline__ int t5_bucket(int dist) {
    const int n = dist < 0 ? 0 : dist;
    if (n < 16) return n;
    const int lg = 16 + (int)(__logf((float)n * 0.0625f) * (16.0f / 2.0794415416798357f));
    return lg < 31 ? lg : 31;
}

struct Params {
    const float* in[37];
    float* out;
    unsigned char* ws;
    int ph_lo, ph_hi;
};
#define IN_X 0
#define IN_MEM 1
#define IN_WIN 2
#define IN_WOUT 3
#define IN_MIXN 4
#define IN_OUTN 5
#define IN_SARE 6
#define IN_SAIM 7
#define IN_SBRE 8
#define IN_SBIM 9
#define IN_SCRE 10
#define IN_SCIM 11
#define IN_SD 12
#define IN_SLDT 13
#define IN_SGLU 14
#define IN_MQN 15
#define IN_MWUQ 16
#define IN_MKVN 17
#define IN_MWUKV 18
#define IN_NPE 19
#define IN_NW1 20
#define IN_NW2 21
#define IN_RELB 22
#define IN_XN 23
#define IN_MEMN 24
#define IN_XWQ 25
#define IN_XWKV 26
#define IN_XWO 27
#define IN_FFN 28
#define IN_DWG 29
#define IN_DWU 30
#define IN_DWD 31
#define IN_ROUTER 32
#define IN_MWG 33
#define IN_MWU 34
#define IN_MWD 35
#define IN_FINAL 36

#define GT_DECL const int tid = tid_(), lane = tid & 63; const int gt = blockIdx.x * NTHR + tid, NT = gridDim.x * NTHR; const int gw = gt >> 6, NW = NT >> 6; (void)lane; (void)gw; (void)NW; (void)gt; (void)NT;

__device__ __forceinline__ void ph_rms(const float* src, const float* gain, bf16_t* dst, int rows) {
    GT_DECL
    f32x4 gg[4];
#pragma unroll
    for (int j = 0; j < 4; ++j) gg[j] = *((const f32x4*)gain + lane + 64 * j);
    for (int r = gw; r < rows; r += 4 * NW) {
        f32x4 v[4][4];
#pragma unroll
        for (int q = 0; q < 4; ++q) { const int rq = r + q * NW; const f32x4* x = (const f32x4*)(src + (size_t)(rq < rows ? rq : r) * D) + lane;
#pragma unroll
            for (int j = 0; j < 4; ++j) v[q][j] = __builtin_nontemporal_load(x + 64 * j); }
#pragma unroll
        for (int q = 0; q < 4; ++q) { const int rq = r + q * NW;
            float s = 0.f;
#pragma unroll
            for (int j = 0; j < 4; ++j) s += v[q][j].x * v[q][j].x + v[q][j].y * v[q][j].y + v[q][j].z * v[q][j].z + v[q][j].w * v[q][j].w;
            const float rstd = rsqrtf(wave_sum(s) * (1.f / D) + EPS);
            if (rq < rows) { u32x2* o = (u32x2*)(dst + (size_t)rq * D) + lane;
#pragma unroll
                for (int j = 0; j < 4; ++j) o[64 * j] = (u32x2){pk_bf16(v[q][j].x * rstd * gg[j].x, v[q][j].y * rstd * gg[j].y), pk_bf16(v[q][j].z * rstd * gg[j].z, v[q][j].w * rstd * gg[j].w)}; }
        }
    }
}

template <int MODE, bool CBF>
__device__ __forceinline__ void gemm_naive(LAS float* lds, const bf16_t* A, int lda, const int* rowidx,
                                           const float* B, const float* B2, int ldb, size_t bstride, const int* tile_exp,
                                           void* Cv, int ldc, const void* Rv, int ldr, int N, int K, int tm_lo, int tm_hi, int crow_off) {
    const int tid = tid_();
    LAS float* As = lds;
    LAS float* Bs = lds + 16 * 132;
    LAS float* B2s = Bs + 16 * 64;
    const int ntn = (N + 63) / 64, ntiles = (tm_hi - tm_lo) * ntn;
    const int ty = tid >> 4, tx = tid & 15;
    for (int tile = blockIdx.x; tile < ntiles; tile += gridDim.x) {
        const int tm = tm_lo + tile / ntn, tn = tile % ntn;
        const int row0 = tm * 128, n0 = tn * 64;
        const float* Bp = B; const float* B2p = B2;
        if (tile_exp) { const int e = tile_exp[row0 >> 8]; if (e < 0) continue; Bp = B + (size_t)e * bstride; if (MODE == 2) B2p = B2 + (size_t)e * bstride; }
        float acc[4][4], acc2[4][4];
#pragma unroll
        for (int i = 0; i < 4; ++i)
#pragma unroll
            for (int j = 0; j < 4; ++j) { acc[i][j] = 0.f; acc2[i][j] = 0.f; }
        const int ar = tid >> 2, ak = (tid & 3) * 4;
        const int arow = rowidx ? rowidx[row0 + ar] : (row0 + ar);
        const bf16_t* Ap = A + (size_t)arow * lda + ak;
        for (int k0 = 0; k0 < K; k0 += 16) {
            const u32x2 av = *(const u32x2*)(Ap + k0);
            As[(ak + 0) * 132 + ar] = bflo(av.x); As[(ak + 1) * 132 + ar] = bfhi(av.x); As[(ak + 2) * 132 + ar] = bflo(av.y); As[(ak + 3) * 132 + ar] = bfhi(av.y);
#pragma unroll
            for (int i = 0; i < 2; ++i) {
                const int e = tid + i * 512, kk = e >> 6, nn = e & 63, col = n0 + nn;
                Bs[kk * 64 + nn] = col < N ? Bp[(size_t)(k0 + kk) * ldb + col] : 0.f;
                if (MODE == 2) B2s[kk * 64 + nn] = col < N ? B2p[(size_t)(k0 + kk) * ldb + col] : 0.f;
            }
            __syncthreads();
#pragma unroll
            for (int kk = 0; kk < 16; ++kk) {
                const f32x4 a = *(const LAS f32x4*)(As + kk * 132 + ty * 4);
                const f32x4 b = *(const LAS f32x4*)(Bs + kk * 64 + tx * 4);
                const float aa[4] = {a.x, a.y, a.z, a.w}, bb[4] = {b.x, b.y, b.z, b.w};
#pragma unroll
                for (int i = 0; i < 4; ++i)
#pragma unroll
                    for (int j = 0; j < 4; ++j) acc[i][j] += aa[i] * bb[j];
                if (MODE == 2) {
                    const f32x4 b2 = *(const LAS f32x4*)(B2s + kk * 64 + tx * 4);
                    const float bb2[4] = {b2.x, b2.y, b2.z, b2.w};
#pragma unroll
                    for (int i = 0; i < 4; ++i)
#pragma unroll
                        for (int j = 0; j < 4; ++j) acc2[i][j] += aa[i] * bb2[j];
                }
            }
            __syncthreads();
        }
#pragma unroll
        for (int i = 0; i < 4; ++i) {
            const int row = row0 + ty * 4 + i;
#pragma unroll
            for (int j = 0; j < 4; ++j) {
                const int col = n0 + tx * 4 + j;
                if (col < N) {
                    float v = acc[i][j];
                    if (MODE == 1) v += ((const float*)Rv)[(size_t)row * ldr + col];
                    if (MODE == 2) v = v * sigmoidf_(v) * acc2[i][j];
                    if (MODE == 3) v = bf2f(((const bf16_t*)Rv)[(size_t)row * ldr + col]) * sigmoidf_(v);
                    if (CBF) ((bf16_t*)Cv)[(size_t)(row - crow_off) * ldc + col] = f2bf(v);
                    else ((float*)Cv)[(size_t)(row - crow_off) * ldc + col] = v;
                }
            }
        }
    }
}

namespace pg8 {
#define PG8_LAS __attribute__((address_space(3)))
typedef short bf16x8 __attribute__((ext_vector_type(8)));
constexpr int BM = 256, BK = 64, HALF = 128, HTB = HALF * BK * 2, STAGE_BYTES = 8 * HTB, NXCD = 8, WGM = 8;
__host__ __device__ __forceinline__ int lds_byte(int r, int c) { const int st = (r >> 4) * 2 + (c >> 5), rr = r & 15, cc = c & 31, ob = rr * 64 + cc * 2; return st * 1024 + (ob ^ (((ob >> 9) & 1) << 5)); }
__host__ __device__ __forceinline__ void stage_rc(int b, int& R, int& C) { const int st = b / 1024, sb = b % 1024, swz = sb ^ (((sb >> 9) & 1) << 5); R = (st >> 1) * 16 + swz / 64; C = (st & 1) * 32 + (swz % 64) / 2; }
__host__ __device__ __forceinline__ int perm32(int rho) { const int n = rho >> 4, i = rho & 15; return 8 * (i >> 2) + 4 * n + (i & 3); }

struct Unit { int pm, pn, ks; };
struct Gemm { const bf16_t* A; const bf16_t* Bt; int K; const int* rowidx; const int* texp; size_t estride; int ld; int nks; int nNr; };

struct StaticOrder {
    int nM, nN, nwg, G, c, pm0;
    __device__ void init(int nM_, int nN_, int G_, int c_, int pm0_) { nM = nM_; nN = nN_; nwg = nM * nN; G = G_; c = c_; pm0 = pm0_; }
    __device__ bool next(int i, Unit& u) const {
        const long L = (long)i * G + c; if (L >= nwg) return false;
        int wgid = (int)L; { const int q = nwg / NXCD, r = nwg % NXCD, xcd = wgid % NXCD, off = wgid / NXCD; wgid = (xcd < r ? xcd * (q + 1) : r * (q + 1) + (xcd - r) * q) + off; }
        const int nig = WGM * nN, gid = wgid / nig, fm = gid * WGM, gsz = (nM - fm) < WGM ? (nM - fm) : WGM;
        u.pm = pm0 + fm + ((wgid % nig) % gsz); u.pn = (wgid % nig) / gsz; return true;
    }
};

__device__ __forceinline__ float row_rstd(const float* ssq, int row) {
    const f32x4* q = (const f32x4*)(ssq + (size_t)row * 16); const f32x4 a = q[0], b = q[1], c = q[2], d = q[3];
    const float s = ((a.x + a.y) + (a.z + a.w)) + ((b.x + b.y) + (b.z + b.w)) + ((c.x + c.y) + (c.z + c.w)) + ((d.x + d.y) + (d.z + d.w));
    return rsqrtf(s * (1.f / 1024.f) + EPS);
}
struct EpiF32 {
    static constexpr bool PERM = false;
    float* C; int ldc; const float* ssq;
    __device__ __forceinline__ void operator()(const f32x4 (&acc)[2][2][4][2], const Unit& u, int wr, int wc, int fr, int fq) const {
        const int row0 = u.pm * BM + wr * 64 + fr, col0 = u.pn * BM + wc * 32 + 4 * fq;
#pragma unroll
        for (int ai = 0; ai < 2; ++ai)
#pragma unroll
            for (int m = 0; m < 4; ++m) { const int row = row0 + ai * HALF + m * 16; float* rowp = C + (size_t)row * ldc + col0;
                const float rs = ssq ? row_rstd(ssq, row) : 1.f;
#pragma unroll
                for (int bj = 0; bj < 2; ++bj)
#pragma unroll
                    for (int n = 0; n < 2; ++n) *(f32x4*)(rowp + bj * HALF + n * 16) = acc[ai][bj][m][n] * rs; }
    }
};
struct EpiF32Slab {
    static constexpr bool PERM = false;
    float* C; int ldc; size_t slab; int rsub;
    __device__ __forceinline__ void operator()(const f32x4 (&acc)[2][2][4][2], const Unit& u, int wr, int wc, int fr, int fq) const {
        const int row0 = u.pm * BM - rsub + wr * 64 + fr, col0 = u.pn * BM + wc * 32 + 4 * fq;
        float* Cs = C + (size_t)u.ks * slab;
#pragma unroll
        for (int ai = 0; ai < 2; ++ai)
#pragma unroll
            for (int m = 0; m < 4; ++m) { float* rowp = Cs + (size_t)(row0 + ai * HALF + m * 16) * ldc + col0;
#pragma unroll
                for (int bj = 0; bj < 2; ++bj)
#pragma unroll
                    for (int n = 0; n < 2; ++n) *(f32x4*)(rowp + bj * HALF + n * 16) = acc[ai][bj][m][n]; }
    }
};
struct EpiProj {
    static constexpr bool PERM = true;
    float* C; int ldc; bf16_t* NK; const float* ssq; bf16_t* NQ;
    __device__ __forceinline__ void operator()(const f32x4 (&acc)[2][2][4][2], const Unit& u, int wr, int wc, int fr, int fq) const {
        const int row0 = u.pm * BM + wr * 64 + fr, col0 = u.pn * BM + wc * 32 + 8 * fq;
#pragma unroll
        for (int ai = 0; ai < 2; ++ai)
#pragma unroll
            for (int m = 0; m < 4; ++m) { const int row = row0 + ai * HALF + m * 16;
                const float rs = ssq ? row_rstd(ssq, row) : 1.f;
#pragma unroll
                for (int bj = 0; bj < 2; ++bj) { const f32x4 v0 = acc[ai][bj][m][0] * rs, v1 = acc[ai][bj][m][1] * rs; const int col = col0 + bj * HALF;
                    if (col >= 608 && col < 1760) {
                        const u32x4 w = {pk_bf16(v0[0], v0[1]), pk_bf16(v0[2], v0[3]), pk_bf16(v1[0], v1[1]), pk_bf16(v1[2], v1[3])};
                        if (col >= 992) *(u32x4*)(NK + (size_t)row * 768 + (col - 992)) = w; else *(u32x4*)(NQ + (size_t)row * 384 + (col - 608)) = w;
                    } else { float* cp = C + (size_t)row * ldc + col; *(f32x4*)cp = v0; *(f32x4*)(cp + 4) = v1; } } }
    }
};
struct EpiResF32 {
    static constexpr bool PERM = false;
    float* C; const float* R; int ld;
    __device__ __forceinline__ void operator()(const f32x4 (&acc)[2][2][4][2], const Unit& u, int wr, int wc, int fr, int fq) const {
        const int row0 = u.pm * BM + wr * 64 + fr, col0 = u.pn * BM + wc * 32 + 4 * fq;
#pragma unroll
        for (int ai = 0; ai < 2; ++ai)
#pragma unroll
            for (int m = 0; m < 4; ++m) { const size_t ro = (size_t)(row0 + ai * HALF + m * 16) * ld + col0;
                f32x4 rv[2][2];
#pragma unroll
                for (int bj = 0; bj < 2; ++bj)
#pragma unroll
                    for (int n = 0; n < 2; ++n) rv[bj][n] = *(const f32x4*)(R + ro + bj * HALF + n * 16);
#pragma unroll
                for (int bj = 0; bj < 2; ++bj)
#pragma unroll
                    for (int n = 0; n < 2; ++n) *(f32x4*)(C + ro + bj * HALF + n * 16) = rv[bj][n] + acc[ai][bj][m][n]; }
    }
};
struct EpiResNorm {
    static constexpr bool PERM = true;
    bf16_t* HB; const float* Rf; int ld; float* ssq;
    __device__ __forceinline__ void operator()(const f32x4 (&acc)[2][2][4][2], const Unit& u, int wr, int wc, int fr, int fq) const {
        const int row0 = u.pm * BM + wr * 64 + fr, col0 = u.pn * BM + wc * 32 + 8 * fq;
#pragma unroll
        for (int ai = 0; ai < 2; ++ai)
#pragma unroll
            for (int m = 0; m < 4; ++m) { const int row = row0 + ai * HALF + m * 16; const size_t ro = (size_t)row * ld + col0;
                f32x4 r0[2], r1[2];
#pragma unroll
                for (int bj = 0; bj < 2; ++bj) {
                    if (Rf) { r0[bj] = *(const f32x4*)(Rf + ro + bj * HALF); r1[bj] = *(const f32x4*)(Rf + ro + bj * HALF + 4); }
                    else { const u32x4 hb = *(const u32x4*)(HB + ro + bj * HALF);
                        r0[bj] = (f32x4){bflo(hb.x), bfhi(hb.x), bflo(hb.y), bfhi(hb.y)}; r1[bj] = (f32x4){bflo(hb.z), bfhi(hb.z), bflo(hb.w), bfhi(hb.w)}; } }
                float sq = 0.f;
#pragma unroll
                for (int bj = 0; bj < 2; ++bj) { const f32x4 v0 = r0[bj] + acc[ai][bj][m][0], v1 = r1[bj] + acc[ai][bj][m][1];
                    *(u32x4*)(HB + ro + bj * HALF) = (u32x4){pk_bf16(v0[0], v0[1]), pk_bf16(v0[2], v0[3]), pk_bf16(v1[0], v1[1]), pk_bf16(v1[2], v1[3])};
                    sq += ((v0[0] * v0[0] + v0[1] * v0[1]) + (v0[2] * v0[2] + v0[3] * v0[3])) + ((v1[0] * v1[0] + v1[1] * v1[1]) + (v1[2] * v1[2] + v1[3] * v1[3])); }
                if (ssq) { sq += __shfl_xor(sq, 16); sq += __shfl_xor(sq, 32);
                    if (fq == 0) ssq[(size_t)row * 16 + u.pn * 4 + wc] = sq; } }
    }
};
struct EpiGlu {
    static constexpr bool PERM = false;
    float* Y; int ldy; const bf16_t* R;
    __device__ __forceinline__ void operator()(const f32x4 (&acc)[2][2][4][2], const Unit& u, int wr, int wc, int fr, int fq) const {
        const int row0 = u.pm * BM + wr * 64 + fr, col0 = u.pn * BM + wc * 32 + 4 * fq;
#pragma unroll
        for (int ai = 0; ai < 2; ++ai)
#pragma unroll
            for (int m = 0; m < 4; ++m) { const int row = row0 + ai * HALF + m * 16;
#pragma unroll
                for (int bj = 0; bj < 2; ++bj)
#pragma unroll
                    for (int n = 0; n < 2; ++n) { const int col = col0 + bj * HALF + n * 16;
                        const u32x2 r2 = *(const u32x2*)(R + (size_t)row * 256 + col); const f32x4 a = acc[ai][bj][m][n];
                        *(f32x4*)(Y + (size_t)row * ldy + col) = (f32x4){bflo(r2.x) * sigmoidf_(a[0]), bfhi(r2.x) * sigmoidf_(a[1]), bflo(r2.y) * sigmoidf_(a[2]), bfhi(r2.y) * sigmoidf_(a[3])}; } }
    }
};
struct EpiSwiglu {
    static constexpr bool PERM = true;
    bf16_t* O; int ldo; int rsub; const float* ssq;
    __device__ __forceinline__ void operator()(const f32x4 (&acc)[2][2][4][2], const Unit& u, int wr, int wc, int fr, int fq) const {
        const int row0 = u.pm * BM - rsub + wr * 64 + fr, col0 = u.pn * HALF + wc * 32 + 8 * fq;
#pragma unroll
        for (int ai = 0; ai < 2; ++ai)
#pragma unroll
            for (int m = 0; m < 4; ++m) { bf16_t* rowp = O + (size_t)(row0 + ai * HALF + m * 16) * ldo + col0;
                const float rs = ssq ? row_rstd(ssq, u.pm * BM + wr * 64 + fr + ai * HALF + m * 16) : 1.f;
                const f32x4 g0 = acc[ai][0][m][0] * rs, g1 = acc[ai][0][m][1] * rs, u0 = acc[ai][1][m][0] * rs, u1 = acc[ai][1][m][1] * rs;
                u32x4 w;
                w.x = pk_bf16(g0[0] * sigmoidf_(g0[0]) * u0[0], g0[1] * sigmoidf_(g0[1]) * u0[1]); w.y = pk_bf16(g0[2] * sigmoidf_(g0[2]) * u0[2], g0[3] * sigmoidf_(g0[3]) * u0[3]);
                w.z = pk_bf16(g1[0] * sigmoidf_(g1[0]) * u1[0], g1[1] * sigmoidf_(g1[1]) * u1[1]); w.w = pk_bf16(g1[2] * sigmoidf_(g1[2]) * u1[2], g1[3] * sigmoidf_(g1[3]) * u1[3]);
                *(u32x4*)rowp = w; }
    }
};
struct EpiBf16 {
    static constexpr bool PERM = true;
    bf16_t* O; int ldo; const float* ssq;
    __device__ __forceinline__ void operator()(const f32x4 (&acc)[2][2][4][2], const Unit& u, int wr, int wc, int fr, int fq) const {
        const int row0 = u.pm * BM + wr * 64 + fr, col0 = u.pn * BM + wc * 32 + 8 * fq;
#pragma unroll
        for (int ai = 0; ai < 2; ++ai)
#pragma unroll
            for (int m = 0; m < 4; ++m) { const int row = row0 + ai * HALF + m * 16; bf16_t* rowp = O + (size_t)row * ldo + col0;
                const float rs = ssq ? row_rstd(ssq, row) : 1.f;
#pragma unroll
                for (int bj = 0; bj < 2; ++bj) { const f32x4 v0 = acc[ai][bj][m][0] * rs, v1 = acc[ai][bj][m][1] * rs;
                    u32x4 w; w.x = pk_bf16(v0[0], v0[1]); w.y = pk_bf16(v0[2], v0[3]); w.z = pk_bf16(v1[0], v1[1]); w.w = pk_bf16(v1[2], v1[3]);
                    *(u32x4*)(rowp + bj * HALF) = w; } }
    }
};

template <class Epi, bool GATHER>
__device__ __forceinline__ void gemm_phase(PG8_LAS unsigned char* lds, const Gemm g, const StaticOrder& S, const Epi& E) {
    const int tid = tid_(), wid = __builtin_amdgcn_readfirstlane(tid >> 6), lane = tid & 63, wr = wid >> 2, wc = wid & 3, fr = lane & 15, fq = lane >> 4;
    const int K = g.ld ? g.ld : g.K, nt = g.K / BK;
    unsigned voffA[2], voffB[2]; int sR[2], sC[2];
#pragma unroll
    for (int i = 0; i < 2; ++i) { int R, C; stage_rc(tid * 16 + i * 8192, R, C); const int Rb = Epi::PERM ? ((R & ~31) + perm32(R & 31)) : R; sR[i] = R; sC[i] = C;
        voffA[i] = (unsigned)(R * K + C) * 2u; voffB[i] = (unsigned)(Rb * K + C) * 2u; }
    const size_t kstep = (size_t)(BK * 2);
    const size_t hstep = (size_t)HALF * K * 2;
    const size_t sstep = (size_t)g.K * 2;
    const size_t tstep = 2 * hstep;
    const unsigned ldsw = (unsigned)wid * 1024u;
    const int aoff = lds_byte(wr * 64 + fr, fq * 8), boff = lds_byte(wc * 32 + fr, fq * 8);
#define PG8_SA(b, h) (((b) * 2 + (h)) * HTB)
#define PG8_SB(b, h) ((4 + (b) * 2 + (h)) * HTB)
#define PG8_STAGE(bufoff, gbase, voff) do { _Pragma("unroll") for (int _i = 0; _i < 2; ++_i) \
        __builtin_amdgcn_global_load_lds((const unsigned*)((const char*)(gbase) + (voff)[_i]), (PG8_LAS unsigned*)(lds + (bufoff) + ldsw + _i * 8192), 16, 0, 0); } while (0)
#define PG8_LDA(dst, b, h) do { _Pragma("unroll") for (int m = 0; m < 4; ++m) _Pragma("unroll") for (int k = 0; k < 2; ++k) dst[m][k] = *(const PG8_LAS bf16x8*)(lds + PG8_SA(b, h) + aoff + m * 2048 + k * 1024); } while (0)
#define PG8_LDB(dst, b, h) do { _Pragma("unroll") for (int n = 0; n < 2; ++n) _Pragma("unroll") for (int k = 0; k < 2; ++k) dst[n][k] = *(const PG8_LAS bf16x8*)(lds + PG8_SB(b, h) + boff + n * 2048 + k * 1024); } while (0)
#define PG8_MMA(ai, bj, At, Bt) do { __builtin_amdgcn_s_setprio(1); _Pragma("unroll") for (int m = 0; m < 4; ++m) _Pragma("unroll") for (int n = 0; n < 2; ++n) _Pragma("unroll") for (int k = 0; k < 2; ++k) \
        acc[ai][bj][m][n] = __builtin_amdgcn_mfma_f32_16x16x32_bf16(Bt[n][k], At[m][k], acc[ai][bj][m][n], 0, 0, 0); __builtin_amdgcn_s_setprio(0); } while (0)
#define PG8_WAIT_V(n) asm volatile("s_waitcnt vmcnt(" #n ")" ::: "memory")
#define PG8_WAIT_L(n) asm volatile("s_waitcnt lgkmcnt(" #n ")" ::: "memory")
#define PG8_BAR __builtin_amdgcn_s_barrier()
#define PG8_SCHED __builtin_amdgcn_sched_barrier(0)
#define PG8_GOFF(v, u) do { _Pragma("unroll") for (int _h = 0; _h < 2; ++_h) _Pragma("unroll") for (int _i = 0; _i < 2; ++_i) \
        v[_h][_i] = (unsigned)(g.rowidx[(u).pm * BM + _h * HALF + sR[_i]] * K + sC[_i]) * 2u; } while (0)
    Unit cur, nxt; int ui = 0;
    if (!S.next(0, cur)) return;
    cur.ks = 0; if (g.nks > 1) { cur.ks = cur.pn / g.nNr; cur.pn -= cur.ks * g.nNr; }
    f32x4 acc[2][2][4][2];
#pragma unroll
    for (int a = 0; a < 2; ++a)
#pragma unroll
        for (int b = 0; b < 2; ++b)
#pragma unroll
            for (int m = 0; m < 4; ++m)
#pragma unroll
                for (int n = 0; n < 2; ++n) acc[a][b][m][n] = (f32x4){0.f, 0.f, 0.f, 0.f};
    bf16x8 At[4][2], B0[2][2], B1[2][2];
    unsigned vAc[2][2], vAn[2][2];
    if constexpr (GATHER) { PG8_GOFF(vAc, cur); }
    const char* gA = (const char*)g.A;
    const char* cA = gA + (GATHER ? (size_t)0 : (size_t)cur.pm * tstep + (size_t)cur.ks * sstep);
    const char* cB = (const char*)g.Bt + (size_t)cur.pn * tstep + (size_t)cur.ks * sstep + (g.texp ? (size_t)g.texp[cur.pm] * g.estride * 2 : (size_t)0);
    PG8_STAGE(PG8_SB(0, 0), cB, voffB); PG8_STAGE(PG8_SB(0, 1), cB + hstep, voffB);
    if constexpr (GATHER) { PG8_STAGE(PG8_SA(0, 0), gA, vAc[0]); PG8_STAGE(PG8_SA(0, 1), gA, vAc[1]); }
    else { PG8_STAGE(PG8_SA(0, 0), cA, voffA); PG8_STAGE(PG8_SA(0, 1), cA + hstep, voffA); }
    if (wr == 1) PG8_BAR;
    PG8_WAIT_V(2); PG8_BAR;
    PG8_STAGE(PG8_SB(1, 0), cB + kstep, voffB);
    if constexpr (GATHER) { PG8_STAGE(PG8_SA(1, 0), gA + kstep, vAc[0]); } else { PG8_STAGE(PG8_SA(1, 0), cA + kstep, voffA); }
    PG8_STAGE(PG8_SB(1, 1), cB + hstep + kstep, voffB);
    PG8_WAIT_V(6); PG8_BAR;
    for (;;) {
        const bool has_next = S.next(ui + 1, nxt);
        nxt.ks = 0; if (has_next && g.nks > 1) { nxt.ks = nxt.pn / g.nNr; nxt.pn -= nxt.ks * g.nNr; }
        const char* nA = (has_next && !GATHER) ? gA + (size_t)nxt.pm * tstep + (size_t)nxt.ks * sstep : cA;
        const char* nB = has_next ? (const char*)g.Bt + (size_t)nxt.pn * tstep + (size_t)nxt.ks * sstep + (g.texp ? (size_t)g.texp[nxt.pm] * g.estride * 2 : (size_t)0) : cB;
        if constexpr (GATHER) { if (has_next) { PG8_GOFF(vAn, nxt); } else {
#pragma unroll
            for (int h = 0; h < 2; ++h)
#pragma unroll
                for (int i = 0; i < 2; ++i) vAn[h][i] = vAc[h][i]; } }
        for (int t = 0; t < nt; t += 2) {
            const bool last = (t == nt - 2);
            const char* a1 = cA + (size_t)(t + 1) * kstep;
            const char* a2 = last ? nA : cA + (size_t)(t + 2) * kstep; const char* b2 = last ? nB : cB + (size_t)(t + 2) * kstep;
            const char* a3 = a2 + kstep; const char* b3 = b2 + kstep;
            unsigned v2[2][2];
            if constexpr (GATHER) {
#pragma unroll
                for (int h = 0; h < 2; ++h)
#pragma unroll
                    for (int i = 0; i < 2; ++i) v2[h][i] = last ? vAn[h][i] : vAc[h][i]; }
#define PG8_STA1(buf) do { if constexpr (GATHER) { PG8_STAGE(buf, a1, vAc[1]); } else { PG8_STAGE(buf, a1 + hstep, voffA); } } while (0)
#define PG8_STA2(buf, h) do { if constexpr (GATHER) { PG8_STAGE(buf, a2, v2[h]); } else { PG8_STAGE(buf, a2 + (h) * hstep, voffA); } } while (0)
#define PG8_STA3(buf) do { if constexpr (GATHER) { PG8_STAGE(buf, a3, v2[0]); } else { PG8_STAGE(buf, a3, voffA); } } while (0)
            PG8_LDB(B0, 0, 0); PG8_LDB(B1, 0, 1); PG8_SCHED; PG8_LDA(At, 0, 0); PG8_STA1(PG8_SA(1, 1));
            PG8_WAIT_V(8); PG8_WAIT_L(0); PG8_BAR; PG8_MMA(0, 0, At, B0); PG8_MMA(0, 1, At, B1); PG8_BAR; PG8_SCHED;
            PG8_LDA(At, 0, 1); PG8_STAGE(PG8_SB(0, 0), b2, voffB); PG8_STAGE(PG8_SB(0, 1), b2 + hstep, voffB); PG8_STA2(PG8_SA(0, 0), 0);
            PG8_WAIT_V(8); PG8_WAIT_L(0); PG8_BAR; PG8_MMA(1, 0, At, B0); PG8_MMA(1, 1, At, B1); PG8_BAR; PG8_SCHED;
            PG8_LDB(B0, 1, 0); PG8_LDB(B1, 1, 1); PG8_SCHED; PG8_LDA(At, 1, 0); PG8_STA2(PG8_SA(0, 1), 1);
            PG8_WAIT_V(8); PG8_WAIT_L(0); PG8_BAR; PG8_MMA(0, 0, At, B0); PG8_MMA(0, 1, At, B1); PG8_BAR; PG8_SCHED;
            PG8_LDA(At, 1, 1); PG8_STAGE(PG8_SB(1, 0), b3, voffB); PG8_STAGE(PG8_SB(1, 1), b3 + hstep, voffB); PG8_STA3(PG8_SA(1, 0));
            PG8_WAIT_V(8); PG8_WAIT_L(0); PG8_BAR; PG8_MMA(1, 0, At, B0); PG8_MMA(1, 1, At, B1); PG8_BAR; PG8_SCHED;
        }
        if (wr == 0) PG8_BAR;
        E(acc, cur, wr, wc, fr, fq);
        if (!has_next) break;
#pragma unroll
        for (int a = 0; a < 2; ++a)
#pragma unroll
            for (int b = 0; b < 2; ++b)
#pragma unroll
                for (int m = 0; m < 4; ++m)
#pragma unroll
                    for (int n = 0; n < 2; ++n) acc[a][b][m][n] = (f32x4){0.f, 0.f, 0.f, 0.f};
        cur = nxt; cA = nA; cB = nB; ++ui;
        if constexpr (GATHER) {
#pragma unroll
            for (int h = 0; h < 2; ++h)
#pragma unroll
                for (int i = 0; i < 2; ++i) vAc[h][i] = vAn[h][i]; }
        if (wr == 1) PG8_BAR;
    }
    PG8_WAIT_V(0);
    PG8_BAR;
#undef PG8_SA
#undef PG8_SB
#undef PG8_STAGE
#undef PG8_LDA
#undef PG8_LDB
#undef PG8_MMA
#undef PG8_WAIT_V
#undef PG8_WAIT_L
#undef PG8_BAR
#undef PG8_SCHED
#undef PG8_GOFF
#undef PG8_STA1
#undef PG8_STA2
#undef PG8_STA3
}
}

struct CvtCursor { int base; };
template <bool VEC4>
__device__ __forceinline__ void cvt_matrix(CvtCursor& cur, const float* W, int K, int N, bf16_t* WT, int Kpad, int Npad, int mode, LAS float* scr, int gw, int NW, int lane, const float* kgain = nullptr) {
    const int nkb = Kpad / 64, nnb = Npad / 32, nitems = nkb * nnb;
    int first = (gw - cur.base % NW + NW) % NW;
    cur.base += nitems;
    for (int it = first; it < nitems; it += NW) {
        const int kb = it / nnb, nb = it % nnb, k0 = kb * 64, n0 = nb * 32;
        const int drow0 = mode == 0 ? n0 : (((n0 >> 7) << 8) + (n0 & 127) + (mode == 2 ? 128 : 0));
        if (VEC4) {
            const bool inr = (k0 < K) && (n0 < N);
#pragma unroll
            for (int i = 0; i < 8; ++i) {
                const int kk = i * 8 + (lane >> 3), nn = (lane & 7) * 4;
                f32x4 v = {0.f, 0.f, 0.f, 0.f};
                if (inr) { v = __builtin_nontemporal_load((const f32x4*)(W + (size_t)(k0 + kk) * N + n0 + nn)); if (kgain) v = v * kgain[k0 + kk]; }
                scr[kk * 33 + nn] = v.x; scr[kk * 33 + nn + 1] = v.y; scr[kk * 33 + nn + 2] = v.z; scr[kk * 33 + nn + 3] = v.w;
            }
        } else {
#pragma unroll 8
            for (int i = 0; i < 32; ++i) { const int kk = 2 * i + (lane >> 5), n = n0 + (lane & 31);
                scr[kk * 33 + (lane & 31)] = (k0 + kk < K && n < N) ? W[(size_t)(k0 + kk) * N + n] * (kgain ? kgain[k0 + kk] : 1.f) : 0.f; }
        }
        asm volatile("s_waitcnt lgkmcnt(0)" ::: "memory");
        const int c = lane & 7;
#pragma unroll
        for (int j = 0; j < 4; ++j) { const int n = (lane >> 3) + 8 * j; const LAS float* sp = scr + (8 * c) * 33 + n;
            u32x4 o; o.x = pk_bf16(sp[0 * 33], sp[1 * 33]); o.y = pk_bf16(sp[2 * 33], sp[3 * 33]); o.z = pk_bf16(sp[4 * 33], sp[5 * 33]); o.w = pk_bf16(sp[6 * 33], sp[7 * 33]);
            *(u32x4*)(WT + (size_t)(drow0 + n) * Kpad + k0 + 8 * c) = o; }
        asm volatile("s_waitcnt lgkmcnt(0)" ::: "memory");
    }
}

__device__ __forceinline__ void ph_rope_table(float* tab) {
    GT_DECL
    for (int i = gt; i < SEQ * 16; i += NT) {
        const int s = i >> 4, k = i & 15;
        const double inv = exp10(-0.25 * (double)k);
        float sn, cs; sincos_d((double)s * inv, sn, cs);
        tab[i] = cs; tab[SEQ * 16 + i] = sn;
    }
}

__device__ __forceinline__ void ph_mla_prep(const float* proj, const float* qn_g, const float* kvn_g, const float* rope, bf16_t* cqn, bf16_t* ckvn, bf16_t* krope) {
    GT_DECL
    const bool qa = lane < 48, ka = lane < 32;
    const f32x4 gq = qa ? *(const f32x4*)(qn_g + lane * 4) : (f32x4){0.f, 0.f, 0.f, 0.f};
    const f32x4 gk = ka ? *(const f32x4*)(kvn_g + lane * 4) : (f32x4){0.f, 0.f, 0.f, 0.f};
    constexpr int NB4 = 4;
    for (int t0 = gw; t0 < T; t0 += NB4 * NW) {
        f32x4 a[NB4], b[NB4]; float x1[NB4], x2[NB4], c[NB4], sn[NB4];
#pragma unroll
        for (int q = 0; q < NB4; ++q) { const int tq = t0 + q * NW, t = tq < T ? tq : t0;
            const float* pr = proj + (size_t)t * INLD;
            a[q] = qa ? *(const f32x4*)(pr + O_CQ + lane * 4) : (f32x4){0.f, 0.f, 0.f, 0.f};
            b[q] = ka ? *(const f32x4*)(pr + O_CKV + lane * 4) : (f32x4){0.f, 0.f, 0.f, 0.f};
            x1[q] = 0.f; x2[q] = 0.f; c[q] = 0.f; sn[q] = 0.f;
            if (lane < 16) { const int s_ = t & (SEQ - 1); c[q] = rope[s_ * 16 + lane]; sn[q] = rope[SEQ * 16 + s_ * 16 + lane]; x1[q] = pr[O_KR + lane]; x2[q] = pr[O_KR + 16 + lane]; } }
#pragma unroll
        for (int q = 0; q < NB4; ++q) { const int t = t0 + q * NW;
            const float rs = rsqrtf(wave_sum((a[q].x * a[q].x + a[q].y * a[q].y) + (a[q].z * a[q].z + a[q].w * a[q].w)) * (1.f / 192.f) + EPS);
            const float rs2 = rsqrtf(wave_sum((b[q].x * b[q].x + b[q].y * b[q].y) + (b[q].z * b[q].z + b[q].w * b[q].w)) * (1.f / 128.f) + EPS);
            if (t < T) {
                *(u32x2*)(cqn + (size_t)t * 256 + lane * 4) = (u32x2){pk_bf16(a[q].x * rs * gq.x, a[q].y * rs * gq.y), pk_bf16(a[q].z * rs * gq.z, a[q].w * rs * gq.w)};
                *(u32x2*)(ckvn + (size_t)t * 256 + lane * 4) = (u32x2){pk_bf16(b[q].x * rs2 * gk.x, b[q].y * rs2 * gk.y), pk_bf16(b[q].z * rs2 * gk.z, b[q].w * rs2 * gk.w)};
                if (lane < 16) { krope[(size_t)t * 32 + lane] = f2bf(x1[q] * c[q] - x2[q] * sn[q]); krope[(size_t)t * 32 + 16 + lane] = f2bf(x2[q] * c[q] + x1[q] * sn[q]); } } }
    }
}

struct SsmConst { float ab_r, ab_i, bb_r[16], bb_i[16]; double ang; float lrdt; };
__device__ __forceinline__ void ssm_consts(const Params& p, int l, int g, int lane, SsmConst& c) {
    const float dt = expf(p.in[IN_SLDT][l * 16 + g]);
    const float lr = p.in[IN_SARE][(l * 16 + g) * 64 + lane], li = p.in[IN_SAIM][(l * 16 + g) * 64 + lane];
    const float mag = expf(lr * dt);
    float sn, cs; sincos_d((double)li * (double)dt, sn, cs);
    c.ab_r = mag * cs; c.ab_i = mag * sn; c.ang = (double)li * (double)dt; c.lrdt = lr * dt;
    const float den = lr * lr + li * li, nr = c.ab_r - 1.f;
    const float f_r = (nr * lr + c.ab_i * li) / den, f_i = (c.ab_i * lr - nr * li) / den;
    const float* bre = p.in[IN_SBRE] + ((size_t)(l * 16 + g) * 64 + lane) * 16;
    const float* bim = p.in[IN_SBIM] + ((size_t)(l * 16 + g) * 64 + lane) * 16;
#pragma unroll
    for (int k4 = 0; k4 < 4; ++k4) { const f32x4 br4 = *(const f32x4*)(bre + 4 * k4), bi4 = *(const f32x4*)(bim + 4 * k4);
        const float brr[4] = {br4.x, br4.y, br4.z, br4.w}, bii[4] = {bi4.x, bi4.y, bi4.z, bi4.w};
#pragma unroll
        for (int q = 0; q < 4; ++q) { c.bb_r[4 * k4 + q] = f_r * brr[q] - f_i * bii[q]; c.bb_i[4 * k4 + q] = f_r * bii[q] + f_i * brr[q]; } }
}
__device__ __forceinline__ void ph_ssm1(const Params& p, int l, const float* proj, f32x2* E, LAS unsigned char* lds) {
    GT_DECL
    LAS float* ut = (LAS float*)(lds + (tid >> 6) * 16384 + 9216);
    const int nblk = (int)gridDim.x, half_w = (nblk / 2) * (NTHR / 64);
    const bool even_split = (nblk & 1) || (NB * 32 * 16 != 4 * half_w);
    const int wv = gw;
    const int my_first = even_split ? wv : (wv < half_w ? wv : half_w + (wv - half_w) * 3);
    const int my_count = even_split ? 0 : (wv < half_w ? 1 : 3);
    SsmConst c;
    if (!even_split) ssm_consts(p, l, (wv < half_w ? wv : wv - half_w) & 15, lane, c);
    auto item_w = [&](int it) {
        if (even_split) return my_first + it * NW;
        const int v_ = wv < half_w ? wv : wv - half_w; const int chunk = wv < half_w ? 192 + (v_ >> 4) : 3 * (v_ >> 4) + it; return (chunk << 4) + (v_ & 15);
    };
    auto has_item = [&](int it) { return even_split ? (my_first + it * NW < NB * 32 * 16) : (it < my_count); };
    auto u_rows = [&](int w) { const int g = w & 15, k = (w >> 4) & 31, b = w >> 9; return (const f32x4*)(proj + (size_t)(b * SEQ + k * 64 + lane) * INLD + O_U + g * 16); };
    f32x4 un[4];
    if (has_item(0)) { const f32x4* ur = u_rows(item_w(0)); un[0] = ur[0]; un[1] = ur[1]; un[2] = ur[2]; un[3] = ur[3]; }
    for (int it = 0; has_item(it); ++it) {
        const int w = item_w(it);
        const int g = w & 15;
        {
            LAS f32x4* ud = (LAS f32x4*)(ut + lane * 16);
            ud[0] = un[0]; ud[1] = un[1]; ud[2] = un[2]; ud[3] = un[3];
        }
        if (has_item(it + 1)) { const f32x4* ur = u_rows(item_w(it + 1)); un[0] = ur[0]; un[1] = ur[1]; un[2] = ur[2]; un[3] = ur[3]; }
        if (even_split) ssm_consts(p, l, g, lane, c);
        float hr = 0.f, hi = 0.f;
        asm volatile("s_waitcnt lgkmcnt(0)" ::: "memory");
        for (int j = 0; j < 64; ++j) {
            float br = 0.f, bi = 0.f;
            const LAS f32x4* uj4 = (const LAS f32x4*)(ut + j * 16);
            const f32x4 ua = uj4[0], ub = uj4[1], uc = uj4[2], ud4 = uj4[3];
            const float uu[16] = {ua.x, ua.y, ua.z, ua.w, ub.x, ub.y, ub.z, ub.w, uc.x, uc.y, uc.z, uc.w, ud4.x, ud4.y, ud4.z, ud4.w};
#pragma unroll
            for (int q = 0; q < 16; ++q) { const float u = uu[q]; br += u * c.bb_r[q]; bi += u * c.bb_i[q]; }
            const float nr = c.ab_r * hr - c.ab_i * hi + br, ni = c.ab_r * hi + c.ab_i * hr + bi;
            hr = nr; hi = ni;
        }
        E[(size_t)w * 64 + lane] = (f32x2){hr, hi};
    }
}
__device__ __forceinline__ void ph_ssm2(const Params& p, int l, const float* proj, const f32x2* E, bf16_t* ypre, LAS unsigned char* lds) {
    GT_DECL
    constexpr int HSTR = 272;
    LAS unsigned char* hb = lds + (tid >> 6) * 16384;
    LAS float* ut = (LAS float*)(lds + (tid >> 6) * 16384 + 9216);
    LAS bf16_t* yt = (LAS bf16_t*)(lds + (tid >> 6) * 16384 + 13312);
    const int fr = lane & 15, fq = lane >> 4;
    const bool gfix = (NW & 15) == 0;
    SsmConst c; float l64r = 0.f, l64i = 0.f;
    if (gfix) { ssm_consts(p, l, gw & 15, lane, c); float sn, cs; sincos_d(c.ang * 64.0, sn, cs); const float m = expf(64.f * c.lrdt); l64r = m * cs; l64i = m * sn; }
    int itn = 0;
    for (int w = gw; w < NB * 32 * 16; w += NW, ++itn) {
        const int g = w & 15, kq = (w >> 4) & 31, b = w >> 9, k = (((NW & 511) == 0) && (itn & 1)) ? 31 - kq : kq;
        const f32x4* ur = (const f32x4*)(proj + (size_t)(b * SEQ + k * 64 + lane) * INLD + O_U + g * 16);
        const f32x4 u0 = ur[0], u1 = ur[1], u2 = ur[2], u3 = ur[3];
        if (!gfix) { ssm_consts(p, l, g, lane, c); float sn, cs; sincos_d(c.ang * 64.0, sn, cs); const float m = expf(64.f * c.lrdt); l64r = m * cs; l64i = m * sn; }
        float hr = 0.f, hi = 0.f;
        for (int kk0 = 0; kk0 < k; kk0 += 8) {
            f32x2 ev[8];
#pragma unroll
            for (int q = 0; q < 8; ++q) { const int kk = kk0 + q < k ? kk0 + q : k - 1; ev[q] = E[(size_t)(((b * 32 + kk) * 16) + g) * 64 + lane]; }
#pragma unroll
            for (int q = 0; q < 8; ++q) if (kk0 + q < k) {
                const float nr = l64r * hr - l64i * hi + ev[q].x, ni = l64r * hi + l64i * hr + ev[q].y;
                hr = nr; hi = ni;
            }
        }
        bf16x8_t cb[4];
        {
            const float* cre = p.in[IN_SCRE] + ((size_t)(l * 16 + g) * 16 + fr) * 64;
            const float* cim = p.in[IN_SCIM] + ((size_t)(l * 16 + g) * 16 + fr) * 64;
#pragma unroll
            for (int s = 0; s < 4; ++s) {
                const f32x4 vr = *(const f32x4*)(cre + 16 * s + 4 * fq), vi = *(const f32x4*)(cim + 16 * s + 4 * fq);
                cb[s] = pack8f(vr.x, -vi.x, vr.y, -vi.y, vr.z, -vi.z, vr.w, -vi.w);
            }
        }
        const float dd = p.in[IN_SD][l * 256 + g * 16 + fr];
        {
            LAS f32x4* ud = (LAS f32x4*)(ut + lane * 16);
            ud[0] = u0; ud[1] = u1; ud[2] = u2; ud[3] = u3;
        }
        asm volatile("s_waitcnt lgkmcnt(0)" ::: "memory");
        for (int half = 0; half < 2; ++half) {
            for (int j = 0; j < 32; ++j) {
                float br = 0.f, bi = 0.f;
                const LAS f32x4* uj4 = (const LAS f32x4*)(ut + (half * 32 + j) * 16);
                const f32x4 ua = uj4[0], ub = uj4[1], uc = uj4[2], ud4 = uj4[3];
                const float uu[16] = {ua.x, ua.y, ua.z, ua.w, ub.x, ub.y, ub.z, ub.w, uc.x, uc.y, uc.z, uc.w, ud4.x, ud4.y, ud4.z, ud4.w};
#pragma unroll
                for (int q = 0; q < 16; ++q) { const float u = uu[q]; br += u * c.bb_r[q]; bi += u * c.bb_i[q]; }
                const float nr = c.ab_r * hr - c.ab_i * hi + br, ni = c.ab_r * hi + c.ab_i * hr + bi;
                hr = nr; hi = ni;
                *(LAS unsigned*)(hb + j * HSTR + lane * 4) = pk_bf16(hr, hi);
            }
            asm volatile("s_waitcnt lgkmcnt(0)" ::: "memory");
#pragma unroll
            for (int mt = 0; mt < 2; ++mt) {
                f32x4 acc = {0.f, 0.f, 0.f, 0.f};
#pragma unroll
                for (int s = 0; s < 4; ++s) {
                    const bf16x8_t a = *(const LAS bf16x8_t*)(hb + (16 * mt + fr) * HSTR + (32 * s + 8 * fq) * 2);
                    acc = __builtin_amdgcn_mfma_f32_16x16x32_bf16(a, cb[s], acc, 0, 0, 0);
                }
#pragma unroll
                for (int rg = 0; rg < 4; ++rg) {
                    const int step = half * 32 + 16 * mt + 4 * fq + rg;
                    const float u = ut[step * 16 + fr];
                    yt[step * 16 + fr] = f2bf(gelu_tanh(acc[rg] + dd * u));
                }
            }
            asm volatile("s_waitcnt lgkmcnt(0)" ::: "memory");
        }
        {
            const LAS u32x4* yr = (const LAS u32x4*)(yt + lane * 16);
            const u32x4 y0 = yr[0], y1 = yr[1];
            u32x4* yo = (u32x4*)(ypre + (size_t)(b * SEQ + k * 64 + lane) * 256 + g * 16);
            yo[0] = y0; yo[1] = y1;
        }
        asm volatile("s_waitcnt lgkmcnt(0)" ::: "memory");
    }
}

__device__ __forceinline__ void ph_cmp1(const Params& p, int l, const float* proj, float* hid) {
    GT_DECL
    const int total = 2 * NB * NBC * 2 * 64;
    for (int i = gt; i < total; i += NT) {
        const int c = i & 63, row = (i >> 6) % (NB * NBC * 2), j = (i >> 6) / (NB * NBC * 2);
        const int g = row & 1, n = (row >> 1) % NBC, b = (row >> 1) / NBC;
        const float* w1 = p.in[IN_NW1] + (size_t)(l * 2 + j) * 2048 * 64;
        const float* pe = p.in[IN_NPE] + (size_t)(l * 2 + j) * 32 * 64;
        float acc = 0.f;
        for (int pos = 0; pos < 32; ++pos) {
            const float* kv = proj + (size_t)(b * SEQ + n * 16 + pos) * INLD + O_NKV + j * 128 + g * 64;
            for (int d = 0; d < 64; ++d) acc += (kv[d] + pe[pos * 64 + d]) * w1[(size_t)(pos * 64 + d) * 64 + c];
        }
        hid[i] = gelu_tanh(acc);
    }
}
__device__ __forceinline__ void ph_cmp2(const Params& p, int l, const float* hid, float* kc) {
    GT_DECL
    const int total = 2 * NB * NBC * 2 * 64;
    for (int i = gt; i < total; i += NT) {
        const int c = i & 63, j = (i >> 6) / (NB * NBC * 2);
        const float* w2 = p.in[IN_NW2] + (size_t)(l * 2 + j) * 64 * 64;
        const float* h = hid + (size_t)(i >> 6) * 64;
        float acc = 0.f;
        for (int k = 0; k < 64; ++k) acc += h[k] * w2[k * 64 + c];
        kc[i] = acc;
    }
}

__device__ __forceinline__ void ph_mla_attn(const float* qmla, const float* kvmla, const float* krope, const float* rope, float* ycat) {
    GT_DECL
    const float scale = 0.10206207261596575f;
    for (int w = gw; w < 6 * (T / 64); w += NW) {
        const int h = __builtin_amdgcn_readfirstlane(w % 6), tb = __builtin_amdgcn_readfirstlane(w / 6);
        const int t = tb * 64 + lane, s = t & (SEQ - 1), b = __builtin_amdgcn_readfirstlane(t >> 11);
        float q[96];
        const float* qp = qmla + (size_t)t * 768 + h * 96;
#pragma unroll
        for (int d = 0; d < 64; ++d) q[d] = qp[d] * scale;
#pragma unroll
        for (int d = 0; d < 16; ++d) {
            const float c = rope[s * 16 + d], sn = rope[SEQ * 16 + s * 16 + d];
            const float x1 = qp[64 + d], x2 = qp[80 + d];
            q[64 + d] = (x1 * c - x2 * sn) * scale; q[80 + d] = (x2 * c + x1 * sn) * scale;
        }
        const int jmax = __builtin_amdgcn_readfirstlane((tb * 64 + 63) & (SEQ - 1));
        for (int half = 0; half < 2; ++half) {
            float acc[32];
#pragma unroll
            for (int d = 0; d < 32; ++d) acc[d] = 0.f;
            float m = -1e30f, lsum = 0.f;
            for (int j = 0; j <= jmax; ++j) {
                const float* kp = kvmla + (size_t)(b * SEQ + j) * 768 + h * 128;
                const float* rp = krope + (size_t)(b * SEQ + j) * 32;
                float sc = 0.f;
#pragma unroll
                for (int d = 0; d < 64; ++d) sc += q[d] * kp[d];
#pragma unroll
                for (int d = 0; d < 32; ++d) sc += q[64 + d] * rp[d];
                const bool ok = j <= s;
                const float mn = ok ? fmaxf(m, sc) : m;
                const float corr = __expf(m - mn), pj = ok ? __expf(sc - mn) : 0.f;
                lsum = lsum * corr + pj; m = mn;
#pragma unroll
                for (int d = 0; d < 32; ++d) acc[d] = acc[d] * corr + pj * kp[64 + half * 32 + d];
            }
            const float inv = 1.f / lsum;
            float* o = ycat + (size_t)t * D + 256 + h * 64 + half * 32;
#pragma unroll
            for (int d = 0; d < 32; ++d) o[d] = acc[d] * inv;
        }
    }
}

__device__ __forceinline__ void ph_nsa_cmp(const Params& p, const float* proj, const float* kc, float* impp, float* ycat) {
    GT_DECL
    const float* relb = p.in[IN_RELB];
    for (int w = gw; w < 6 * (T / 64); w += NW) {
        const int hh = __builtin_amdgcn_readfirstlane(w % 6), tb = __builtin_amdgcn_readfirstlane(w / 6);
        const int g = hh / 3;
        const int t = tb * 64 + lane, s = t & (SEQ - 1), b = __builtin_amdgcn_readfirstlane(t >> 11);
        float q[64];
        const float* qp = proj + (size_t)t * INLD + O_NQ + hh * 64;
#pragma unroll
        for (int d = 0; d < 64; ++d) q[d] = qp[d] * 0.125f;
        const int nvis = s >= 31 ? ((s - 31) >> 4) + 1 : 0;
        const int smax = (tb * 64 + 63) & (SEQ - 1);
        const int nmax = __builtin_amdgcn_readfirstlane(smax >= 31 ? ((smax - 31) >> 4) + 1 : 0);
        const float* kcb = kc + (size_t)b * NBC * 128 + g * 64;
        const float* vcb = kc + (size_t)NB * NBC * 128 + (size_t)b * NBC * 128 + g * 64;
        float m = -1e30f, lsum = 0.f;
        for (int n = 0; n < nmax; ++n) {
            const float* kp = kcb + n * 128;
            float sc = 0.f;
#pragma unroll
            for (int d = 0; d < 64; ++d) sc += q[d] * kp[d];
            const bool ok = n < nvis;
            sc += relb[t5_bucket(s - (n * 16 + 31)) * 6 + hh];
            const float mn = ok ? fmaxf(m, sc) : m;
            lsum = lsum * __expf(m - mn) + (ok ? __expf(sc - mn) : 0.f); m = mn;
        }
        const float inv = nvis > 0 ? 1.f / lsum : 0.f;
        float acc[64];
#pragma unroll
        for (int d = 0; d < 64; ++d) acc[d] = 0.f;
        const int mmax = (nmax + 4) >> 2;
        for (int mb = 0; mb < 32; ++mb) {
            float im = 0.f;
            if (mb < mmax) {
                for (int dn = -1; dn < 4; ++dn) {
                    const int n = 4 * mb + dn;
                    if (n < 0 || n >= nmax) continue;
                    const float* kp = kcb + n * 128;
                    float sc = 0.f;
#pragma unroll
                    for (int d = 0; d < 64; ++d) sc += q[d] * kp[d];
                    sc += relb[t5_bucket(s - (n * 16 + 31)) * 6 + hh];
                    const float pn = (n < nvis) ? __expf(sc - m) * inv : 0.f;
                    im += pn;
                    if (dn >= 0) { const float* vp = vcb + n * 128;
#pragma unroll
                        for (int d = 0; d < 64; ++d) acc[d] += pn * vp[d]; }
                }
            }
            impp[((size_t)t * 6 + hh) * 32 + mb] = im;
        }
        const float gate = sigmoidf_(proj[(size_t)t * INLD + O_NG + 0 * 6 + hh]);
        float* o = ycat + (size_t)t * D + 640 + hh * 64;
#pragma unroll
        for (int d = 0; d < 64; ++d) o[d] = gate * acc[d];
    }
}
__device__ __forceinline__ unsigned nsa_topk_mask(const float* ip  , int cur) {
    float imp[32];
#pragma unroll
    for (int m = 0; m < 32; ++m) imp[m] = (ip[(size_t)m * SEQ] + ip[(size_t)(32 + m) * SEQ]) + ip[(size_t)(64 + m) * SEQ];
#pragma unroll
    for (int m = 0; m < 32; ++m) {
        const bool forced = (m == 0) || (m == cur) || (m == cur - 1);
        const bool future = m > cur;
        imp[m] = forced ? 1e9f : (future ? -1e9f : imp[m]);
    }
    unsigned mask = 0u;
#pragma unroll
    for (int k = 0; k < 8; ++k) {
        float best = -3e38f; int bi = 0;
#pragma unroll
        for (int m = 0; m < 32; ++m) { const bool free_ = !((mask >> m) & 1u); if (free_ && imp[m] > best) { best = imp[m]; bi = m; } }
        mask |= 1u << bi;
    }
    return mask;
}
__device__ __forceinline__ void ph_nsa_selwin(const Params& p, const float* proj, const unsigned* sel, float* ycat) {
    GT_DECL
    const float* relb = p.in[IN_RELB];
    for (int w = gw; w < 6 * (T / 64); w += NW) {
        const int hh = w % 6, tb = w / 6, g = hh / 3;
        const int t = tb * 64 + lane, s = t & (SEQ - 1), b = t >> 11, cur = s >> 6;
        float q[64];
        const float* qp = proj + (size_t)t * INLD + O_NQ + hh * 64;
#pragma unroll
        for (int d = 0; d < 64; ++d) q[d] = qp[d] * 0.125f;
        const unsigned mask = sel[t * 2 + g];
        float* o = ycat + (size_t)t * D + 640 + hh * 64;
        const float gs = sigmoidf_(proj[(size_t)t * INLD + O_NG + 1 * 6 + hh]), gwn = sigmoidf_(proj[(size_t)t * INLD + O_NG + 2 * 6 + hh]);
        for (int half = 0; half < 2; ++half) {
        {
            float acc[32];
#pragma unroll
            for (int d = 0; d < 32; ++d) acc[d] = 0.f;
            float m = -1e30f, lsum = 0.f;
            for (int mb = 0; mb < 32; ++mb) {
                const bool on = ((mask >> mb) & 1u) && mb <= cur;
                if (!__any(on)) continue;
                for (int j = 0; j < 64; ++j) {
                    const int kpos = mb * 64 + j;
                    const bool ok = on && kpos <= s;
                    if (ok) {
                        const float* kp = proj + (size_t)(b * SEQ + kpos) * INLD + O_NKV + 2 * 128 + g * 64;
                        const float* vp = kp + 128 + half * 32;
                        float sc = 0.f;
#pragma unroll
                        for (int d = 0; d < 64; ++d) sc += q[d] * kp[d];
                        sc += relb[t5_bucket(s - kpos) * 6 + hh];
                        const float mn = fmaxf(m, sc), corr = __expf(m - mn), pj = __expf(sc - mn);
                        lsum = lsum * corr + pj; m = mn;
#pragma unroll
                        for (int d = 0; d < 32; ++d) acc[d] = acc[d] * corr + pj * vp[d];
                    }
                }
            }
            const float inv = gs / lsum;
#pragma unroll
            for (int d = 0; d < 32; ++d) o[half * 32 + d] += acc[d] * inv;
        }
        {
            float acc[32];
#pragma unroll
            for (int d = 0; d < 32; ++d) acc[d] = 0.f;
            float m = -1e30f, lsum = 0.f;
            for (int j = 0; j < 256; ++j) {
                const int kpos = s - 255 + j;
                if (kpos >= 0) {
                    const float* kp = proj + (size_t)(b * SEQ + kpos) * INLD + O_NKV + 4 * 128 + g * 64;
                    const float* vp = kp + 128 + half * 32;
                    float sc = 0.f;
#pragma unroll
                    for (int d = 0; d < 64; ++d) sc += q[d] * kp[d];
                    sc += relb[t5_bucket(s - kpos) * 6 + hh];
                    const float mn = fmaxf(m, sc), corr = __expf(m - mn), pj = __expf(sc - mn);
                    lsum = lsum * corr + pj; m = mn;
#pragma unroll
                    for (int d = 0; d < 32; ++d) acc[d] = acc[d] * corr + pj * vp[d];
                }
            }
            const float inv = gwn / lsum;
#pragma unroll
            for (int d = 0; d < 32; ++d) o[half * 32 + d] += acc[d] * inv;
        }
        }
    }
}

__device__ __forceinline__ void ph_group_norm(const float* ycat, const float* gain, bf16_t* yb) {
    GT_DECL
    const f32x4 ga = *(const f32x4*)(gain + lane * 4);
    f32x2 gb[3], gc[3];
#pragma unroll
    for (int i = 0; i < 3; ++i) { gb[i] = *(const f32x2*)(gain + 256 + lane * 6 + 2 * i); gc[i] = *(const f32x2*)(gain + 640 + lane * 6 + 2 * i); }
    for (int t = gw; t < T; t += NW) {
        const float* y = ycat + (size_t)t * D; bf16_t* o = yb + (size_t)t * D;
        const f32x4 a = __builtin_nontemporal_load((const f32x4*)(y + lane * 4));
        f32x2 b[3], c[3];
#pragma unroll
        for (int i = 0; i < 3; ++i) { b[i] = __builtin_nontemporal_load((const f32x2*)(y + 256 + lane * 6 + 2 * i)); c[i] = __builtin_nontemporal_load((const f32x2*)(y + 640 + lane * 6 + 2 * i)); }
        float sa = (a.x * a.x + a.y * a.y) + (a.z * a.z + a.w * a.w), sb = 0.f, sc = 0.f;
#pragma unroll
        for (int i = 0; i < 3; ++i) { sb += b[i].x * b[i].x + b[i].y * b[i].y; sc += c[i].x * c[i].x + c[i].y * c[i].y; }
        const float ra = rsqrtf(wave_sum(sa) * (1.f / 256.f) + EPS), rb = rsqrtf(wave_sum(sb) * (1.f / 384.f) + EPS), rc = rsqrtf(wave_sum(sc) * (1.f / 384.f) + EPS);
        *(u32x2*)(o + lane * 4) = (u32x2){pk_bf16(a.x * ra * ga.x, a.y * ra * ga.y), pk_bf16(a.z * ra * ga.z, a.w * ra * ga.w)};
#pragma unroll
        for (int i = 0; i < 3; ++i) {
            *(unsigned*)(o + 256 + lane * 6 + 2 * i) = pk_bf16(b[i].x * rb * gb[i].x, b[i].y * rb * gb[i].y);
            *(unsigned*)(o + 640 + lane * 6 + 2 * i) = pk_bf16(c[i].x * rc * gc[i].x, c[i].y * rc * gc[i].y);
        }
    }
}

__device__ __forceinline__ void ph_xattn(const float* qx, const float* kvx, bf16_t* ox) {
    GT_DECL
    for (int w = gw; w < T * 4; w += NW) {
        const int h = w & 3, t = w >> 2, b = t >> 11;
        const float* q = qx + (size_t)t * D + h * 256;
        const float* kb = kvx + (size_t)(b * 256) * 2048 + h * 256;
        float sc[4] = {0.f, 0.f, 0.f, 0.f};
        for (int d = 0; d < 256; d += 4) {
            const f32x4 qv = *(const f32x4*)(q + d);
#pragma unroll
            for (int i = 0; i < 4; ++i) { const f32x4 kv = *(const f32x4*)(kb + (size_t)(i * 64 + lane) * 2048 + d); sc[i] += qv.x * kv.x + qv.y * kv.y + qv.z * kv.z + qv.w * kv.w; }
        }
        float mx = -1e30f;
#pragma unroll
        for (int i = 0; i < 4; ++i) { sc[i] *= 0.0625f; mx = fmaxf(mx, sc[i]); }
        mx = wave_max(mx);
        float ls = 0.f;
#pragma unroll
        for (int i = 0; i < 4; ++i) { sc[i] = __expf(sc[i] - mx); ls += sc[i]; }
        ls = wave_sum(ls);
        const float inv = 1.f / ls;
        f32x4 o = {0.f, 0.f, 0.f, 0.f};
        const float* vb = kb + 1024 + lane * 4;
#pragma unroll
        for (int i = 0; i < 4; ++i)
            for (int j = 0; j < 64; ++j) {
                const float pj = __shfl(sc[i], j);
                const f32x4 vv = *(const f32x4*)(vb + (size_t)(i * 64 + j) * 2048);
                o.x += pj * vv.x; o.y += pj * vv.y; o.z += pj * vv.z; o.w += pj * vv.w;
            }
        *(u32x2*)(ox + (size_t)t * D + h * 256 + lane * 4) = (u32x2){pk_bf16(o.x * inv, o.y * inv), pk_bf16(o.z * inv, o.w * inv)};
    }
}

__device__ __forceinline__ void ph_moe_route(const bf16_t* h, const float* gain, const float* router, bf16_t* hn, int* topi, float* topw, int* cntg, LAS int* lcnt) {
    GT_DECL
    if (tid < 8) lcnt[tid] = 0;
    __syncthreads();
    f32x4 ra[16], rb[16], gg4[4];
#pragma unroll
    for (int j = 0; j < 4; ++j) {
        gg4[j] = *((const f32x4*)gain + lane + 64 * j);
#pragma unroll
        for (int c = 0; c < 4; ++c) { const float* r = router + (size_t)(j * 256 + lane * 4 + c) * 8; ra[4 * j + c] = *(const f32x4*)r; rb[4 * j + c] = *(const f32x4*)(r + 4); }
    }
    const int CH = (T + (int)gridDim.x - 1) / (int)gridDim.x, WCH = (CH + NTHR / 64 - 1) / (NTHR / 64);
    constexpr int NWV = NTHR / 64;
    u32x2 xnext[4];
    { const int t0 = (int)blockIdx.x * CH + (tid >> 6); const u32x2* x0 = (const u32x2*)(h + (size_t)(t0 < T ? t0 : 0) * D) + lane;
#pragma unroll
      for (int j = 0; j < 4; ++j) xnext[j] = __builtin_nontemporal_load(x0 + 64 * j); }
    for (int k = 0; k < WCH; ++k) {
        const int tl = k * NWV + (tid >> 6), t = (int)blockIdx.x * CH + tl;
        if (tl >= CH || t >= T) break;
        u32x2 xcur[4];
#pragma unroll
        for (int j = 0; j < 4; ++j) xcur[j] = xnext[j];
        { const bool more = (k + 1 < WCH) && (tl + NWV < CH) && (t + NWV < T); const u32x2* xn = (const u32x2*)(h + (size_t)(more ? t + NWV : t) * D) + lane;
#pragma unroll
          for (int j = 0; j < 4; ++j) xnext[j] = __builtin_nontemporal_load(xn + 64 * j); }
        f32x4 v[4]; float s = 0.f;
#pragma unroll
        for (int j = 0; j < 4; ++j) { const u32x2 xb = xcur[j]; v[j] = (f32x4){bflo(xb.x), bfhi(xb.x), bflo(xb.y), bfhi(xb.y)}; s += v[j].x * v[j].x + v[j].y * v[j].y + v[j].z * v[j].z + v[j].w * v[j].w; }
        const float rstd = rsqrtf(wave_sum(s) * (1.f / D) + EPS);
        u32x2* o = (u32x2*)(hn + (size_t)t * D) + lane;
        float lg[8] = {0.f, 0.f, 0.f, 0.f, 0.f, 0.f, 0.f, 0.f};
#pragma unroll
        for (int j = 0; j < 4; ++j) {
            const f32x4 gg = gg4[j];
            const f32x4 y = {v[j].x * rstd * gg.x, v[j].y * rstd * gg.y, v[j].z * rstd * gg.z, v[j].w * rstd * gg.w};
            o[64 * j] = (u32x2){pk_bf16(y.x, y.y), pk_bf16(y.z, y.w)};
            const float yy[4] = {y.x, y.y, y.z, y.w};
#pragma unroll
            for (int c = 0; c < 4; ++c) {
                const f32x4 r0 = ra[4 * j + c], r1 = rb[4 * j + c];
                lg[0] += yy[c] * r0.x; lg[1] += yy[c] * r0.y; lg[2] += yy[c] * r0.z; lg[3] += yy[c] * r0.w;
                lg[4] += yy[c] * r1.x; lg[5] += yy[c] * r1.y; lg[6] += yy[c] * r1.z; lg[7] += yy[c] * r1.w;
            }
        }
#pragma unroll
        for (int e = 0; e < 8; ++e) lg[e] = wave_sum(lg[e]);
        float v0 = -3e38f; int i0 = 0;
#pragma unroll
        for (int e = 0; e < 8; ++e) if (lg[e] > v0) { v0 = lg[e]; i0 = e; }
        float v1 = -3e38f; int i1 = 0;
#pragma unroll
        for (int e = 0; e < 8; ++e) if (e != i0 && lg[e] > v1) { v1 = lg[e]; i1 = e; }
        const float e1 = __expf(v1 - v0), w0 = 1.f / (1.f + e1), w1 = e1 * w0;
        if (lane == 0) { topi[t * 2] = i0; topi[t * 2 + 1] = i1; topw[t * 2] = w0; topw[t * 2 + 1] = w1;
            __hip_atomic_fetch_add(lcnt + i0, 1, __ATOMIC_RELAXED, __HIP_MEMORY_SCOPE_WORKGROUP); __hip_atomic_fetch_add(lcnt + i1, 1, __ATOMIC_RELAXED, __HIP_MEMORY_SCOPE_WORKGROUP); }
    }
    __syncthreads();
    if (tid < 8) cntg[(int)blockIdx.x * 8 + tid] = lcnt[tid];
}
__device__ __forceinline__ void ph_moe_sort(LAS int* lds, const int* topi, const int* cntg, int* pos, int* rsrc, int* texp) {
    const int tid = tid_(), lane = tid & 63, wave = tid >> 6;
    const int nb = (int)gridDim.x, me = (int)blockIdx.x;
    LAS int* tot = lds;
    {
        int sum = 0, pre = 0;
        for (int b = lane; b < nb; b += 64) { const int v = cntg[b * 8 + wave]; sum += v; pre += (b < me) ? v : 0; }
#pragma unroll
        for (int o = 32; o > 0; o >>= 1) { sum += __shfl_xor(sum, o); pre += __shfl_xor(pre, o); }
        if (lane == 0) { tot[wave] = sum; tot[8 + wave] = pre; }
    }
    __syncthreads();
    if (wave == 0) {
        const int CH = (T + nb - 1) / nb;
        int run[8];
#pragma unroll
        for (int k = 0; k < 8; ++k) run[k] = 0;
        for (int base = 0; base < CH; base += 64) {
            const int tl = base + lane, t = me * CH + tl;
            const bool ok = tl < CH && t < T;
            const int e0 = ok ? topi[t * 2] : -1, e1 = ok ? topi[t * 2 + 1] : -1;
            const unsigned long long lt = (1ull << lane) - 1ull;
            int p0 = 0, p1 = 0, off = 0;
#pragma unroll
            for (int k = 0; k < 8; ++k) {
                const unsigned long long b0 = __ballot(e0 == k), b1 = __ballot(e1 == k);
                const int before = off + tot[8 + k] + run[k] + __popcll(b0 & lt) + __popcll(b1 & lt);
                p0 = (e0 == k) ? before : p0;
                p1 = (e1 == k) ? before + ((e0 == k) ? 1 : 0) : p1;
                run[k] += __popcll(b0) + __popcll(b1);
                off += (tot[k] + 255) & ~255;
            }
            if (ok) { pos[t * 2] = p0; pos[t * 2 + 1] = p1; rsrc[p0] = t; rsrc[p1] = t; }
        }
    }
    if (me == 0) {
        if (tid < MOE_TILES) { const int r0 = tid * 256; int ex = -1, lo = 0;
            for (int e = 0; e < 8; ++e) { const int hi = lo + ((tot[e] + 255) & ~255); if (r0 >= lo && r0 < hi) ex = e; lo = hi; }
            texp[tid] = ex; if (tid == 0) texp[160] = lo >> 8; }
        int lo = 0;
        for (int e = 0; e < 8; ++e) { const int hi = lo + ((tot[e] + 255) & ~255); for (int r = lo + tot[e] + tid; r < hi; r += NTHR) rsrc[r] = 0; lo = hi; }
    }
}
__device__ __forceinline__ f32x4 moe_row4(const bf16_t* ys, const float* ys2p, int r, int col) {
    if (r < 2 * MOE_RT * 256) { const u32x2 b2 = __builtin_nontemporal_load((const u32x2*)(ys + (size_t)r * D + col)); return (f32x4){bflo(b2.x), bfhi(b2.x), bflo(b2.y), bfhi(b2.y)}; }
    const float* q = ys2p + (size_t)(r - 2 * MOE_RT * 256) * D + col;
    return (*(const f32x4*)q + *(const f32x4*)(q + (size_t)2048 * D)) + (*(const f32x4*)(q + (size_t)2 * 2048 * D) + *(const f32x4*)(q + (size_t)3 * 2048 * D));
}
__device__ __forceinline__ void ph_moe_combine(const bf16_t* h, const bf16_t* ys, const float* ys2p, const int* pos, const float* topw, const float* gain, float* out,
                                               int blk_lo, int t_lo, int t_hi, bool late, int t_split, bool early_a, bool early_b) {
    const int tid = tid_(), lane = tid & 63;
    if ((int)blockIdx.x < blk_lo) return;
    const int wv = ((int)blockIdx.x - blk_lo) * (NTHR / 64) + (tid >> 6), nwv = ((int)gridDim.x - blk_lo) * (NTHR / 64);
    for (int t = t_lo + wv; t < t_hi; t += nwv) {
        const int r0 = pos[t * 2], r1 = pos[t * 2 + 1];
        const bool full = r0 < 2 * MOE_RT * 256 && r1 < 2 * MOE_RT * 256;
        if (!late) { if (!full) continue; }
        else if (full && (t < t_split ? early_a : early_b)) continue;
        const u32x2* x = (const u32x2*)(h + (size_t)t * D) + lane;
        const float w0 = topw[t * 2], w1 = topw[t * 2 + 1];
        f32x4 v[4]; float s = 0.f;
#pragma unroll
        for (int j = 0; j < 4; ++j) { const u32x2 xb = __builtin_nontemporal_load(x + 64 * j); const f32x4 a = {bflo(xb.x), bfhi(xb.x), bflo(xb.y), bfhi(xb.y)};
            const f32x4 b = moe_row4(ys, ys2p, r0, 256 * j + 4 * lane), c = moe_row4(ys, ys2p, r1, 256 * j + 4 * lane);
            v[j] = (f32x4){a.x + w0 * b.x + w1 * c.x, a.y + w0 * b.y + w1 * c.y, a.z + w0 * b.z + w1 * c.z, a.w + w0 * b.w + w1 * c.w};
            s += v[j].x * v[j].x + v[j].y * v[j].y + v[j].z * v[j].z + v[j].w * v[j].w; }
        const float rstd = rsqrtf(wave_sum(s) * (1.f / D) + EPS);
        f32x4* o = (f32x4*)(out + (size_t)t * D) + lane; const f32x4* g = (const f32x4*)gain + lane;
#pragma unroll
        for (int j = 0; j < 4; ++j) { const f32x4 gg = g[64 * j]; __builtin_nontemporal_store((f32x4){v[j].x * rstd * gg.x, v[j].y * rstd * gg.y, v[j].z * rstd * gg.z, v[j].w * rstd * gg.w}, o + 64 * j); }
    }
}

namespace fa {
typedef short bf16x8 __attribute__((ext_vector_type(8)));
typedef __bf16 bfv8 __attribute__((ext_vector_type(8)));
typedef float f32x8 __attribute__((ext_vector_type(8)));
typedef float f32x16 __attribute__((ext_vector_type(16)));
typedef short s16x4 __attribute__((ext_vector_type(4)));
#define FA_MFMA(a, b, c) __builtin_amdgcn_mfma_f32_32x32x16_bf16((a), (b), (c), 0, 0, 0)
constexpr float LOG2E = 1.4426950408889634f;
constexpr float NEG_S = -1e30f, M_INIT = -1e20f;
enum { MASK_NONE = 0, MASK_CAUSAL = 1, MASK_WIN = 2, MASK_SEL = 3 };

__device__ __forceinline__ bf16x8 pack8(float a0, float a1, float a2, float a3, float a4, float a5, float a6, float a7) {
    const f32x8 v = {a0, a1, a2, a3, a4, a5, a6, a7};
    return __builtin_bit_cast(bf16x8, __builtin_convertvector(v, bfv8));
}
struct KVSrc { const bf16_t* K0; int ldk0; const bf16_t* K1; int ldk1; const bf16_t* V; int ldv; };

template <int DK, int DK0, int DVT, int KT>
struct Geo {
    static constexpr int KSTR = DK * 2 + 16, VSTR = (DVT == 64) ? 192 : (DVT * 2 + 64);
    static constexpr int KBUF = KT * KSTR, VBUF = KT * VSTR;
    static constexpr int NKC = KT * DK / 8 / 256, NVC = KT * DVT / 8 / 256;
    static constexpr int LDS_TILES = 2 * KBUF + 2 * VBUF;
    static_assert(NKC * 256 * 8 == KT * DK && NVC * 256 * 8 == KT * DVT && (VSTR / 4) % 64 % 32 == 16, "staging split / V stride");
};

template <int DK, int DK0, int DVW, int DVT, int KT, int MASK>
__device__ __forceinline__ void attn_pass(LAS unsigned char* lds, const KVSrc src, const bf16x8 (&qf)[DK / 16], f32x16 (&O)[DVW / 32], float& m, float& l,
                                          int kt_lo, int kt_hi, int qpos, int qw, int dvoff, unsigned selmask, const LAS float* biasT, float c1) {
    typedef Geo<DK, DK0, DVT, KT> G;
    const int tid = tid_(), lane = tid & 63, r = lane & 31, h = lane >> 5;
    constexpr bool UNI = (MASK == MASK_NONE) && (DK == DVT) && (DK0 == DK);
    u32x4 kreg[G::NKC]; u32x4 vreg[UNI ? 1 : G::NVC];
    const int trq = (lane & 15) >> 2, trp = lane & 3, trblk = (lane >> 4) & 1;
    const bf16_t* ubase = (tid >= 256) ? src.K0 : src.V;
    const int ustr = (tid >= 256) ? G::KSTR : G::VSTR, uoff0 = (tid >= 256) ? 0 : 2 * G::KBUF, ubufsz = (tid >= 256) ? G::KBUF : G::VBUF;
#define FA_ISSUE(k0_) do { const int k0i_ = (k0_); \
    if (UNI) { _Pragma("unroll") for (int i_ = 0; i_ < G::NKC; ++i_) { const int c_ = (tid & 255) + 256 * i_, key_ = c_ / (DK / 8), col_ = (c_ % (DK / 8)) * 8; \
        kreg[i_] = *(const u32x4*)(ubase + (size_t)(k0i_ + key_) * src.ldk0 + col_); } } \
    else if (tid >= 256) { _Pragma("unroll") for (int i_ = 0; i_ < G::NKC; ++i_) { const int c_ = (tid - 256) + 256 * i_, key_ = c_ / (DK / 8), col_ = (c_ % (DK / 8)) * 8; \
        const bf16_t* p_ = (col_ < DK0) ? src.K0 + (size_t)(k0i_ + key_) * src.ldk0 + col_ : src.K1 + (size_t)(k0i_ + key_) * src.ldk1 + (col_ - DK0); \
        kreg[i_] = *(const u32x4*)p_; } } \
    else { _Pragma("unroll") for (int i_ = 0; i_ < G::NVC; ++i_) { const int c_ = tid + 256 * i_, key_ = c_ / (DVT / 8), cc_ = c_ % (DVT / 8); \
        vreg[i_] = *(const u32x4*)(src.V + (size_t)(k0i_ + key_) * src.ldv + cc_ * 8); } } } while (0)
#define FA_COMMIT(buf_) do { LAS unsigned char* kb_ = lds + (buf_) * G::KBUF; LAS unsigned char* vb_ = lds + 2 * G::KBUF + (buf_) * G::VBUF; \
    if (UNI) { LAS unsigned char* ub_ = lds + uoff0 + (buf_) * ubufsz; _Pragma("unroll") for (int i_ = 0; i_ < G::NKC; ++i_) { const int c_ = (tid & 255) + 256 * i_, key_ = c_ / (DK / 8), cc_ = c_ % (DK / 8); \
        *(LAS u32x4*)(ub_ + key_ * ustr + cc_ * 16) = kreg[i_]; } } \
    else if (tid >= 256) { _Pragma("unroll") for (int i_ = 0; i_ < G::NKC; ++i_) { const int c_ = (tid - 256) + 256 * i_, key_ = c_ / (DK / 8), cc_ = c_ % (DK / 8); \
        *(LAS u32x4*)(kb_ + key_ * G::KSTR + cc_ * 16) = kreg[i_]; } } \
    else { _Pragma("unroll") for (int i_ = 0; i_ < G::NVC; ++i_) { const int c_ = tid + 256 * i_, key_ = c_ / (DVT / 8), cc_ = c_ % (DVT / 8); \
        *(LAS u32x4*)(vb_ + key_ * G::VSTR + cc_ * 16) = vreg[i_]; } } } while (0)
    if (kt_lo < kt_hi) { FA_ISSUE(kt_lo * KT); FA_COMMIT(0); }
    __syncthreads();
    for (int kt = kt_lo; kt < kt_hi; ++kt) {
        const int buf = (kt - kt_lo) & 1, k0 = kt * KT;
        if (kt + 1 < kt_hi) FA_ISSUE(k0 + KT);
        bool need = true, full = true;
        if (MASK == MASK_CAUSAL || MASK == MASK_SEL) { need = k0 <= qw + 31; full = (k0 + KT - 1 <= qw); }
        if (MASK == MASK_WIN) { need = (k0 <= qw + 31) && (k0 + KT - 1 >= qw - 255); full = (k0 + KT - 1 <= qw) && (k0 >= qw + 31 - 255); }
        if (need) {
            const LAS unsigned char* kb = lds + buf * G::KBUF; const LAS unsigned char* vb = lds + 2 * G::KBUF + buf * G::VBUF;
            f32x16 S[KT / 32];
#pragma unroll
            for (int mt = 0; mt < KT / 32; ++mt) {
#pragma unroll
                for (int i = 0; i < 16; ++i) S[mt][i] = 0.f;
#pragma unroll
                for (int s = 0; s < DK / 16; ++s) {
                    const bf16x8 a = *(const LAS bf16x8*)(kb + (32 * mt + r) * G::KSTR + (2 * s + h) * 16);
                    __builtin_amdgcn_s_setprio(1); S[mt] = FA_MFMA(a, qf[s], S[mt]); __builtin_amdgcn_s_setprio(0);
                }
            }
            const bool hasbias = (MASK == MASK_WIN || MASK == MASK_SEL);
            const bool near = hasbias && (qw - (k0 + KT - 1) < 127);
            const bool selok = (MASK == MASK_SEL) ? (((selmask >> (k0 >> 6)) & 1u) != 0u) : true;
            const float bfar = hasbias ? biasT[256] : 0.f;
            float tmax = NEG_S;
            bool raw = false;
            float c1e = c1, be = 0.f;
            if (full && !near) {
                raw = true;
                if (hasbias) be = bfar;
                if (MASK == MASK_SEL) { c1e = selok ? c1 : 0.f; be = selok ? be : NEG_S; }
#pragma unroll
                for (int mt = 0; mt < KT / 32; ++mt)
#pragma unroll
                    for (int i = 0; i < 16; ++i) tmax = fmaxf(tmax, S[mt][i]);
                tmax = tmax * c1e + be;
            } else if (hasbias) {
                const LAS float* tb = biasT + (383 - (qpos - k0 - 4 * h));
#pragma unroll
                for (int mt = 0; mt < KT / 32; ++mt)
#pragma unroll
                    for (int i = 0; i < 16; ++i) {
                        float v = S[mt][i] * c1 + tb[32 * mt + (i & 3) + 8 * (i >> 2)];
                        if (MASK == MASK_SEL) v = selok ? v : NEG_S;
                        v = fmaxf(v, NEG_S);
                        S[mt][i] = v; tmax = fmaxf(tmax, v);
                    }
            } else {
                const int qrel = qpos - k0 - 4 * h;
#pragma unroll
                for (int mt = 0; mt < KT / 32; ++mt)
#pragma unroll
                    for (int i = 0; i < 16; ++i) {
                        const int dist = qrel - (32 * mt + (i & 3) + 8 * (i >> 2));
                        bool ok = selok;
                        if (MASK != MASK_NONE) ok = ok && (dist >= 0);
                        if (MASK == MASK_WIN) ok = ok && (dist < 256);
                        float b = 0.f;
                        if (hasbias) { const int di = dist < 0 ? 0 : (dist > 127 ? 127 : dist); b = biasT[di]; }
                        const float v = ok ? S[mt][i] * c1 + b : NEG_S;
                        S[mt][i] = v; tmax = fmaxf(tmax, v);
                    }
            }
            tmax = xhalf_max(tmax);
            const float mn = fmaxf(m, tmax);
            const bool moved = mn > m;
            float ps = 0.f;
            if (raw) {
                const float kk = be - mn;
#pragma unroll
                for (int mt = 0; mt < KT / 32; ++mt)
#pragma unroll
                    for (int i = 0; i < 16; ++i) { const float pv = __builtin_amdgcn_exp2f(S[mt][i] * c1e + kk); S[mt][i] = pv; ps += pv; }
            } else {
#pragma unroll
                for (int mt = 0; mt < KT / 32; ++mt)
#pragma unroll
                    for (int i = 0; i < 16; ++i) { const float pv = __builtin_amdgcn_exp2f(S[mt][i] - mn); S[mt][i] = pv; ps += pv; }
            }
            if (__any(moved)) {
                const float alpha = __builtin_amdgcn_exp2f(m - mn);
                l *= alpha;
#pragma unroll
                for (int dt = 0; dt < DVW / 32; ++dt)
#pragma unroll
                    for (int i = 0; i < 16; ++i) O[dt][i] *= alpha;
            }
            m = mn;
            l += ps;
#pragma unroll
            for (int mt = 0; mt < KT / 32; ++mt)
#pragma unroll
                for (int s = 0; s < 2; ++s) {
                    const bf16x8 pb = pack8(S[mt][8 * s + 0], S[mt][8 * s + 1], S[mt][8 * s + 2], S[mt][8 * s + 3], S[mt][8 * s + 4], S[mt][8 * s + 5], S[mt][8 * s + 6], S[mt][8 * s + 7]);
#pragma unroll
                    for (int dt = 0; dt < DVW / 32; ++dt) {
                        const LAS unsigned char* vp = vb + (32 * mt + 16 * s + 4 * h + trq) * G::VSTR + (dvoff + 32 * dt + 16 * trblk + 4 * trp) * 2;
                        const s16x4 lo = __builtin_amdgcn_ds_read_tr16_b64_v4i16((LAS s16x4*)vp);
                        const s16x4 hi = __builtin_amdgcn_ds_read_tr16_b64_v4i16((LAS s16x4*)(vp + 8 * G::VSTR));
                        const bf16x8 av = __builtin_shufflevector(lo, hi, 0, 1, 2, 3, 4, 5, 6, 7);
                        O[dt] = FA_MFMA(av, pb, O[dt]);
                    }
                }
        }
        if (kt + 1 < kt_hi) FA_COMMIT(buf ^ 1);
        __syncthreads();
    }
#undef FA_ISSUE
#undef FA_COMMIT
}

__device__ __forceinline__ bf16x8 ld8f(const float* p) { const f32x4 a = *(const f32x4*)p, b = *(const f32x4*)(p + 4); return pack8(a.x, a.y, a.z, a.w, b.x, b.y, b.z, b.w); }

__device__ __forceinline__ int next_unit(unsigned* ctr, volatile LAS unsigned* uw) {
    __syncthreads();
    if (threadIdx.x == 0) *uw = atomicAdd(ctr, 1u);
    __syncthreads();
    return (int)*uw;
}
constexpr int LDS_BIAS = 98304, LDS_UW = 98304 + 2048 + 64;

__device__ __forceinline__ void mla_unit(LAS unsigned char* lds, int qb, int bh, const bf16_t* qmla, const bf16_t* kvmb, const bf16_t* krb, const float* rope, float* ycat) {
    const int tid = tid_(), lane = tid & 63, wave = tid >> 6, r = lane & 31, h = lane >> 5;
    {
        const int b = bh / 6, hd = bh % 6;
        const int qw = qb * 256 + wave * 32, qpos = qw + r;
        const bf16_t* qp = qmla + (size_t)(b * SEQ + qpos) * 768 + hd * 96;
        bf16x8 qf[6];
#pragma unroll
        for (int s = 0; s < 4; ++s) qf[s] = *(const bf16x8*)(qp + 16 * s + 8 * h);
        {
            const u32x4 r1 = *(const u32x4*)(qp + 64 + 8 * h), r2 = *(const u32x4*)(qp + 80 + 8 * h);
            const f32x4 x1a = {bflo(r1.x), bfhi(r1.x), bflo(r1.y), bfhi(r1.y)}, x1b = {bflo(r1.z), bfhi(r1.z), bflo(r1.w), bfhi(r1.w)};
            const f32x4 x2a = {bflo(r2.x), bfhi(r2.x), bflo(r2.y), bfhi(r2.y)}, x2b = {bflo(r2.z), bfhi(r2.z), bflo(r2.w), bfhi(r2.w)};
            const float* cs = rope + qpos * 16 + 8 * h; const float* sn = rope + SEQ * 16 + qpos * 16 + 8 * h;
            const f32x4 ca = *(const f32x4*)cs, cb = *(const f32x4*)(cs + 4), sa = *(const f32x4*)sn, sb = *(const f32x4*)(sn + 4);
            qf[4] = pack8(x1a.x * ca.x - x2a.x * sa.x, x1a.y * ca.y - x2a.y * sa.y, x1a.z * ca.z - x2a.z * sa.z, x1a.w * ca.w - x2a.w * sa.w,
                          x1b.x * cb.x - x2b.x * sb.x, x1b.y * cb.y - x2b.y * sb.y, x1b.z * cb.z - x2b.z * sb.z, x1b.w * cb.w - x2b.w * sb.w);
            qf[5] = pack8(x2a.x * ca.x + x1a.x * sa.x, x2a.y * ca.y + x1a.y * sa.y, x2a.z * ca.z + x1a.z * sa.z, x2a.w * ca.w + x1a.w * sa.w,
                          x2b.x * cb.x + x1b.x * sb.x, x2b.y * cb.y + x1b.y * sb.y, x2b.z * cb.z + x1b.z * sb.z, x2b.w * cb.w + x1b.w * sb.w);
        }
        KVSrc src; src.K0 = kvmb + (size_t)b * SEQ * 768 + hd * 128; src.ldk0 = 768; src.K1 = krb + (size_t)b * SEQ * 32; src.ldk1 = 32; src.V = kvmb + (size_t)b * SEQ * 768 + hd * 128 + 64; src.ldv = 768;
        f32x16 O[2];
#pragma unroll
        for (int dt = 0; dt < 2; ++dt)
#pragma unroll
            for (int i = 0; i < 16; ++i) O[dt][i] = 0.f;
        float m = M_INIT, l = 0.f;
        attn_pass<96, 64, 64, 64, 64, MASK_CAUSAL>(lds, src, qf, O, m, l, 0, (qb + 1) * 4, qpos, qw, 0, 0u, nullptr, 0.10206207261596575f * LOG2E);
        const float inv = 1.f / xhalf_sum(l);
        float* op = ycat + (size_t)(b * SEQ + qpos) * D + 256 + hd * 64;
#pragma unroll
        for (int dt = 0; dt < 2; ++dt)
#pragma unroll
            for (int g = 0; g < 4; ++g)
                *(f32x4*)(op + 32 * dt + 8 * g + 4 * h) = (f32x4){O[dt][4 * g] * inv, O[dt][4 * g + 1] * inv, O[dt][4 * g + 2] * inv, O[dt][4 * g + 3] * inv};
    }
}

__device__ __forceinline__ void selwin_unit(LAS unsigned char* lds, int qb, int bh, const float* proj, const bf16_t* nqb, const bf16_t* nkvb, const float* impp, const float* relb, float* ycat) {
    const int tid = tid_(), lane = tid & 63, wave = tid >> 6, r = lane & 31, h = lane >> 5;
    LAS float* biasT = (LAS float*)(lds + LDS_BIAS);
    {
        const int b = bh / 6, hh = bh % 6, g = hh / 3;
        { const int dist = 383 - tid; biasT[tid] = (dist < 0 || dist >= 256) ? NEG_S : relb[t5_bucket(dist > 127 ? 127 : dist) * 6 + hh] * LOG2E; }
        const int qw = qb * 256 + wave * 32, qpos = qw + r;
        const size_t trow = (size_t)(b * SEQ + qpos);
        const bf16_t* qp = nqb + trow * 384 + hh * 64;
        bf16x8 qf[4];
#pragma unroll
        for (int s = 0; s < 4; ++s) qf[s] = *(const bf16x8*)(qp + 16 * s + 8 * h);
        const unsigned selmask = nsa_topk_mask(impp + ((size_t)(b * 6 + g * 3) * 32) * SEQ + qpos, qpos >> 6);
        const bf16_t* kvb = nkvb + (size_t)b * SEQ * 768 + g * 64;
        f32x16 O[2], Os[2];
        float m, l;
        KVSrc src; src.K1 = nullptr; src.ldk1 = 0; src.ldk0 = 768; src.ldv = 768;
#pragma unroll
        for (int dt = 0; dt < 2; ++dt)
#pragma unroll
            for (int i = 0; i < 16; ++i) O[dt][i] = 0.f;
        m = M_INIT; l = 0.f;
        src.K0 = kvb + 2 * 128; src.V = kvb + 3 * 128;
        attn_pass<64, 64, 64, 64, 64, MASK_SEL>(lds, src, qf, O, m, l, 0, (qb + 1) * 4, qpos, qw, 0, selmask, biasT, 0.125f * LOG2E);
        {
            const float gs = sigmoidf_(proj[trow * INLD + O_NG + 6 + hh]) / xhalf_sum(l);
#pragma unroll
            for (int dt = 0; dt < 2; ++dt)
#pragma unroll
                for (int i = 0; i < 16; ++i) { Os[dt][i] = O[dt][i] * gs; O[dt][i] = 0.f; }
        }
        m = M_INIT; l = 0.f;
        src.K0 = kvb + 4 * 128; src.V = kvb + 5 * 128;
        attn_pass<64, 64, 64, 64, 64, MASK_WIN>(lds, src, qf, O, m, l, qb > 0 ? qb * 4 - 4 : 0, (qb + 1) * 4, qpos, qw, 0, 0u, biasT, 0.125f * LOG2E);
        const float gwn = sigmoidf_(proj[trow * INLD + O_NG + 12 + hh]) / xhalf_sum(l);
        float* op = ycat + trow * D + 640 + hh * 64;
#pragma unroll
        for (int dt = 0; dt < 2; ++dt)
#pragma unroll
            for (int gq = 0; gq < 4; ++gq) {
                float* o4 = op + 32 * dt + 8 * gq + 4 * h;
                const f32x4 old = *(const f32x4*)o4;
                *(f32x4*)o4 = (f32x4){old.x + Os[dt][4 * gq] + O[dt][4 * gq] * gwn, old.y + Os[dt][4 * gq + 1] + O[dt][4 * gq + 1] * gwn,
                                      old.z + Os[dt][4 * gq + 2] + O[dt][4 * gq + 2] * gwn, old.w + Os[dt][4 * gq + 3] + O[dt][4 * gq + 3] * gwn};
            }
    }
}

__device__ __forceinline__ void ph_attn_merged(LAS unsigned char* lds, unsigned* ctr, const bf16_t* qmla, const bf16_t* kvmb, const bf16_t* krb, const float* rope,
                                               const float* proj, const bf16_t* nqb, const bf16_t* nkvb, const float* impp, const float* relb, float* ycat) {
    volatile LAS unsigned* uw = (volatile LAS unsigned*)(lds + LDS_UW);
    for (;;) {
        const int u = next_unit(ctr, uw);
        if (u >= 16 * 48) break;
        const int grp = u / 48, bh = u % 48;
        const unsigned code = (unsigned)((0x7654736251430210ull >> (4 * (15 - grp))) & 0xfull);
        const bool is_mla = ((0x0ab7u >> (15 - grp)) & 1u) != 0u;
        if (is_mla) mla_unit(lds, (int)code, bh, qmla, kvmb, krb, rope, ycat);
        else selwin_unit(lds, (int)code, bh, proj, nqb, nkvb, impp, relb, ycat);
    }
}

__device__ __forceinline__ void ph_xattn_mfma(LAS unsigned char* lds, int nblk, const bf16_t* qx, const bf16_t* kvxb, bf16_t* oxb) {
    const int tid = tid_(), lane = tid & 63, wave = tid >> 6, r = lane & 31, h = lane >> 5;
    if ((int)blockIdx.x >= nblk) return;
    for (int u = (int)blockIdx.x; u < (T / 128) * 4; u += nblk) {
        const int hd = u & 3, tt = u >> 2, t0 = tt * 128, b = t0 >> 11;
        const int qw = t0 + (wave & 3) * 32, qrow = qw + r, dvoff = (wave >> 2) * 128;
        const bf16_t* qp = qx + (size_t)qrow * D + hd * 256;
        bf16x8 qf[16];
#pragma unroll
        for (int s = 0; s < 16; ++s) qf[s] = *(const bf16x8*)(qp + 16 * s + 8 * h);
        KVSrc src; src.K0 = kvxb + (size_t)(b * 256) * 2048 + hd * 256; src.ldk0 = 2048; src.K1 = nullptr; src.ldk1 = 0; src.V = src.K0 + 1024; src.ldv = 2048;
        f32x16 O[4];
#pragma unroll
        for (int dt = 0; dt < 4; ++dt)
#pragma unroll
            for (int i = 0; i < 16; ++i) O[dt][i] = 0.f;
        float m = M_INIT, l = 0.f;
        attn_pass<256, 256, 128, 256, 64, MASK_NONE>(lds, src, qf, O, m, l, 0, 4, 0, 0, dvoff, 0u, nullptr, 0.0625f * LOG2E);
        const float inv = 1.f / xhalf_sum(l);
        bf16_t* op = oxb + (size_t)qrow * D + hd * 256 + dvoff;
#pragma unroll
        for (int dt = 0; dt < 4; ++dt)
#pragma unroll
            for (int g = 0; g < 4; ++g)
                *(u32x2*)(op + 32 * dt + 8 * g + 4 * h) = (u32x2){pk_bf16(O[dt][4 * g] * inv, O[dt][4 * g + 1] * inv), pk_bf16(O[dt][4 * g + 2] * inv, O[dt][4 * g + 3] * inv)};
    }
}
}

__device__ __forceinline__ void ph_pe_bias(const Params& p, float* peb) {
    GT_DECL
    const int gwv = (tid >> 6) * (int)gridDim.x + (int)blockIdx.x;
    for (int w = gwv; w < 2 * 2 * 64; w += NW) {
        const int c = w & 63, lj = w >> 6;
        const float* pe = p.in[IN_NPE] + (size_t)lj * 2048; const float* w1 = p.in[IN_NW1] + (size_t)lj * 2048 * 64 + c;
        float acc = 0.f;
        for (int i = 0; i < 32; ++i) { const int k = lane + 64 * i; acc += pe[k] * w1[(size_t)k * 64]; }
        acc = wave_sum(acc);
        if (lane == 0) peb[w] = acc;
    }
}
__device__ __forceinline__ void ph_cmp_mfma(const Params& p, int l, const bf16_t* nkvb, const bf16_t* w1t, const float* peb, bf16_t* kcb, bf16_t* vct, LAS unsigned char* lds) {
    const int tid = tid_(), lane = tid & 63, r = lane & 31, h = lane >> 5, wave = tid >> 6;
    LAS float* red = (LAS float*)lds;
    for (int u = (int)blockIdx.x; u < 128; u += (int)gridDim.x) {
        const int rt = u & 3, g = (u >> 2) & 1, b = (u >> 3) & 7, j = u >> 6;
        const int n = rt * 32 + r, nc = n < NBC ? n : NBC - 1;
        const bf16_t* xrow = nkvb + (size_t)(b * SEQ + nc * 16) * 768 + j * 128 + g * 64;
        const bf16_t* w1 = w1t + (size_t)j * 64 * 2048;
        fa::f32x16 acc[2];
#pragma unroll
        for (int ct = 0; ct < 2; ++ct)
#pragma unroll
            for (int i = 0; i < 16; ++i) acc[ct][i] = 0.f;
#pragma unroll 2
        for (int pp = 0; pp < 4; ++pp) {
            const int pos = wave * 4 + pp;
#pragma unroll
            for (int s4 = 0; s4 < 4; ++s4) {
                const bf16x8_t bfr = *(const bf16x8_t*)(xrow + (size_t)pos * 768 + s4 * 16 + 8 * h);
                const int kk = pos * 64 + s4 * 16 + 8 * h;
#pragma unroll
                for (int ct = 0; ct < 2; ++ct) {
                    const bf16x8_t afr = *(const bf16x8_t*)(w1 + (size_t)(32 * ct + r) * 2048 + kk);
                    acc[ct] = FA_MFMA(afr, bfr, acc[ct]);
                }
            }
        }
        __syncthreads();
#pragma unroll
        for (int ct = 0; ct < 2; ++ct)
#pragma unroll
            for (int i = 0; i < 16; ++i) red[((wave * 2 + ct) * 16 + i) * 64 + lane] = acc[ct][i];
        __syncthreads();
        if (wave != 0) continue;
#pragma unroll 1
        for (int w8 = 1; w8 < 8; ++w8) {
#pragma unroll
            for (int ct = 0; ct < 2; ++ct)
#pragma unroll
                for (int i = 0; i < 16; ++i) acc[ct][i] += red[((w8 * 2 + ct) * 16 + i) * 64 + lane];
        }
        const float* pb = peb + (l * 2 + j) * 64;
#pragma unroll
        for (int ct = 0; ct < 2; ++ct)
#pragma unroll
            for (int g4 = 0; g4 < 4; ++g4) {
                const f32x4 bv = *(const f32x4*)(pb + 32 * ct + 8 * g4 + 4 * h);
                acc[ct][4 * g4 + 0] = gelu_tanh(acc[ct][4 * g4 + 0] + bv.x); acc[ct][4 * g4 + 1] = gelu_tanh(acc[ct][4 * g4 + 1] + bv.y);
                acc[ct][4 * g4 + 2] = gelu_tanh(acc[ct][4 * g4 + 2] + bv.z); acc[ct][4 * g4 + 3] = gelu_tanh(acc[ct][4 * g4 + 3] + bv.w);
            }
        const float* w2 = p.in[IN_NW2] + (size_t)(l * 2 + j) * 64 * 64;
        fa::f32x16 o[2];
#pragma unroll
        for (int ct = 0; ct < 2; ++ct)
#pragma unroll
            for (int i = 0; i < 16; ++i) o[ct][i] = 0.f;
#pragma unroll
        for (int ct = 0; ct < 2; ++ct)
#pragma unroll
            for (int s = 0; s < 2; ++s) {
                const bf16x8_t pbk = pack8f(acc[ct][8 * s + 0], acc[ct][8 * s + 1], acc[ct][8 * s + 2], acc[ct][8 * s + 3], acc[ct][8 * s + 4], acc[ct][8 * s + 5], acc[ct][8 * s + 6], acc[ct][8 * s + 7]);
#pragma unroll
                for (int ct2 = 0; ct2 < 2; ++ct2) {
                    const float* wp = w2 + (size_t)(32 * ct + 16 * s + 4 * h) * 64 + 32 * ct2 + r;
                    const bf16x8_t afr = pack8f(wp[0], wp[64], wp[128], wp[192], wp[512], wp[576], wp[640], wp[704]);
                    o[ct2] = FA_MFMA(afr, pbk, o[ct2]);
                }
            }
        const bool valid = n < NBC;
        if (j == 0) {
            bf16_t* kr = kcb + ((size_t)(b * 2 + g) * 128 + n) * 64;
#pragma unroll
            for (int ct2 = 0; ct2 < 2; ++ct2)
#pragma unroll
                for (int g4 = 0; g4 < 4; ++g4)
                    *(u32x2*)(kr + 32 * ct2 + 8 * g4 + 4 * h) = valid ? (u32x2){pk_bf16(o[ct2][4 * g4], o[ct2][4 * g4 + 1]), pk_bf16(o[ct2][4 * g4 + 2], o[ct2][4 * g4 + 3])} : (u32x2){0u, 0u};
        } else {
            bf16_t* vc = vct + (size_t)(b * 2 + g) * 64 * 128 + n;
#pragma unroll
            for (int ct2 = 0; ct2 < 2; ++ct2)
#pragma unroll
                for (int i = 0; i < 16; ++i) vc[(size_t)(32 * ct2 + (i & 3) + 8 * (i >> 2) + 4 * h) * 128] = valid ? f2bf(o[ct2][i]) : (bf16_t)0;
        }
    }
}
constexpr int LDS_CBIAS = 135168;
__device__ __forceinline__ void ph_nsa_cmp_mfma(const Params& p, const float* proj, const bf16_t* nqb, const bf16_t* kcb, const bf16_t* vct, float* impp, float* ycat, LAS unsigned char* lds) {
    const int tid = tid_(), lane = tid & 63, wave = tid >> 6;
    const int r = lane & 31, h = lane >> 5;
    LAS float* bt = (LAS float*)(lds + LDS_CBIAS);
    constexpr int KS = 144, VS = 264;
    LAS unsigned char* kl = lds;
    LAS unsigned char* vl = lds + 18432;
    for (int i = tid; i < 768; i += NTHR) bt[i] = p.in[IN_RELB][t5_bucket(i & 127) * 6 + (i >> 7)] * fa::LOG2E;
    for (int bu = (int)((blockIdx.x + 64u) % gridDim.x); bu < NB * 6 * 8; bu += (int)gridDim.x) {
        const int q8 = bu & 7, bh = bu >> 3, hh = bh % 6, b = bh / 6, g = hh / 3;
        __syncthreads();
        {
            const bf16_t* ksrc = kcb + (size_t)(b * 2 + g) * 128 * 64; const bf16_t* vsrc = vct + (size_t)(b * 2 + g) * 64 * 128;
#pragma unroll
            for (int i = 0; i < 2; ++i) { const int c = tid + 512 * i, row = c >> 3, cc = c & 7;
                *(LAS u32x4*)(kl + row * KS + cc * 16) = *(const u32x4*)(ksrc + (size_t)row * 64 + cc * 8); }
#pragma unroll
            for (int i = 0; i < 2; ++i) { const int c = tid + 512 * i, row = c >> 4, cc = c & 15;
                *(LAS u32x4*)(vl + row * VS + cc * 16) = *(const u32x4*)(vsrc + (size_t)row * 128 + cc * 8); }
        }
        const int qg = q8 * 8 + wave;
        const int s = qg * 32 + r; const size_t t = (size_t)b * SEQ + s;
        const bf16_t* qp = nqb + t * 384 + hh * 64;
        bf16x8_t qf[4];
#pragma unroll
        for (int ks = 0; ks < 4; ++ks) qf[ks] = *(const bf16x8_t*)(qp + 16 * ks + 8 * h);
        const float gate_logit = proj[t * INLD + O_NG + hh];
        __syncthreads();
        fa::f32x16 S[4];
#pragma unroll
        for (int mt = 0; mt < 4; ++mt) {
#pragma unroll
            for (int i = 0; i < 16; ++i) S[mt][i] = 0.f;
#pragma unroll
            for (int ks = 0; ks < 4; ++ks) {
                const bf16x8_t a = *(const LAS bf16x8_t*)(kl + (32 * mt + r) * KS + (2 * ks + h) * 16);
                S[mt] = FA_MFMA(a, qf[ks], S[mt]);
            }
        }
        const LAS float* bth = bt + hh * 128;
        const int qrel = s - 31 - 64 * h;
        float tmax = fa::NEG_S;
#pragma unroll
        for (int mt = 0; mt < 4; ++mt)
#pragma unroll
            for (int i = 0; i < 16; ++i) {
                const int dist = qrel - 16 * (32 * mt + (i & 3) + 8 * (i >> 2));
                const int di = dist < 0 ? 0 : (dist > 127 ? 127 : dist);
                const float v = dist >= 0 ? S[mt][i] * (0.125f * fa::LOG2E) + bth[di] : fa::NEG_S;
                S[mt][i] = v; tmax = fmaxf(tmax, v);
            }
        tmax = xhalf_max(tmax);
        const float mx = fmaxf(tmax, fa::M_INIT);
        float ps = 0.f;
#pragma unroll
        for (int mt = 0; mt < 4; ++mt)
#pragma unroll
            for (int i = 0; i < 16; ++i) { const float pv = __builtin_amdgcn_exp2f(S[mt][i] - mx); S[mt][i] = pv; ps += pv; }
        ps = xhalf_sum(ps);
        const float inv = ps > 0.f ? 1.f / ps : 0.f;
        {
            float own[16]; float prev = 0.f;
#pragma unroll
            for (int mt = 0; mt < 4; ++mt)
#pragma unroll
                for (int g4 = 0; g4 < 4; ++g4) {
                    const float qs = (S[mt][4 * g4] + S[mt][4 * g4 + 1]) + (S[mt][4 * g4 + 2] + S[mt][4 * g4 + 3]);
                    const auto sw = __builtin_amdgcn_permlane32_swap(__float_as_uint(S[mt][4 * g4 + 3]), __float_as_uint(S[mt][4 * g4 + 3]), false, false);
                    const float rl = __uint_as_float(h ? sw[0] : sw[1]);
                    const float extra = h ? rl : prev;
                    prev = rl;
                    own[4 * mt + g4] = (qs + extra) * inv;
                }
            float* ip = impp + ((size_t)(b * 6 + hh) * 32) * SEQ + s;
#pragma unroll
            for (int j = 0; j < 16; ++j) ip[(size_t)(2 * j + h) * SEQ] = own[j];
        }
        fa::f32x16 O[2];
#pragma unroll
        for (int dt = 0; dt < 2; ++dt)
#pragma unroll
            for (int i = 0; i < 16; ++i) O[dt][i] = 0.f;
#pragma unroll
        for (int mt = 0; mt < 4; ++mt)
#pragma unroll
            for (int s2 = 0; s2 < 2; ++s2) {
                const bf16x8_t pbk = pack8f(S[mt][8 * s2 + 0], S[mt][8 * s2 + 1], S[mt][8 * s2 + 2], S[mt][8 * s2 + 3], S[mt][8 * s2 + 4], S[mt][8 * s2 + 5], S[mt][8 * s2 + 6], S[mt][8 * s2 + 7]);
#pragma unroll
                for (int dt = 0; dt < 2; ++dt) {
                    const LAS unsigned char* vp = vl + (32 * dt + r) * VS + (32 * mt + 16 * s2 + 4 * h) * 2;
                    const u32x2 lo = *(const LAS u32x2*)vp, hi = *(const LAS u32x2*)(vp + 16);
                    const u32x4 av = {lo.x, lo.y, hi.x, hi.y};
                    O[dt] = FA_MFMA(__builtin_bit_cast(bf16x8_t, av), pbk, O[dt]);
                }
            }
        const float gate = sigmoidf_(gate_logit) * inv;
        float* op = ycat + t * D + 640 + hh * 64;
#pragma unroll
        for (int dt = 0; dt < 2; ++dt)
#pragma unroll
            for (int g4 = 0; g4 < 4; ++g4)
                *(f32x4*)(op + 32 * dt + 8 * g4 + 4 * h) = (f32x4){O[dt][4 * g4] * gate, O[dt][4 * g4 + 1] * gate, O[dt][4 * g4 + 2] * gate, O[dt][4 * g4 + 3] * gate};
    }
    __syncthreads();
}

__device__ __forceinline__ void cvt_layer(const Params& p, int l, int which, CvtCursor& cur, bf16_t* WB, LAS float* scr, int gwv, int nwv, int lane) {
    bf16_t* wl = WB + (size_t)l * WL_SIZE;
    if (which != 2) cvt_matrix<true>(cur, p.in[IN_XWKV] + (size_t)l * D * 2048, D, 2048, wl + WL_XWKV, D, 2048, 0, scr, gwv, nwv, lane);
    if (which == 1) return;
    cvt_matrix<false>(cur, p.in[IN_WIN] + (size_t)l * D * INC, D, INC, wl + WL_WIN, D, 1792, 0, scr, gwv, nwv, lane, l ? p.in[IN_MIXN] + D : nullptr);
    cvt_matrix<true>(cur, p.in[IN_MWUQ] + (size_t)l * 192 * 576, 192, 576, wl + WL_WUQ, 256, 768, 0, scr, gwv, nwv, lane);
    cvt_matrix<true>(cur, p.in[IN_MWUKV] + (size_t)l * 128 * 768, 128, 768, wl + WL_WUKV, 256, 768, 0, scr, gwv, nwv, lane);
    cvt_matrix<true>(cur, p.in[IN_SGLU] + (size_t)l * 256 * 256, 256, 256, wl + WL_WGLU, 256, 256, 0, scr, gwv, nwv, lane);
    cvt_matrix<true>(cur, p.in[IN_WOUT] + (size_t)l * D * D, D, D, wl + WL_WOUT, D, D, 0, scr, gwv, nwv, lane);
    cvt_matrix<true>(cur, p.in[IN_XWQ] + (size_t)l * D * D, D, D, wl + WL_XWQ, D, D, 0, scr, gwv, nwv, lane, p.in[IN_XN] + (size_t)l * D);
    cvt_matrix<true>(cur, p.in[IN_XWO] + (size_t)l * D * D, D, D, wl + WL_XWO, D, D, 0, scr, gwv, nwv, lane);
    cvt_matrix<true>(cur, p.in[IN_NW1] + (size_t)(l * 2) * 2048 * 64, 2048, 64, wl + WL_CW1, 2048, 64, 0, scr, gwv, nwv, lane);
    cvt_matrix<true>(cur, p.in[IN_NW1] + (size_t)(l * 2 + 1) * 2048 * 64, 2048, 64, wl + WL_CW1 + 64 * 2048, 2048, 64, 0, scr, gwv, nwv, lane);
}
struct DenseCvtItem { const float* src; bf16_t* dst; int N, Kpad; const float* kg; bool scale; };
__device__ __forceinline__ DenseCvtItem dense_cvt_item(const Params& p, bf16_t* WB, int g) {
    const int m = g / 1408, it = g % 1408;
    DenseCvtItem t;
    if (m < 2) { const int kb = it / 88, nb = it % 88, n0 = nb * 32; t.N = FFD; t.Kpad = D; t.kg = p.in[IN_FFN] + kb * 64; t.scale = true;
        t.src = p.in[m == 0 ? IN_DWG : IN_DWU] + (size_t)(kb * 64) * FFD + n0;
        t.dst = WB + WD_GU + (size_t)(((n0 >> 7) << 8) + (n0 & 127) + (m == 1 ? 128 : 0)) * D + kb * 64; }
    else { const int kb = it / 32, nb = it % 32; t.N = D; t.Kpad = FFD; t.kg = p.in[IN_FFN]; t.scale = false;
        t.src = p.in[IN_DWD] + (size_t)(kb * 64) * D + nb * 32;
        t.dst = WB + WD_DN + (size_t)(nb * 32) * FFD + kb * 64; }
    return t;
}
__device__ __forceinline__ void cvt_dense_batched(const Params& p, bf16_t* WB, LAS float* scr, int gwv, int nwv, int lane) {
    constexpr int NBAT = 3, hi = 3 * 1408;
    for (int g0 = gwv; g0 < hi; g0 += nwv * NBAT) {
        f32x4 v[NBAT][8]; float gk[NBAT][8];
#pragma unroll
        for (int b = 0; b < NBAT; ++b) {
            const int g = g0 + b * nwv;
            if (g < hi) { const DenseCvtItem t = dense_cvt_item(p, WB, g);
#pragma unroll
                for (int i = 0; i < 8; ++i) { v[b][i] = __builtin_nontemporal_load((const f32x4*)(t.src + (size_t)(i * 8 + (lane >> 3)) * t.N + (lane & 7) * 4)); gk[b][i] = t.kg[i * 8 + (lane >> 3)]; } }
        }
#pragma unroll
        for (int b = 0; b < NBAT; ++b) {
            const int g = g0 + b * nwv;
            if (g < hi) { const DenseCvtItem t = dense_cvt_item(p, WB, g);
#pragma unroll
                for (int i = 0; i < 8; ++i) { const int kk = i * 8 + (lane >> 3), nn = (lane & 7) * 4; const float mul = t.scale ? gk[b][i] : 1.f;
                    scr[kk * 33 + nn] = v[b][i].x * mul; scr[kk * 33 + nn + 1] = v[b][i].y * mul; scr[kk * 33 + nn + 2] = v[b][i].z * mul; scr[kk * 33 + nn + 3] = v[b][i].w * mul; }
                asm volatile("s_waitcnt lgkmcnt(0)" ::: "memory");
                const int c = lane & 7;
#pragma unroll
                for (int j = 0; j < 4; ++j) { const int n = (lane >> 3) + 8 * j; const LAS float* sp = scr + (8 * c) * 33 + n;
                    u32x4 o; o.x = pk_bf16(sp[0 * 33], sp[1 * 33]); o.y = pk_bf16(sp[2 * 33], sp[3 * 33]); o.z = pk_bf16(sp[4 * 33], sp[5 * 33]); o.w = pk_bf16(sp[6 * 33], sp[7 * 33]);
                    *(u32x4*)(t.dst + (size_t)n * t.Kpad + 8 * c) = o; }
                asm volatile("s_waitcnt lgkmcnt(0)" ::: "memory"); }
        }
    }
}
__device__ __forceinline__ void ph_convert_small(const Params& p, bf16_t* WB, LAS unsigned char* lds) {
    GT_DECL
    LAS float* scr = (LAS float*)(lds + (tid >> 6) * 16384);
    CvtCursor cur{0};
    cvt_layer(p, 0, 0, cur, WB, scr, gw, NW, lane);
    cvt_layer(p, 1, 1, cur, WB, scr, gw, NW, lane);
    cvt_dense_batched(p, WB, scr, (gw + cur.base) % NW, NW, lane);
}
__device__ __forceinline__ void ph_convert_l1(const Params& p, bf16_t* WB, LAS unsigned char* lds) {
    const int half = (int)gridDim.x / 2;
    if ((int)blockIdx.x < half) return;
    const int tid = tid_(), lane = tid & 63;
    LAS float* scr = (LAS float*)(lds + (tid >> 6) * 16384);
    CvtCursor cur{0};
    cvt_layer(p, 1, 2, cur, WB, scr, ((int)blockIdx.x - half) * (NTHR / 64) + (tid >> 6), ((int)gridDim.x - half) * (NTHR / 64), lane);
}
struct MoeCvtItem { const float* src; bf16_t* dst; int N, Kpad; };
__device__ __forceinline__ MoeCvtItem moe_cvt_item(const Params& p, bf16_t* MW, int g) {
    const int e = g / 5376, r = g % 5376, m = r / 1792, it = r % 1792;
    bf16_t* we = MW + (size_t)e * ME_SIZE;
    MoeCvtItem t;
    if (m < 2) { const int kb = it / 112, nb = it % 112, n0 = nb * 32; t.N = FFE; t.Kpad = D;
        t.src = p.in[m == 0 ? IN_MWG : IN_MWU] + (size_t)e * D * FFE + (size_t)(kb * 64) * FFE + n0;
        t.dst = we + ME_GU + (size_t)(((n0 >> 7) << 8) + (n0 & 127) + (m == 1 ? 128 : 0)) * D + kb * 64; }
    else { const int kb = it / 32, nb = it % 32; t.N = D; t.Kpad = FFE;
        t.src = p.in[IN_MWD] + (size_t)e * FFE * D + (size_t)(kb * 64) * D + nb * 32;
        t.dst = we + ME_DN + (size_t)(nb * 32) * FFE + kb * 64; }
    return t;
}
template <int NBAT>
__device__ __forceinline__ void ph_convert_moe(const Params& p, bf16_t* MW, LAS unsigned char* lds, int e_lo, int e_hi, int blk_lo) {
    const int tid = tid_(), lane = tid & 63;
    if ((int)blockIdx.x < blk_lo) return;
    const int gwv = ((int)blockIdx.x - blk_lo) * (NTHR / 64) + (tid >> 6), nwv = ((int)gridDim.x - blk_lo) * (NTHR / 64);
    LAS float* scr = (LAS float*)(lds + (tid >> 6) * 16384);
    const int hi = e_hi * 5376;
    for (int g0 = e_lo * 5376 + gwv; g0 < hi; g0 += nwv * NBAT) {
        f32x4 v[NBAT][8];
#pragma unroll
        for (int b = 0; b < NBAT; ++b) {
            const int g = g0 + b * nwv;
            if (g < hi) { const MoeCvtItem t = moe_cvt_item(p, MW, g);
#pragma unroll
                for (int i = 0; i < 8; ++i) v[b][i] = __builtin_nontemporal_load((const f32x4*)(t.src + (size_t)(i * 8 + (lane >> 3)) * t.N + (lane & 7) * 4)); }
        }
#pragma unroll
        for (int b = 0; b < NBAT; ++b) {
            const int g = g0 + b * nwv;
            if (g < hi) { const MoeCvtItem t = moe_cvt_item(p, MW, g);
#pragma unroll
                for (int i = 0; i < 8; ++i) { const int kk = i * 8 + (lane >> 3), nn = (lane & 7) * 4;
                    scr[kk * 33 + nn] = v[b][i].x; scr[kk * 33 + nn + 1] = v[b][i].y; scr[kk * 33 + nn + 2] = v[b][i].z; scr[kk * 33 + nn + 3] = v[b][i].w; }
                asm volatile("s_waitcnt lgkmcnt(0)" ::: "memory");
                const int c = lane & 7;
#pragma unroll
                for (int j = 0; j < 4; ++j) { const int n = (lane >> 3) + 8 * j; const LAS float* sp = scr + (8 * c) * 33 + n;
                    u32x4 o; o.x = pk_bf16(sp[0 * 33], sp[1 * 33]); o.y = pk_bf16(sp[2 * 33], sp[3 * 33]); o.z = pk_bf16(sp[4 * 33], sp[5 * 33]); o.w = pk_bf16(sp[6 * 33], sp[7 * 33]);
                    *(u32x4*)(t.dst + (size_t)n * t.Kpad + 8 * c) = o; }
                asm volatile("s_waitcnt lgkmcnt(0)" ::: "memory"); }
        }
    }
}

constexpr int LDS_BYTES = 143360;
constexpr int LDS_MISC = 141312;
enum { P_PRO = 0, P_PROJ0, L0_BASE, L0_GU = L0_BASE + 8, L0_DN, L1_PROJ, L1_BASE, L1_ROUTE = L1_BASE + 8, L1_SORT, M_BASE, P_FINAL = M_BASE + 2 * MOE_NR, NPHASE };

__global__ void __launch_bounds__(NTHR, 2) fwd_kernel(Params p) {
    extern __shared__ __attribute__((aligned(16))) unsigned char lds_raw[];
    LAS unsigned char* lds = (LAS unsigned char*)lds_raw;
    volatile LAS unsigned* misc = (volatile LAS unsigned*)(lds + LDS_MISC);
    if (threadIdx.x < 64) misc[threadIdx.x] = 0u;
    __syncthreads();
    unsigned char* ws = p.ws;
    unsigned* ctl = (unsigned*)(ws + WS_CTL);
    XcdBarrier bar; bar.bar = ctl + 4096; bar.x = 0; bar.st = nullptr;
    const int lo = p.ph_lo, hi = p.ph_hi;
    if (hi - lo > 1) bar = xcd_barrier_post(ctl + 4096, misc + 8);
#ifdef PROBE_MASK
    volatile LAS unsigned long long* stamps = (volatile LAS unsigned long long*)(lds + LDS_MISC + 1024);
#define PH(k) if (blockIdx.x == 0 && threadIdx.x == 0 && lo <= (k) && (k) < hi) stamps[k] = wall_clock64(); if (lo <= (k) && (k) < hi)
#else
#define PH(k) if (lo <= (k) && (k) < hi)
#endif
#define ENDPH(k) if ((k) + 1 < hi) xcd_barrier(bar);

    bf16_t* HB = (bf16_t*)(ws + WS_H);
    bf16_t* XNB = (bf16_t*)(ws + WS_XNB);
    bf16_t* CQNB = (bf16_t*)(ws + XB_CQN);
    bf16_t* CKVNB = (bf16_t*)(ws + XB_CKVN);
    bf16_t* YPREB = (bf16_t*)(ws + XB_YPRE);
    bf16_t* YCATB = (bf16_t*)(ws + WS_XNB);
    bf16_t* KVXB = (bf16_t*)(ws + WS_KVX);
    float* PROJ = (float*)(ws + BG_PROJ);
    bf16_t* NKVB = (bf16_t*)(ws + BG_NKVB);
    bf16_t* QMB = (bf16_t*)(ws + BG_QMLA);
    bf16_t* NQB = (bf16_t*)(ws + BG_NQB);
    bf16_t* KVMB = (bf16_t*)(ws + BG_KVMB);
    bf16_t* KRB = (bf16_t*)(ws + BG_KRB);
    float* YCAT = (float*)(ws + BG_YCAT);
    bf16_t* MEMNB = (bf16_t*)(ws + BG_MEMN);
    bf16_t* QXB = (bf16_t*)(ws + BG_QX);
    bf16_t* OXB = (bf16_t*)(ws + BG_OX);
    bf16_t* ACTB = (bf16_t*)(ws + BG_ACT);
    bf16_t* MACTB = (bf16_t*)(ws + MOE_ACT);
    bf16_t* YSB = (bf16_t*)(ws + MOE_YS);
    float* YS2P = (float*)(ws + MOE_YS2P);
    float* IMPP = (float*)(ws + SM_IMPP);
    float* ROPE = (float*)(ws + SM_ROPE);
    f32x2* SSME = (f32x2*)(ws + SM_SSME);
    bf16_t* KCB = (bf16_t*)(ws + SM_KC);
    bf16_t* VCT = (bf16_t*)(ws + SM_KC + 512 * 1024);
    float* PEB = (float*)(ws + SM_HID);
    unsigned* SEL = (unsigned*)(ws + SM_SEL);
    int* TOPI = (int*)(ws + SM_TOPI);
    float* TOPW = (float*)(ws + SM_TOPW);
    int* POS = (int*)(ws + SM_POS);
    int* RSRC = (int*)(ws + SM_RSRC);
    int* TEXP = (int*)(ws + SM_TEXP);
    bf16_t* WB = (bf16_t*)(ws + WS_WBS);
    bf16_t* MW = (bf16_t*)(ws + MOE_W);
#define QCTR(k) (ctl + 8192 + 64 * (k))
#define PG8_RUN_ROT(ROT, EPI_T, GATH, Aptr, Btptr, Kval, ridx, texp_, estr, nM_, nN_, pm0_, ...) do { \
    pg8::Gemm g_{Aptr, Btptr, Kval, ridx, texp_, estr}; pg8::StaticOrder S_; S_.init(nM_, nN_, (int)gridDim.x, (int)((blockIdx.x + gridDim.x - (ROT)) % gridDim.x), pm0_); \
    EPI_T E_{__VA_ARGS__}; pg8::gemm_phase<EPI_T, GATH>(lds, g_, S_, E_); } while (0)
#define PG8_RUN(...) PG8_RUN_ROT(0, __VA_ARGS__)
#define PG8_RUN_SUB(NBLK, EPI_T, GATH, Aptr, Btptr, Kval, ridx, texp_, estr, nM_, nN_, pm0_, ...) do { if ((int)blockIdx.x < (NBLK)) { \
    pg8::Gemm g_{Aptr, Btptr, Kval, ridx, texp_, estr}; pg8::StaticOrder S_; S_.init(nM_, nN_, (NBLK), (int)blockIdx.x, pm0_); \
    EPI_T E_{__VA_ARGS__}; pg8::gemm_phase<EPI_T, GATH>(lds, g_, S_, E_); } } while (0)
#define PG8_RUN_SPLITK(EPI_T, Aptr, Btptr, Kslice, ld_, nks_, texp_, estr, nM_, nNr_, pm0_, ...) do { \
    pg8::Gemm g_{Aptr, Btptr, Kslice, nullptr, texp_, estr, ld_, nks_, nNr_}; pg8::StaticOrder S_; S_.init(nM_, (nNr_) * (nks_), (int)gridDim.x, (int)blockIdx.x, pm0_); \
    EPI_T E_{__VA_ARGS__}; pg8::gemm_phase<EPI_T, false>(lds, g_, S_, E_); } while (0)

    float* SSQ = (float*)(ws + SM_KROPE);
    PH(P_PRO) {
        ph_rope_table(ROPE);
        ph_pe_bias(p, PEB);
        ph_rms(p.in[IN_MEM], p.in[IN_MEMN], MEMNB, NB * 256);
        ph_rms(p.in[IN_MEM], p.in[IN_MEMN] + D, MEMNB + (size_t)NB * 256 * D, NB * 256);
        ph_rms(p.in[IN_X], p.in[IN_MIXN], XNB, T);
        ph_convert_small(p, WB, lds);
        ENDPH(P_PRO)
    }
    PH(P_PROJ0) {
        PG8_RUN(pg8::EpiProj, false, XNB, WB + WL_WIN, D, nullptr, nullptr, 0, 64, 7, 0, PROJ, INLD, NKVB, nullptr, NQB);
        PG8_RUN_ROT(192, pg8::EpiBf16, false, MEMNB, WB + WL_XWKV, D, nullptr, nullptr, 0, 8, 8, 0, KVXB, 2048);
        ENDPH(P_PROJ0)
    }
#define LAYER_BODY(l, B0, HIN, XO_EPI, EXTRA_XQ, XATT) \
    PH(B0 + 0) { ph_mla_prep(PROJ, p.in[IN_MQN] + (l) * 192, p.in[IN_MKVN] + (l) * 128, ROPE, CQNB, CKVNB, KRB); ph_ssm1(p, l, PROJ, SSME, lds); ph_cmp_mfma(p, l, NKVB, WB + (size_t)(l) * WL_SIZE + WL_CW1, PEB, KCB, VCT, lds); ENDPH(B0 + 0) } \
    PH(B0 + 1) { PG8_RUN(pg8::EpiBf16, false, CQNB, WB + (size_t)(l) * WL_SIZE + WL_WUQ, 256, nullptr, nullptr, 0, 64, 3, 0, QMB, 768); \
                 PG8_RUN_ROT(64, pg8::EpiBf16, false, CKVNB, WB + (size_t)(l) * WL_SIZE + WL_WUKV, 256, nullptr, nullptr, 0, 64, 3, 0, KVMB, 768); \
                 ph_nsa_cmp_mfma(p, PROJ, NQB, KCB, VCT, IMPP, YCAT, lds); ph_ssm2(p, l, PROJ, SSME, YPREB, lds); ENDPH(B0 + 1) } \
    PH(B0 + 2) { PG8_RUN(pg8::EpiGlu, false, YPREB, WB + (size_t)(l) * WL_SIZE + WL_WGLU, 256, nullptr, nullptr, 0, 64, 1, 0, YCAT, D, YPREB); KVX1_HERE \
                 fa::ph_attn_merged(lds, QCTR(3 * (l)), QMB, KVMB, KRB, ROPE, PROJ, NQB, NKVB, IMPP, p.in[IN_RELB], YCAT); ENDPH(B0 + 2) } \
    PH(B0 + 3) { ph_group_norm(YCAT, p.in[IN_OUTN] + (l) * D, YCATB); ENDPH(B0 + 3) } \
    PH(B0 + 4) { PG8_RUN(pg8::EpiResNorm, false, YCATB, WB + (size_t)(l) * WL_SIZE + WL_WOUT, D, nullptr, nullptr, 0, 64, 4, 0, HB, HIN, D, SSQ); ENDPH(B0 + 4) } \
    PH(B0 + 5) { EXTRA_XQ ENDPH(B0 + 5) } \
    PH(B0 + 6) { XATT ENDPH(B0 + 6) } \
    PH(B0 + 7) { XO_EPI ENDPH(B0 + 7) }

#define KVX1_HERE PG8_RUN_ROT(64, pg8::EpiBf16, false, MEMNB + (size_t)NB * 256 * D, WB + WL_SIZE + WL_XWKV, D, nullptr, nullptr, 0, 8, 8, 0, KVXB + (size_t)2048 * 2048, 2048);
    LAYER_BODY(0, L0_BASE, p.in[IN_X], PG8_RUN(pg8::EpiResNorm, false, OXB, WB + WL_XWO, D, nullptr, nullptr, 0, 64, 4, 0, HB, nullptr, D, SSQ);, PG8_RUN(pg8::EpiBf16, false, HB, WB + WL_XWQ, D, nullptr, nullptr, 0, 64, 4, 0, QXB, D, SSQ);,
               fa::ph_xattn_mfma(lds, (int)gridDim.x, QXB, KVXB, OXB);)
    PH(L0_GU) { PG8_RUN(pg8::EpiSwiglu, false, HB, WB + WD_GU, D, nullptr, nullptr, 0, 64, 22, 0, ACTB, FFD, 0, SSQ); ph_convert_l1(p, WB, lds); ENDPH(L0_GU) }
    PH(L0_DN) { PG8_RUN(pg8::EpiResNorm, false, ACTB, WB + WD_DN, FFD, nullptr, nullptr, 0, 64, 4, 0, HB, nullptr, D, SSQ); ENDPH(L0_DN) }
    PH(L1_PROJ) { PG8_RUN(pg8::EpiProj, false, HB, WB + WL_SIZE + WL_WIN, D, nullptr, nullptr, 0, 64, 7, 0, PROJ, INLD, NKVB, SSQ, NQB);
                  ph_convert_moe<4>(p, MW, lds, 7, NE, (int)gridDim.x * 3 / 4); ENDPH(L1_PROJ) }
#undef KVX1_HERE
#define KVX1_HERE
    LAYER_BODY(1, L1_BASE, nullptr,
               PG8_RUN(pg8::EpiResNorm, false, OXB, WB + WL_SIZE + WL_XWO, D, nullptr, nullptr, 0, 64, 4, 0, HB, nullptr, D, nullptr);,
               PG8_RUN_SUB((int)gridDim.x / 2, pg8::EpiBf16, false, HB, WB + WL_SIZE + WL_XWQ, D, nullptr, nullptr, 0, 64, 4, 0, QXB, D, SSQ); ph_convert_moe<4>(p, MW, lds, 0, 4, (int)gridDim.x / 2);,
               fa::ph_xattn_mfma(lds, ((int)gridDim.x * 2 + 2) / 3, QXB, KVXB + (size_t)2048 * 2048, OXB); ph_convert_moe<4>(p, MW, lds, 4, 7, ((int)gridDim.x * 2 + 2) / 3);)
    PH(L1_ROUTE) { ph_moe_route(HB, p.in[IN_FFN] + D, p.in[IN_ROUTER], XNB, TOPI, TOPW, TEXP + 1024, (LAS int*)lds); ENDPH(L1_ROUTE) }
    PH(L1_SORT) { ph_moe_sort((LAS int*)lds, TOPI, TEXP + 1024, POS, RSRC, TEXP); ENDPH(L1_SORT) }
#define MOE_ROUND(r) \
    PH(M_BASE + 2 * (r)) { const int ntl_ = TEXP[160] - (r) * MOE_RT; const int nm_ = ntl_ < 0 ? 0 : (ntl_ > MOE_RT ? MOE_RT : ntl_); \
        PG8_RUN(pg8::EpiSwiglu, true, XNB, MW + ME_GU, D, RSRC, TEXP, ME_SIZE, nm_, 28, (r) * MOE_RT, MACTB, FFE, (r) * MOE_RT * 256, nullptr); ENDPH(M_BASE + 2 * (r)) } \
    PH(M_BASE + 1 + 2 * (r)) { const int ntl_ = TEXP[160] - (r) * MOE_RT; const int nm_ = ntl_ < 0 ? 0 : (ntl_ > MOE_RT ? MOE_RT : ntl_); \
        PG8_RUN(pg8::EpiBf16, false, MACTB - (size_t)(r) * MOE_RT * 256 * FFE, MW + ME_DN, FFE, nullptr, TEXP, ME_SIZE, nm_, 4, (r) * MOE_RT, YSB, D); ENDPH(M_BASE + 1 + 2 * (r)) }
    MOE_ROUND(0) MOE_ROUND(1)
    PH(M_BASE + 4) { const int ntl_ = TEXP[160] - 2 * MOE_RT; const int nm_ = ntl_ < 0 ? 0 : (ntl_ > MOE_RT ? MOE_RT : ntl_);
        PG8_RUN(pg8::EpiSwiglu, true, XNB, MW + ME_GU, D, RSRC, TEXP, ME_SIZE, nm_, 28, 2 * MOE_RT, MACTB, FFE, 2 * MOE_RT * 256, nullptr);
        ph_moe_combine(HB, YSB, YS2P, POS, TOPW, p.in[IN_FINAL], p.out, nm_ * 28, 0, T / 2, false, 0, false, false); ENDPH(M_BASE + 4) }
    PH(M_BASE + 5) { const int ntl_ = TEXP[160] - 2 * MOE_RT; const int nm_ = ntl_ < 0 ? 0 : (ntl_ > MOE_RT ? MOE_RT : ntl_);
        PG8_RUN_SPLITK(pg8::EpiF32Slab, MACTB - (size_t)2 * MOE_RT * 256 * FFE, MW + ME_DN, FFE / 4, FFE, 4, TEXP, ME_SIZE, nm_, 4, 2 * MOE_RT, YS2P, D, (size_t)2048 * D, 2 * MOE_RT * 256);
        ph_moe_combine(HB, YSB, YS2P, POS, TOPW, p.in[IN_FINAL], p.out, nm_ * 16, T / 2, T, false, 0, false, false); ENDPH(M_BASE + 5) }
    PH(P_FINAL) { const int ntl_ = TEXP[160] - 2 * MOE_RT; const int nm_ = ntl_ < 0 ? 0 : (ntl_ > MOE_RT ? MOE_RT : ntl_);
        ph_moe_combine(HB, YSB, YS2P, POS, TOPW, p.in[IN_FINAL], p.out, 0, 0, T, true, T / 2, nm_ * 28 < (int)gridDim.x, nm_ * 16 < (int)gridDim.x); }
#ifdef PROBE_MASK
    if (blockIdx.x == 0 && threadIdx.x == 0 && hi == NPHASE && lo == 0) {
        const unsigned long long now = wall_clock64(); stamps[NPHASE] = now;
        unsigned long long tot = 0;
        for (int k = 0; k < NPHASE; ++k) if ((PROBE_MASK >> k) & 1ull) tot += stamps[k + 1] - stamps[k];
        while (wall_clock64() - now < 4ull * tot) __builtin_amdgcn_s_sleep(16);
    }
#endif
}

extern "C" void kernel_launch(void* const* d_in, const int* in_sizes, int n_in, void* d_out, int out_size, void* d_ws, size_t ws_size, hipStream_t stream) {
    static int grid = 0;
    if (grid == 0) {
        if (n_in != 37 || out_size != T * D || ws_size < WS_END) { fprintf(stderr, "kernel_launch: unexpected shapes: n_in %d out %d ws %zu (need %zu)\n", n_in, out_size, ws_size, (size_t)WS_END); grid = -1; return; }
        int dev = 0, cus = 0;
        if (hipGetDevice(&dev) != hipSuccess || hipDeviceGetAttribute(&cus, hipDeviceAttributeMultiprocessorCount, dev) != hipSuccess) { grid = -1; return; }
        if (hipFuncSetAttribute((const void*)fwd_kernel, hipFuncAttributeMaxDynamicSharedMemorySize, LDS_BYTES) != hipSuccess) { fprintf(stderr, "kernel_launch: hipFuncSetAttribute failed\n"); grid = -1; return; }
        int per_cu = 0;
        if (hipOccupancyMaxActiveBlocksPerMultiprocessor(&per_cu, (const void*)fwd_kernel, NTHR, LDS_BYTES) != hipSuccess || per_cu < 1) fprintf(stderr, "kernel_launch: occupancy query says %d\n", per_cu);
        (void)hipGetLastError();
        grid = cus;
    }
    if (grid < 0) return;
    (void)hipMemsetAsync((char*)d_ws + WS_CTL, 0, CTL_BYTES, stream);
    Params p{};
    for (int i = 0; i < 37; ++i) p.in[i] = (const float*)d_in[i];
    p.out = (float*)d_out; p.ws = (unsigned char*)d_ws;
#if MK_ONE_LAUNCH
    p.ph_lo = 0; p.ph_hi = NPHASE;
    hipLaunchKernelGGL(fwd_kernel, dim3(grid), dim3(NTHR), LDS_BYTES, stream, p);
#else
    for (int k = 0; k < NPHASE; ++k) { p.ph_lo = k; p.ph_hi = k + 1; hipLaunchKernelGGL(fwd_kernel, dim3(grid), dim3(NTHR), LDS_BYTES, stream, p); }
#endif
}
```
